# Optimizing an MI355X kernel written in HIP

```python
import math
import jax
import jax.numpy as jnp
from jax import lax
import numpy as np

D_MODEL = 1024
BATCH = 2
SEQ = 16384
DEPTH = 2

GRID_W = 64
CTX_LEN = 256
N_BRANCH = 4
N_HEADS = 4
HEAD_DIM = 64
BR_WIDTH = N_HEADS * HEAD_DIM
D_FF = 2816
MACARON_W = 0.5
N_SUB = 3
N_MOD = 3
EPS = 1e-6
ROPE_BASE = 10000.0
QBLOCK = 128

RW_DECAY_LORA = 64
RW_AAA_LORA = 64
RW_GATE_LORA = 128
RW_LN_EPS = 64e-5
RW_SIZES = (BR_WIDTH, BR_WIDTH, BR_WIDTH, RW_GATE_LORA, RW_DECAY_LORA, RW_DECAY_LORA, RW_AAA_LORA, RW_AAA_LORA)
RW_COLS = 3 * BR_WIDTH + RW_GATE_LORA + 2 * RW_DECAY_LORA + 2 * RW_AAA_LORA

HY_COLS = 3 * BR_WIDTH
HY_EMB = 33
HY_FFN = 64
HY_FAST_DECAY = 0.3
HY_SLOW_DECAY = 1.5
HY_TARGET = 1e-2

MLA_Q_RANK = 192
MLA_KV_RANK = 128
MLA_NOPE = 64
MLA_ROPE = 32
MLA_V = HEAD_DIM
MLA_SIZES = (MLA_Q_RANK, MLA_KV_RANK, MLA_ROPE)
MLA_COLS = MLA_Q_RANK + MLA_KV_RANK + MLA_ROPE

DF_QK = 32
DF_V = 2 * DF_QK
DF_SUBLN_EPS = 1e-5
DF_SIZES = (2 * N_HEADS * DF_QK, 2 * N_HEADS * DF_QK, N_HEADS * DF_V)
DF_COLS = 4 * N_HEADS * DF_QK + N_HEADS * DF_V

SECTION_SIZES = (RW_COLS, HY_COLS, MLA_COLS, DF_COLS)
P_TOTAL = RW_COLS + HY_COLS + MLA_COLS + DF_COLS

kernel_name = 'hybrid_rwkv_hyena_mla_diff_prefix_dit'


def _split(x, sizes):
    cuts = [int(i) for i in np.cumsum(sizes)[:-1]]
    return jnp.split(x, cuts, axis=-1)


def _flat(x):
    return x.reshape(x.shape[:2] + (-1,))


def _rmsnorm(x, g, eps=EPS):
    xf = x.astype(jnp.float32)
    y = xf * lax.rsqrt(jnp.mean(xf * xf, axis=-1, keepdims=True) + eps)
    return (y * g.astype(jnp.float32)).astype(x.dtype)


def _modulated_norm(x, g, mod_s):
    return _rmsnorm(x, g) * (1.0 + mod_s[:, 1][:, None]) + mod_s[:, 0][:, None]


def _gated_post_add(x, y, g_post, mod_s, weight):
    return x + weight * mod_s[:, 2][:, None] * _rmsnorm(y, g_post)


def _ffn_sublayer(x, mod_s, g_pre, g_post, w_in, w_out):
    h = _modulated_norm(x, g_pre, mod_s)
    a, b = jnp.split(h @ w_in, 2, axis=-1)
    return _gated_post_add(x, (jax.nn.silu(a) * b) @ w_out, g_post, mod_s, MACARON_W)


def _conv3(x, w):
    xp = jnp.pad(x, ((0, 0), (1, 1), (0, 0)))
    return xp[:, :-2] * w[0] + xp[:, 1:-1] * w[1] + xp[:, 2:] * w[2]


def _axial_tables(n_lat, rot_dim, dtype):
    rows = n_lat // GRID_W
    row = jnp.repeat(jnp.arange(rows, dtype=jnp.float32), GRID_W)
    col = jnp.tile(jnp.arange(GRID_W, dtype=jnp.float32), rows)
    half = rot_dim // 2
    inv = ROPE_BASE ** (-jnp.arange(0, half, 2, dtype=jnp.float32) / half)

    def tab(pos):
        ang = pos[:, None] * inv[None]
        return jnp.cos(ang)[:, None].astype(dtype), jnp.sin(ang)[:, None].astype(dtype)

    return tab(row), tab(col)


def _rope_half(x, cos, sin):
    x1, x2 = jnp.split(x, 2, axis=-1)
    return jnp.concatenate([x1 * cos - x2 * sin, x2 * cos + x1 * sin], axis=-1)


def _rope_2d(x, tabs):
    (cr, sr), (cc, sc) = tabs
    xr, xc = jnp.split(x, 2, axis=-1)
    return jnp.concatenate([_rope_half(xr, cr, sr), _rope_half(xc, cc, sc)], axis=-1)


def _softmax_f32(s, scale):
    return jax.nn.softmax(s.astype(jnp.float32) * scale, axis=-1)


def _attend(q, k, v, scale):
    p = _softmax_f32(jnp.einsum('bqhd,bkhd->bhqk', q, k), scale).astype(v.dtype)
    return jnp.einsum('bhqk,bkhe->bqhe', p, v)


def _diff_attend(q1, q2, k1, k2, v, lam, scale):
    p1 = _softmax_f32(jnp.einsum('bqhd,bkhd->bhqk', q1, k1), scale)
    p2 = _softmax_f32(jnp.einsum('bqhd,bkhd->bhqk', q2, k2), scale)
    a = (p1 - lam * p2).astype(v.dtype)
    return jnp.einsum('bhqk,bkhe->bqhe', a, v)


def _by_query_blocks(fn, *qs):
    b, t = qs[0].shape[:2]
    nb = t // QBLOCK
    blocks = tuple(jnp.swapaxes(q.reshape((b, nb, QBLOCK) + q.shape[2:]), 0, 1) for q in qs)
    out = lax.map(lambda blk: fn(*blk), blocks)
    return jnp.swapaxes(out, 0, 1).reshape((b, t) + out.shape[3:])


def _rwkv_prepare(p, w0, w2, a0, a2, g2, k_k, k_a):
    r, k, v, g_a, wa_f, wa_b, aa_f, aa_b = _split(p, RW_SIZES)
    bsz, t = p.shape[:2]

    def heads(z):
        return z.reshape(bsz, t, N_HEADS, HEAD_DIM)

    kk = heads((k * k_k).astype(jnp.float32))
    kk = kk / jnp.maximum(jnp.linalg.norm(kk, axis=-1, keepdims=True), 1e-12)
    decays, ks, bs = [], [], []
    for d, (wa, aa) in enumerate(((wa_f, aa_f), (wa_b, aa_b))):
        w_log = -jax.nn.softplus(-(w0[d] + jnp.tanh(wa) @ w2[d])) - 0.5
        decays.append(heads(jnp.exp(-jnp.exp(w_log.astype(jnp.float32)))))
        a = jax.nn.sigmoid(a0[d] + aa @ a2[d])
        ks.append(heads(k * (1.0 + (a - 1.0) * k_a)))
        bs.append(kk * heads(a.astype(jnp.float32)))
    g = jax.nn.sigmoid(g_a) @ g2
    return heads(r), heads(v), kk, g, decays, ks, bs


def _wkv7_scan(state0, r, w, k, v, kk, b, reverse, with_out):
    def step(s, inp):
        r_t, w_t, k_t, v_t, kk_t, b_t = inp
        sa = jnp.einsum('bhij,bhj->bhi', s, -kk_t)
        s = s * w_t[:, :, None, :] + sa[..., None] * b_t[:, :, None, :] + v_t[..., None] * k_t[:, :, None, :]
        y = jnp.einsum('bhij,bhj->bhi', s, r_t) if with_out else None
        return s, y

    xs = tuple(jnp.moveaxis(z.astype(jnp.float32), 1, 0) for z in (r, w, k, v, kk, b))
    s_fin, ys = lax.scan(step, state0, xs, reverse=reverse)
    return s_fin, (jnp.moveaxis(ys, 0, 1) if with_out else None)


def _rwkv_dir(state0, prep, d, reverse, with_out):
    r, v, kk, g, decays, ks, bs = prep
    return _wkv7_scan(state0, r, decays[d], ks[d], v, kk, bs[d], reverse, with_out)


def _rwkv_output(y_f, y_b, prep, r_k, ln_w, ln_b):
    r, v, kk, g, decays, ks, bs = prep
    y = y_f + y_b
    mean = jnp.mean(y, axis=-1, keepdims=True)
    var = jnp.mean(jnp.square(y - mean), axis=-1, keepdims=True)
    y = _flat((y - mean) * lax.rsqrt(var + RW_LN_EPS)) * ln_w + ln_b
    bonus = sum(jnp.sum(r * k_d * r_k, axis=-1, keepdims=True) * v for k_d in ks)
    return ((y + _flat(bonus)) * g).astype(v.dtype)


def _hyena_filter(n, w1, b1, f1, w2, b2, f2, w3):
    t = jnp.linspace(0.0, 1.0, n, dtype=jnp.float32)[:, None]
    bands = (HY_EMB - 1) // 2
    wpos = 2.0 * math.pi * jnp.arange(n, dtype=jnp.float32) / n
    fr = jnp.linspace(1e-4, bands - 1, bands, dtype=jnp.float32)
    ang = wpos[:, None] * fr[None]
    z = jnp.concatenate([t, jnp.cos(ang), -jnp.sin(ang)], axis=-1)
    h = jnp.sin(f1 * (z @ w1 + b1))
    h = jnp.sin(f2 * (h @ w2 + b2))
    h = (h @ w3).astype(jnp.float32)
    max_decay = math.log(HY_TARGET) / HY_FAST_DECAY
    min_decay = math.log(HY_TARGET) / HY_SLOW_DECAY
    deltas = jnp.abs(jnp.linspace(min_decay, max_decay, BR_WIDTH, dtype=jnp.float32))
    h = h * jnp.exp(-t * jnp.tile(deltas, 2)[None])
    h_f, h_b = jnp.split(h, 2, axis=-1)
    kern = jnp.concatenate([h_f, jnp.zeros((1, BR_WIDTH), jnp.float32), h_b[:n - 1][::-1]], axis=0)
    return kern * lax.rsqrt(jnp.sum(kern * kern, axis=0, keepdims=True))


def _fftconv(u, kern):
    n = u.shape[1]
    uf = jnp.fft.rfft(u.astype(jnp.float32), n=2 * n, axis=1)
    kf = jnp.fft.rfft(kern, n=2 * n, axis=0)
    return jnp.fft.irfft(uf * kf[None], n=2 * n, axis=1)[:, :n].astype(u.dtype)


def _hyena(p, conv_w, conv_b, w1, b1, f1, w2, b2, f2, w3, bias):
    u = _conv3(p, conv_w) + conv_b
    x0, x1, v = jnp.split(u, 3, axis=-1)
    kern = _hyena_filter(u.shape[1], w1, b1, f1, w2, b2, f2, w3)
    z = v * x1
    z = _fftconv(z, kern) + z * bias
    return x0 * z


def _mla_qkv(p, q_norm, wq_b, kv_norm, wkv_b, tabs):
    cq, ckv, kpe = _split(p, MLA_SIZES)
    bsz, t = p.shape[:2]
    q = (_rmsnorm(cq, q_norm) @ wq_b).reshape(bsz, t, N_HEADS, MLA_NOPE + MLA_ROPE)
    q_nope, q_pe = q[..., :MLA_NOPE], q[..., MLA_NOPE:]
    kv = (_rmsnorm(ckv, kv_norm) @ wkv_b).reshape(bsz, t, N_HEADS, MLA_NOPE + MLA_V)
    k_nope, v = kv[..., :MLA_NOPE], kv[..., MLA_NOPE:]
    k_pe = kpe[:, :, None, :]
    if tabs is not None:
        q_pe = _rope_2d(q_pe, tabs)
        k_pe = _rope_2d(k_pe, tabs)
    q = jnp.concatenate([q_nope, q_pe], axis=-1)
    k = jnp.concatenate([k_nope, jnp.broadcast_to(k_pe, (bsz, t, N_HEADS, MLA_ROPE))], axis=-1)
    return q, k, v


def _diff_qkv(p, tabs):
    pq, pk, pv = _split(p, DF_SIZES)
    bsz, t = p.shape[:2]
    q = pq.reshape(bsz, t, 2 * N_HEADS, DF_QK)
    k = pk.reshape(bsz, t, 2 * N_HEADS, DF_QK)
    if tabs is not None:
        q = _rope_2d(q, tabs)
        k = _rope_2d(k, tabs)
    q = q.reshape(bsz, t, N_HEADS, 2, DF_QK)
    k = k.reshape(bsz, t, N_HEADS, 2, DF_QK)
    return q[..., 0, :], q[..., 1, :], k[..., 0, :], k[..., 1, :], pv.reshape(bsz, t, N_HEADS, DF_V)


def _diff_out(o, subln, lam_init):
    return _flat(_rmsnorm(o, subln, DF_SUBLN_EPS) * (1.0 - lam_init))


def _merge(h, outs, w_up, w_gate, b_gate, w_o):
    acc = sum(jax.nn.sigmoid(h @ w_gate[n] + b_gate[n]) * (o @ w_up[n]) for n, o in enumerate(outs))
    return acc @ w_o


def _token_mixing(h, hc, tabs_mla, tabs_df, lam_init, with_ctx_out, lp):
    p_rw, p_hy, p_mla, p_df = _split(h @ lp['w_in'], SECTION_SIZES)
    c_rw, c_hy, c_mla, c_df = _split(hc @ lp['w_in'], SECTION_SIZES)

    mu = lp['rw_mu']
    shift_w = jnp.stack([0.5 * mu, 1.0 - mu, 0.5 * mu])
    rw_args = (lp['rw_w0'], lp['rw_w2'], lp['rw_a0'], lp['rw_a2'], lp['rw_g2'], lp['rw_kk'], lp['rw_ka'])
    prep = _rwkv_prepare(_conv3(p_rw, shift_w), *rw_args)
    prep_c = _rwkv_prepare(_conv3(c_rw, shift_w), *rw_args)
    s0 = jnp.zeros((hc.shape[0], N_HEADS, HEAD_DIM, HEAD_DIM), jnp.float32)
    sf_c, yf_c = _rwkv_dir(s0, prep_c, 0, False, with_ctx_out)
    sb_c, yb_c = _rwkv_dir(s0, prep_c, 1, True, with_ctx_out)
    _, yf = _rwkv_dir(sf_c, prep, 0, False, True)
    _, yb = _rwkv_dir(sb_c, prep, 1, True, True)
    rw_out_args = (lp['rw_rk'], lp['rw_ln_w'], lp['rw_ln_b'])
    o_rw = _rwkv_output(yf, yb, prep, *rw_out_args)

    hy_args = (lp['hy_conv_w'], lp['hy_conv_b'], lp['hy_w1'], lp['hy_b1'], lp['hy_f1'],
               lp['hy_w2'], lp['hy_b2'], lp['hy_f2'], lp['hy_w3'], lp['hy_bias'])
    o_hy = _hyena(p_hy, *hy_args)

    mla_args = (lp['mla_q_norm'], lp['mla_wq_b'], lp['mla_kv_norm'], lp['mla_wkv_b'])
    q, k, v = _mla_qkv(p_mla, *mla_args, tabs_mla)
    qc, kc, vc = _mla_qkv(c_mla, *mla_args, None)
    k_all = jnp.concatenate([k, kc], axis=1)
    v_all = jnp.concatenate([v, vc], axis=1)
    s_mla = 1.0 / math.sqrt(MLA_NOPE + MLA_ROPE)
    o_mla = _flat(_by_query_blocks(lambda qb: _attend(qb, k_all, v_all, s_mla), q))

    lam = (jnp.exp(jnp.sum(lp['df_lq1'] * lp['df_lk1']).astype(jnp.float32))
           - jnp.exp(jnp.sum(lp['df_lq2'] * lp['df_lk2']).astype(jnp.float32)) + lam_init)
    q1, q2, k1, k2, vd = _diff_qkv(p_df, tabs_df)
    qc1, qc2, kc1, kc2, vdc = _diff_qkv(c_df, None)
    k1_all = jnp.concatenate([k1, kc1], axis=1)
    k2_all = jnp.concatenate([k2, kc2], axis=1)
    vd_all = jnp.concatenate([vd, vdc], axis=1)
    s_df = 1.0 / math.sqrt(DF_QK)
    o_df = _by_query_blocks(lambda a, b: _diff_attend(a, b, k1_all, k2_all, vd_all, lam, s_df), q1, q2)
    o_df = _diff_out(o_df, lp['df_subln'], lam_init)

    merge_args = (lp['w_up'], lp['w_gate'], lp['b_gate'], lp['w_o'])
    y = _merge(h, (o_rw, o_hy, o_mla, o_df), *merge_args)
    if not with_ctx_out:
        return y, None

    oc_rw = _rwkv_output(yf_c, yb_c, prep_c, *rw_out_args)
    oc_hy = _hyena(c_hy, *hy_args)
    oc_mla = _flat(_attend(qc, kc, vc, s_mla))
    oc_df = _diff_out(_diff_attend(qc1, qc2, kc1, kc2, vdc, lam, s_df), lp['df_subln'], lam_init)
    yc = _merge(hc, (oc_rw, oc_hy, oc_mla, oc_df), *merge_args)
    return y, yc


def setup_inputs(seed: int = 0) -> dict:
    key = jax.random.key(seed)
    keys = jax.random.split(key, 64)
    counter = [0]
    f32 = jnp.float32
    L = DEPTH
    D = D_MODEL

    def nxt():
        k = keys[counter[0]]
        counter[0] += 1
        return k

    def nrm(shape, scale):
        return scale * jax.random.normal(nxt(), shape, f32)

    def gain(shape):
        return 1.0 + nrm(shape, 0.02)

    def unif(shape, lo, hi):
        return jax.random.uniform(nxt(), shape, f32, lo, hi)

    return {
        'x': nrm((BATCH, SEQ, D), 1.0),
        'c': nrm((BATCH, D), 1.0),
        'ctx': nrm((BATCH, CTX_LEN, D), 1.0),
        'c_ctx': nrm((D,), 1.0),
        'w_mod': nrm((L, D, N_SUB * N_MOD * D), 0.5 * D ** -0.5),
        'b_mod': nrm((L, N_SUB * N_MOD * D), 0.02),
        'norm_pre': gain((L, N_SUB, D)),
        'norm_post': gain((L, N_SUB, D)),
        'ffn_w_in': nrm((L, 2, D, 2 * D_FF), D ** -0.5),
        'ffn_w_out': nrm((L, 2, D_FF, D), D_FF ** -0.5),
        'w_in': nrm((L, D, P_TOTAL), D ** -0.5),
        'rw_mu': unif((L, RW_COLS), 0.2, 0.8),
        'rw_w0': unif((L, 2, BR_WIDTH), -6.0, -1.0),
        'rw_w2': nrm((L, 2, RW_DECAY_LORA, BR_WIDTH), 0.1 * RW_DECAY_LORA ** -0.5),
        'rw_a0': nrm((L, 2, BR_WIDTH), 0.1),
        'rw_a2': nrm((L, 2, RW_AAA_LORA, BR_WIDTH), 0.1 * RW_AAA_LORA ** -0.5),
        'rw_g2': nrm((L, RW_GATE_LORA, BR_WIDTH), RW_GATE_LORA ** -0.5),
        'rw_kk': 0.85 + nrm((L, BR_WIDTH), 0.02),
        'rw_ka': gain((L, BR_WIDTH)),
        'rw_rk': nrm((L, N_HEADS, HEAD_DIM), 0.1),
        'rw_ln_w': gain((L, BR_WIDTH)),
        'rw_ln_b': nrm((L, BR_WIDTH), 0.02),
        'hy_conv_w': nrm((L, 3, HY_COLS), 3 ** -0.5),
        'hy_conv_b': nrm((L, HY_COLS), 0.02),
        'hy_w1': nrm((L, HY_EMB, HY_FFN), HY_EMB ** -0.5),
        'hy_b1': nrm((L, HY_FFN), 0.02),
        'hy_f1': gain((L, HY_FFN)),
        'hy_w2': nrm((L, HY_FFN, HY_FFN), HY_FFN ** -0.5),
        'hy_b2': nrm((L, HY_FFN), 0.02),
        'hy_f2': gain((L, HY_FFN)),
        'hy_w3': nrm((L, HY_FFN, 2 * BR_WIDTH), HY_FFN ** -0.5),
        'hy_bias': nrm((L, BR_WIDTH), 0.5),
        'mla_q_norm': gain((L, MLA_Q_RANK)),
        'mla_wq_b': nrm((L, MLA_Q_RANK, N_HEADS * (MLA_NOPE + MLA_ROPE)), MLA_Q_RANK ** -0.5),
        'mla_kv_norm': gain((L, MLA_KV_RANK)),
        'mla_wkv_b': nrm((L, MLA_KV_RANK, N_HEADS * (MLA_NOPE + MLA_V)), MLA_KV_RANK ** -0.5),
        'df_lq1': nrm((L, DF_QK), 0.1),
        'df_lk1': nrm((L, DF_QK), 0.1),
        'df_lq2': nrm((L, DF_QK), 0.1),
        'df_lk2': nrm((L, DF_QK), 0.1),
        'df_subln': gain((L, DF_V)),
        'w_up': nrm((L, N_BRANCH, BR_WIDTH, D), BR_WIDTH ** -0.5),
        'w_gate': nrm((L, N_BRANCH, D, D), D ** -0.5),
        'b_gate': nrm((L, N_BRANCH, D), 0.02),
        'w_o': nrm((L, D, D), D ** -0.5),
    }


def reference(x, c, ctx, c_ctx, w_mod, b_mod, norm_pre, norm_post, ffn_w_in, ffn_w_out, w_in,
              rw_mu, rw_w0, rw_w2, rw_a0, rw_a2, rw_g2, rw_kk, rw_ka, rw_rk, rw_ln_w, rw_ln_b,
              hy_conv_w, hy_conv_b, hy_w1, hy_b1, hy_f1, hy_w2, hy_b2, hy_f2, hy_w3, hy_bias,
              mla_q_norm, mla_wq_b, mla_kv_norm, mla_wkv_b,
              df_lq1, df_lk1, df_lq2, df_lk2, df_subln, w_up, w_gate, b_gate, w_o):
    n_lat = x.shape[1]
    tabs_mla = _axial_tables(n_lat, MLA_ROPE, x.dtype)
    tabs_df = _axial_tables(n_lat, DF_QK, x.dtype)
    s_c = jax.nn.silu(c)
    s_cc = jax.nn.silu(c_ctx)[None]
    xc = ctx
    for l in range(DEPTH):
        last = l == DEPTH - 1
        mod = (s_c @ w_mod[l] + b_mod[l]).reshape(-1, N_SUB, N_MOD, D_MODEL)
        modc = (s_cc @ w_mod[l] + b_mod[l]).reshape(1, N_SUB, N_MOD, D_MODEL)
        ffn_a = (norm_pre[l, 0], norm_post[l, 0], ffn_w_in[l, 0], ffn_w_out[l, 0])
        ffn_b = (norm_pre[l, 2], norm_post[l, 2], ffn_w_in[l, 1], ffn_w_out[l, 1])

        x = _ffn_sublayer(x, mod[:, 0], *ffn_a)
        xc = _ffn_sublayer(xc, modc[:, 0], *ffn_a)

        h = _modulated_norm(x, norm_pre[l, 1], mod[:, 1])
        hc = _modulated_norm(xc, norm_pre[l, 1], modc[:, 1])
        lp = dict(w_in=w_in[l], rw_mu=rw_mu[l], rw_w0=rw_w0[l], rw_w2=rw_w2[l], rw_a0=rw_a0[l],
                  rw_a2=rw_a2[l], rw_g2=rw_g2[l], rw_kk=rw_kk[l], rw_ka=rw_ka[l], rw_rk=rw_rk[l],
                  rw_ln_w=rw_ln_w[l], rw_ln_b=rw_ln_b[l], hy_conv_w=hy_conv_w[l], hy_conv_b=hy_conv_b[l],
                  hy_w1=hy_w1[l], hy_b1=hy_b1[l], hy_f1=hy_f1[l], hy_w2=hy_w2[l], hy_b2=hy_b2[l],
                  hy_f2=hy_f2[l], hy_w3=hy_w3[l], hy_bias=hy_bias[l], mla_q_norm=mla_q_norm[l],
                  mla_wq_b=mla_wq_b[l], mla_kv_norm=mla_kv_norm[l], mla_wkv_b=mla_wkv_b[l],
                  df_lq1=df_lq1[l], df_lk1=df_lk1[l], df_lq2=df_lq2[l], df_lk2=df_lk2[l],
                  df_subln=df_subln[l], w_up=w_up[l], w_gate=w_gate[l], b_gate=b_gate[l], w_o=w_o[l])
        lam_init = 0.8 - 0.6 * math.exp(-0.3 * l)
        y, yc = _token_mixing(h, hc, tabs_mla, tabs_df, lam_init, not last, lp)

        x = _gated_post_add(x, y, norm_post[l, 1], mod[:, 1], 1.0)
        x = _ffn_sublayer(x, mod[:, 2], *ffn_b)
        if not last:
            xc = _gated_post_add(xc, yc, norm_post[l, 1], modc[:, 1], 1.0)
            xc = _ffn_sublayer(xc, modc[:, 2], *ffn_b)
    return x
```

```cpp
#include <hip/hip_runtime.h>
#include <hip/hip_cooperative_groups.h>
#include <cstdio>
namespace cg = cooperative_groups;

#define DI __device__ __forceinline__
typedef unsigned short u16;
typedef unsigned int u32;
typedef short bf16x8 __attribute__((ext_vector_type(8)));
typedef short s16x4 __attribute__((ext_vector_type(4)));
typedef float f32x16 __attribute__((ext_vector_type(16)));
typedef __bf16 bf16x2_t __attribute__((ext_vector_type(2)));
typedef float f32x2_t __attribute__((ext_vector_type(2)));

#ifndef COOP
#define COOP 1
#endif
#ifndef PHSEL
#define PHSEL -1
#endif
#ifndef T3SEL
#define T3SEL -1
#endif
#define PH_ON(k) (PHSEL < 0 || PHSEL == (k))
#define T3_ON(k) (T3SEL < 0 || T3SEL == (k))

constexpr int D = 1024, ML = 32768, MC = 512, M = 33280, TK = 16640;
constexpr int DFF = 2816, PS = 3072;
constexpr int NT = 512;
constexpr int RKROW = 33024, OFFC = 16408;
constexpr int NPH = 33;
constexpr int SMEM = 110592;

constexpr size_t O_WFFN1 = 0;
constexpr size_t O_WFFN2 = O_WFFN1 + 2ull * 5632 * 1024 * 2;
constexpr size_t O_WIN = O_WFFN2 + 2ull * 1024 * 2816 * 2;
constexpr size_t O_WGATE = O_WIN + 3072ull * 1024 * 2;
constexpr size_t O_WUP = O_WGATE + 4ull * 1024 * 1024 * 2;
constexpr size_t O_WO = O_WUP + 4ull * 1024 * 256 * 2;
constexpr size_t O_WQB = O_WO + 1024ull * 1024 * 2;
constexpr size_t O_WKVB = O_WQB + 384 * 192 * 2;
constexpr size_t O_W2 = O_WKVB + 512 * 128 * 2;
constexpr size_t O_A2 = O_W2 + 2 * 256 * 64 * 2;
constexpr size_t O_G2 = O_A2 + 2 * 256 * 64 * 2;
constexpr size_t O_MOD = O_G2 + 256 * 128 * 2;
constexpr size_t O_CNT = O_MOD + 2ull * 3 * 9216 * 4;
constexpr size_t O_XC = O_CNT + 256;
constexpr size_t O_H = O_XC + 512ull * 1024 * 4;
constexpr size_t O_RKG = O_H + (size_t)M * 1024 * 2;
constexpr size_t O_HFC = O_RKG + 256ull * RKROW * 2;
constexpr size_t O_HPART = O_HFC + 256ull * 512 * 4;
constexpr size_t O_ZC = O_HPART + 260ull * 512 * 4;
constexpr size_t O_X0C = O_ZC + 512ull * 256 * 4;
constexpr size_t O_S = O_X0C + 512ull * 256 * 4;
constexpr size_t O_QD = O_H;
constexpr size_t O_KD = O_QD + 2ull * 8 * TK * 32 * 2;
constexpr size_t O_VDT = O_KD + 2ull * 8 * TK * 32 * 2;
constexpr size_t O_ZT = O_VDT + 2ull * 4 * 64 * TK * 2;
static_assert(O_ZT + 256ull * 2 * 16384 * 2 <= O_RKG, "H alias overflow");
constexpr size_t SZ256 = (size_t)M * 256 * 2;
constexpr size_t S_R = O_S;
constexpr size_t S_KRAW = S_R + SZ256;
constexpr size_t S_V = S_KRAW + SZ256;
constexpr size_t S_KK = S_V + SZ256;
constexpr size_t S_X0T = S_KK + SZ256;
constexpr size_t S_KM = S_X0T + 256ull * 2 * 16384 * 2;
constexpr size_t S_P = S_KM + 2ull * 4 * TK * 96 * 2;
constexpr size_t S_LIN = S_P + (size_t)M * PS * 2;
constexpr size_t S_CQN = S_LIN + (size_t)M * 384 * 2;
constexpr size_t S_CKVN = S_CQN + (size_t)M * 192 * 2;
constexpr size_t S_END = S_CKVN + (size_t)M * 128 * 2;
constexpr size_t S_LOUT = S_P;
constexpr size_t S_QRAW = S_LOUT + (size_t)M * 1280 * 2;
constexpr size_t S_KVRAW = S_QRAW + (size_t)M * 384 * 2;
constexpr size_t S_QM = S_LIN;
constexpr size_t S_VMT = S_QM + 2ull * 4 * TK * 96 * 2;
static_assert(S_VMT + 2ull * 4 * 64 * TK * 2 <= S_END, "QM/VMT overflow");
constexpr size_t S_OALL = S_QRAW;
constexpr size_t S_YF = S_OALL + (size_t)M * 1024 * 2;
constexpr size_t S_YB = S_YF + SZ256;
constexpr size_t S_OHT = S_YB + SZ256;
static_assert(S_OHT + 256ull * 2 * 16384 * 2 <= S_LIN, "P-region overflow");
constexpr size_t S_ACCM = S_LOUT;
constexpr size_t S_YM = S_R;
static_assert(S_YM + (size_t)M * 1024 * 2 <= S_P, "YM overflow");
constexpr size_t S_ACT = O_S;
constexpr size_t S_Y = S_ACT + (size_t)M * DFF * 2;
static_assert(S_Y + (size_t)M * 1024 * 2 <= S_END, "FFN overflow");
constexpr size_t WS_NEED = S_END;

struct Params {
  const float* in[45];
  float* out;
  char* ws;
  int ph0, ph1;
};
typedef const __attribute__((address_space(4))) Params* CP;

DI int tidx() { int t = threadIdx.x; asm volatile("" : "+v"(t)); return t; }
DI u32 pk2(float a, float b) {
  f32x2_t v = {a, b};
  bf16x2_t r = __builtin_convertvector(v, bf16x2_t);
  return __builtin_bit_cast(u32, r);
}
DI u16 f2bf(float f) { return (u16)(pk2(f, 0.f) & 0xffffu); }
DI float bf2f(u16 v) { return __uint_as_float(((u32)v) << 16); }
DI void unpack8(const uint4& v, float (&f)[8]) {
  f[0] = __uint_as_float(v.x << 16); f[1] = __uint_as_float(v.x & 0xffff0000u);
  f[2] = __uint_as_float(v.y << 16); f[3] = __uint_as_float(v.y & 0xffff0000u);
  f[4] = __uint_as_float(v.z << 16); f[5] = __uint_as_float(v.z & 0xffff0000u);
  f[6] = __uint_as_float(v.w << 16); f[7] = __uint_as_float(v.w & 0xffff0000u);
}
DI void ld8(const u16* p, float (&f)[8]) { uint4 v = *(const uint4*)p; unpack8(v, f); }
DI uint4 pack8(const float (&f)[8]) {
  uint4 v; v.x = pk2(f[0], f[1]); v.y = pk2(f[2], f[3]); v.z = pk2(f[4], f[5]); v.w = pk2(f[6], f[7]); return v;
}
DI void st8(u16* p, const float (&f)[8]) { *(uint4*)p = pack8(f); }
DI void ld8f(const float* p, float (&f)[8]) {
  float4 a = *(const float4*)p, b = *(const float4*)(p + 4);
  f[0] = a.x; f[1] = a.y; f[2] = a.z; f[3] = a.w; f[4] = b.x; f[5] = b.y; f[6] = b.z; f[7] = b.w;
}
DI float sigmoidf_(float x) { return 1.f / (1.f + expf(-x)); }
DI float siluf_(float x) { return x / (1.f + expf(-x)); }
DI float wave_sum(float v) {
#pragma unroll
  for (int o = 32; o; o >>= 1) v += __shfl_xor(v, o);
  return v;
}
DI float grp8_sum(float v) { v += __shfl_xor(v, 1); v += __shfl_xor(v, 2); v += __shfl_xor(v, 4); return v; }
template <int CTRL> DI float dppf(float v) {
  return __builtin_bit_cast(float, __builtin_amdgcn_update_dpp(0, __builtin_bit_cast(int, v), CTRL, 0xF, 0xF, true));
}
DI float dpp_sum16(float v) {
  v += dppf<0xB1>(v);
  v += dppf<0x4E>(v);
  v += dppf<0x141>(v);
  v += dppf<0x140>(v);
  return v;
}
#define MFMA32(a, b, c) __builtin_amdgcn_mfma_f32_32x32x16_bf16((a), (b), (c), 0, 0, 0)
DI int crow(int i, int h) { return (i & 3) + 8 * (i >> 2) + 4 * h; }
DI int mod_index(int m) { return m < ML ? (m >> 14) : 2; }
DI float lam_init_of(int l) { return l == 0 ? 0.2f : 0.35550907f; }

DI float rope_inv(int i) { return exp2f(-(float)i * 1.6609640474436813f); }

DI void ph_prep(CP p, char* smem) {
  const int tid = tidx();
  if (blockIdx.x == 0 && tid < 64) ((u32*)(p->ws + O_CNT))[tid] = 0u;
  float* sv = (float*)smem;
  float* red = sv + 3072;
  for (int i = tid; i < 3072; i += NT) {
    int v = i >> 10, k = i & 1023;
    float c = (v < 2) ? p->in[1][v * 1024 + k] : p->in[3][k];
    sv[i] = siluf_(c);
  }
  __syncthreads();
  float* MOD = (float*)(p->ws + O_MOD);
  for (int it = blockIdx.x; it < 288; it += gridDim.x) {
    int l = it / 144, cb = (it % 144) * 64;
    int col = cb + (tid & 63), ks = tid >> 6;
    const float* w = p->in[4] + (size_t)l * 1024 * 9216 + col;
    float a0 = 0.f, a1 = 0.f, a2 = 0.f;
#pragma unroll 8
    for (int k = ks * 128; k < ks * 128 + 128; ++k) {
      float wv = w[(size_t)k * 9216];
      a0 += sv[k] * wv; a1 += sv[1024 + k] * wv; a2 += sv[2048 + k] * wv;
    }
    red[(0 * 8 + ks) * 64 + (tid & 63)] = a0;
    red[(1 * 8 + ks) * 64 + (tid & 63)] = a1;
    red[(2 * 8 + ks) * 64 + (tid & 63)] = a2;
    __syncthreads();
    if (tid < 192) {
      int v = tid >> 6, c = tid & 63;
      float s = 0.f;
#pragma unroll
      for (int q = 0; q < 8; ++q) s += red[(v * 8 + q) * 64 + c];
      MOD[(size_t)l * 27648 + v * 9216 + cb + c] = s + p->in[5][l * 9216 + cb + c];
    }
    __syncthreads();
  }
}

struct CvtJob { const float* src; u16* dst; int K, Nsrc, Ndst, mode; };
DI CvtJob cvt_job(CP p, int l, int j) {
  CvtJob c; c.mode = 0;
  char* ws = p->ws;
  if (j < 2) { c.src = p->in[8] + (size_t)(l * 2 + j) * 1024 * 5632; c.dst = (u16*)(ws + O_WFFN1) + (size_t)j * 5632 * 1024; c.K = 1024; c.Nsrc = 5632; c.Ndst = 5632; c.mode = 1; }
  else if (j < 4) { int f = j - 2; c.src = p->in[9] + (size_t)(l * 2 + f) * 2816 * 1024; c.dst = (u16*)(ws + O_WFFN2) + (size_t)f * 1024 * 2816; c.K = 2816; c.Nsrc = 1024; c.Ndst = 1024; }
  else if (j == 4) { c.src = p->in[10] + (size_t)l * 1024 * 3040; c.dst = (u16*)(ws + O_WIN); c.K = 1024; c.Nsrc = 3040; c.Ndst = 3072; }
  else if (j < 9) { int n = j - 5; c.src = p->in[42] + (size_t)(l * 4 + n) * 1024 * 1024; c.dst = (u16*)(ws + O_WGATE) + (size_t)n * 1024 * 1024; c.K = 1024; c.Nsrc = 1024; c.Ndst = 1024; }
  else if (j < 13) { int n = j - 9; c.src = p->in[41] + (size_t)(l * 4 + n) * 256 * 1024; c.dst = (u16*)(ws + O_WUP) + (size_t)n * 1024 * 256; c.K = 256; c.Nsrc = 1024; c.Ndst = 1024; }
  else if (j == 13) { c.src = p->in[44] + (size_t)l * 1024 * 1024; c.dst = (u16*)(ws + O_WO); c.K = 1024; c.Nsrc = 1024; c.Ndst = 1024; }
  else if (j == 14) { c.src = p->in[33] + (size_t)l * 192 * 384; c.dst = (u16*)(ws + O_WQB); c.K = 192; c.Nsrc = 384; c.Ndst = 384; }
  else if (j == 15) { c.src = p->in[35] + (size_t)l * 128 * 512; c.dst = (u16*)(ws + O_WKVB); c.K = 128; c.Nsrc = 512; c.Ndst = 512; }
  else if (j < 18) { int d = j - 16; c.src = p->in[13] + (size_t)(l * 2 + d) * 64 * 256; c.dst = (u16*)(ws + O_W2) + (size_t)d * 256 * 64; c.K = 64; c.Nsrc = 256; c.Ndst = 256; }
  else if (j < 20) { int d = j - 18; c.src = p->in[15] + (size_t)(l * 2 + d) * 64 * 256; c.dst = (u16*)(ws + O_A2) + (size_t)d * 256 * 64; c.K = 64; c.Nsrc = 256; c.Ndst = 256; }
  else { c.src = p->in[16] + (size_t)l * 128 * 256; c.dst = (u16*)(ws + O_G2); c.K = 128; c.Nsrc = 256; c.Ndst = 256; }
  return c;
}
DI int cvt_tiles(int j) {
  if (j < 2) return 16 * 88;
  if (j < 4) return 44 * 16;
  if (j == 4) return 16 * 48;
  if (j < 9) return 256;
  if (j < 13) return 4 * 16;
  if (j == 13) return 256;
  if (j == 14) return 3 * 6;
  if (j == 15) return 2 * 8;
  if (j < 20) return 4;
  return 2 * 4;
}
constexpr int CVT_TOTAL = 2 * 1408 + 2 * 704 + 768 + 4 * 256 + 4 * 64 + 256 + 18 + 16 + 16 + 8;

DI void cvt_tile(CP p, int l, int tile, char* smem) {
  int j = 0;
  for (; j < 21; ++j) { int n = cvt_tiles(j); if (tile < n) break; tile -= n; }
  CvtJob c = cvt_job(p, l, j);
  const int nkt = c.K >> 6;
  const int k0 = (tile % nkt) * 64, n0 = (tile / nkt) * 64;
  float* t = (float*)smem;
  const int tid = tidx();
#pragma unroll
  for (int e = 0; e < 8; ++e) {
    int idx = tid + NT * e;
    int kk = idx >> 6, nn = idx & 63;
    int nd = n0 + nn;
    int col;
    if (c.mode == 1) {
      int jt = nd >> 7, w = nd & 127;
      int wn = w >> 6, ab = (w >> 5) & 1, cc = w & 31;
      col = ab * 2816 + 64 * jt + 32 * wn + cc;
    } else col = nd;
    float v = (col < c.Nsrc) ? c.src[(size_t)(k0 + kk) * c.Nsrc + col] : 0.f;
    t[kk * 65 + nn] = v;
  }
  __syncthreads();
#pragma unroll
  for (int e = 0; e < 4; ++e) {
    int idx = tid + NT * e;
    int nn = idx >> 5, k2 = (idx & 31) * 2;
    u32 v = pk2(t[k2 * 65 + nn], t[(k2 + 1) * 65 + nn]);
    *(u32*)(c.dst + (size_t)(n0 + nn) * c.K + k0 + k2) = v;
  }
  __syncthreads();
}

DI void filt_item(CP p, int l, int fi, char* smem) {
  const int tid = tidx();
  const bool lat = fi < 256;
  const int n = lat ? 16384 : 256;
  const int p0 = lat ? fi * 64 : (fi - 256) * 64;
  float* zf = (float*)smem;
  float* h1 = zf + 64 * 36;
  float* h2 = h1 + 4096;
  const float* w1 = p->in[24] + l * 33 * 64;
  const float* b1 = p->in[25] + l * 64;
  const float* f1 = p->in[26] + l * 64;
  const float* w2 = p->in[27] + l * 64 * 64;
  const float* b2 = p->in[28] + l * 64;
  const float* f2 = p->in[29] + l * 64;
  const float* w3 = p->in[30] + l * 64 * 512;
  for (int it = tid; it < 64 * 33; it += NT) {
    int pos = it / 33, e = it % 33;
    int pp = p0 + pos;
    float tt = (float)pp / (float)(n - 1);
    float wpos = 6.283185307179586f * (float)pp / (float)n;
    float v;
    if (e == 0) v = tt;
    else {
      int bi = (e - 1) & 15;
      float fr = 1e-4f + (float)bi * ((15.f - 1e-4f) / 15.f);
      float ang = wpos * fr;
      v = (e <= 16) ? cosf(ang) : -sinf(ang);
    }
    zf[pos * 36 + e] = v;
  }
  __syncthreads();
#pragma unroll 1
  for (int e = 0; e < 8; ++e) {
    int it = tid + NT * e;
    int pos = it >> 6, k = it & 63;
    float a = b1[k];
#pragma unroll 3
    for (int q = 0; q < 33; ++q) a += zf[pos * 36 + q] * w1[q * 64 + k];
    h1[pos * 64 + k] = sinf(f1[k] * a);
  }
  __syncthreads();
#pragma unroll 1
  for (int e = 0; e < 8; ++e) {
    int it = tid + NT * e;
    int pos = it >> 6, k = it & 63;
    float a = b2[k];
#pragma unroll 4
    for (int q = 0; q < 64; ++q) a += h1[pos * 64 + q] * w2[q * 64 + k];
    h2[k * 64 + pos] = sinf(f2[k] * a);
  }
  __syncthreads();
  {
    const int c2 = tid, c = c2 & 255;
    const bool bwd = c2 >= 256;
    const float mind = -3.0701134573253945f, maxd = -15.350567286626973f;
    const float dl = fabsf(mind + (float)c * ((maxd - mind) / 255.f));
    float ssq = 0.f;
    u16* rk = (u16*)(p->ws + O_RKG) + (size_t)c * RKROW;
    float* hfc = (float*)(p->ws + O_HFC);
#pragma unroll 1
    for (int g = 0; g < 4; ++g) {
      float acc[16];
#pragma unroll
      for (int j = 0; j < 16; ++j) acc[j] = 0.f;
#pragma unroll 2
      for (int k = 0; k < 64; ++k) {
        const float w = w3[k * 512 + c2];
        const float* hp = h2 + k * 64 + g * 16;
        float4 v0 = *(const float4*)(hp), v1 = *(const float4*)(hp + 4), v2 = *(const float4*)(hp + 8), v3 = *(const float4*)(hp + 12);
        acc[0] += v0.x * w; acc[1] += v0.y * w; acc[2] += v0.z * w; acc[3] += v0.w * w;
        acc[4] += v1.x * w; acc[5] += v1.y * w; acc[6] += v1.z * w; acc[7] += v1.w * w;
        acc[8] += v2.x * w; acc[9] += v2.y * w; acc[10] += v2.z * w; acc[11] += v2.w * w;
        acc[12] += v3.x * w; acc[13] += v3.y * w; acc[14] += v3.z * w; acc[15] += v3.w * w;
      }
#pragma unroll
      for (int j = 0; j < 16; ++j) {
        int pp = p0 + g * 16 + j;
        float tt = (float)pp / (float)(n - 1);
        float val = acc[j] * expf(-tt * dl);
        bool used = !(bwd && pp == n - 1);
        if (used) ssq += val * val;
        if (lat) {
          if (!bwd) rk[OFFC - pp] = f2bf(val);
          else if (used) rk[OFFC + pp + 1] = f2bf(val);
        } else {
          hfc[pp * 512 + c2] = val;
        }
      }
    }
    ((float*)(p->ws + O_HPART))[fi * 512 + c2] = ssq;
  }
  if (fi == 0) {
    u16* rkg = (u16*)(p->ws + O_RKG);
    for (int it = tid; it < 256 * 257; it += NT) {
      int c = it / 257, e = it % 257;
      int idx = e < 25 ? e : 32792 + (e - 25);
      rkg[(size_t)c * RKROW + idx] = 0;
    }
  }
  __syncthreads();
}

DI void row_op(CP p, int m, const float* xs, float* xd, const u16* Y, const float* gpost, const float* modpost, int sub_post,
               float wgt, const float* gpre, const float* modpre, int sub_pre, u16* H) {
  const int lane = tidx() & 63;
  float xa[8], xb[8];
  ld8f(xs + lane * 8, xa);
  ld8f(xs + 512 + lane * 8, xb);
  if (Y) {
    float ya[8], yb[8];
    ld8(Y + (size_t)m * 1024 + lane * 8, ya);
    ld8(Y + (size_t)m * 1024 + 512 + lane * 8, yb);
    float ss = 0.f;
#pragma unroll
    for (int j = 0; j < 8; ++j) ss += ya[j] * ya[j] + yb[j] * yb[j];
    ss = wave_sum(ss);
    float rs = rsqrtf(ss * (1.f / 1024.f) + 1e-6f);
    const float* gate = modpost + (sub_post * 3 + 2) * 1024;
    {
      float g[8], gp[8];
      ld8f(gate + lane * 8, g); ld8f(gpost + lane * 8, gp);
#pragma unroll
      for (int j = 0; j < 8; ++j) xa[j] += wgt * g[j] * (ya[j] * rs * gp[j]);
      ld8f(gate + 512 + lane * 8, g); ld8f(gpost + 512 + lane * 8, gp);
#pragma unroll
      for (int j = 0; j < 8; ++j) xb[j] += wgt * g[j] * (yb[j] * rs * gp[j]);
    }
  }
  if (xd) {
    *(float4*)(xd + lane * 8) = make_float4(xa[0], xa[1], xa[2], xa[3]);
    *(float4*)(xd + lane * 8 + 4) = make_float4(xa[4], xa[5], xa[6], xa[7]);
    *(float4*)(xd + 512 + lane * 8) = make_float4(xb[0], xb[1], xb[2], xb[3]);
    *(float4*)(xd + 512 + lane * 8 + 4) = make_float4(xb[4], xb[5], xb[6], xb[7]);
  }
  if (gpre) {
    float ss = 0.f;
#pragma unroll
    for (int j = 0; j < 8; ++j) ss += xa[j] * xa[j] + xb[j] * xb[j];
    ss = wave_sum(ss);
    float rs = rsqrtf(ss * (1.f / 1024.f) + 1e-6f);
    const float* shift = modpre + (sub_pre * 3 + 0) * 1024;
    const float* scale = modpre + (sub_pre * 3 + 1) * 1024;
    float g[8], sc[8], sh[8], hv[8];
    ld8f(gpre + lane * 8, g); ld8f(scale + lane * 8, sc); ld8f(shift + lane * 8, sh);
#pragma unroll
    for (int j = 0; j < 8; ++j) hv[j] = xa[j] * rs * g[j] * (1.f + sc[j]) + sh[j];
    st8(H + (size_t)m * 1024 + lane * 8, hv);
    ld8f(gpre + 512 + lane * 8, g); ld8f(scale + 512 + lane * 8, sc); ld8f(shift + 512 + lane * 8, sh);
#pragma unroll
    for (int j = 0; j < 8; ++j) hv[j] = xb[j] * rs * g[j] * (1.f + sc[j]) + sh[j];
    st8(H + (size_t)m * 1024 + 512 + lane * 8, hv);
  }
}

DI void row_dispatch(CP p, int l, int kind, int m) {
  const float* MOD = (const float*)(p->ws + O_MOD);
  const int mi = mod_index(m);
  const float* modl = MOD + (size_t)l * 27648 + mi * 9216;
  float* xc = (float*)(p->ws + O_XC);
  float* xcur = (m < ML) ? p->out + (size_t)m * 1024 : xc + (size_t)(m - ML) * 1024;
  const float* xin = (m < ML) ? p->in[0] + (size_t)m * 1024 : p->in[2] + (size_t)(m - ML) * 1024;
  u16* H = (u16*)(p->ws + O_H);
  const float* npre = p->in[6] + (size_t)l * 3 * 1024;
  const float* npost = p->in[7] + (size_t)l * 3 * 1024;
  if (kind == 0) {
    row_op(p, m, xin, nullptr, nullptr, nullptr, nullptr, 0, 0.f, npre, modl, 0, H);
  } else if (kind == 1) {
    const float* xs = (l == 0) ? xin : xcur;
    row_op(p, m, xs, xcur, (const u16*)(p->ws + S_Y), npost, modl, 0, 0.5f, npre + 1024, modl, 1, H);
  } else if (kind == 2) {
    row_op(p, m, xcur, xcur, (const u16*)(p->ws + S_YM), npost + 1024, modl, 1, 1.0f, npre + 2048, modl, 2, H);
  } else {
    if (l == 0) {
      const float* modn = MOD + (size_t)1 * 27648 + mi * 9216;
      row_op(p, m, xcur, xcur, (const u16*)(p->ws + S_Y), npost + 2048, modl, 2, 0.5f, p->in[6] + 3 * 1024, modn, 0, H);
    } else {
      row_op(p, m, xcur, xcur, (const u16*)(p->ws + S_Y), npost + 2048, modl, 2, 0.5f, nullptr, nullptr, 0, nullptr);
    }
  }
}
DI void ph_rows(CP p, int l, int kind) {
  const int wave = tidx() >> 6;
  for (int m = blockIdx.x * 8 + wave; m < M; m += gridDim.x * 8) row_dispatch(p, l, kind, m);
}

template <int BM, int WNT>
DI void gemm_main(const u16* __restrict__ A, int lda, const u16* __restrict__ BT, int K, int m0, int n0, char* lds,
                  f32x16 (&acc)[2][WNT]) {
  constexpr int AE = BM / 64;
  constexpr int STG = (BM + 128) * 144;
  constexpr int WN = 32 * WNT;
  const int tid = tidx(), lane = tid & 63, wave = tid >> 6, r = lane & 31, h = lane >> 5;
  const int wm = (BM == 256) ? (wave >> 1) : (wave >> 2);
  const int wn = (BM == 256) ? (wave & 1) : (wave & 3);
  const int KT = K >> 6;
  uint4 ra0, ra1, ra2 = make_uint4(0, 0, 0, 0), ra3 = make_uint4(0, 0, 0, 0), rb0, rb1;
  const u16* Ap = A + (size_t)(m0 + (tid >> 3)) * lda + (tid & 7) * 8;
  const u16* Bp = BT + (size_t)(n0 + (tid >> 3)) * K + (tid & 7) * 8;
  const size_t astr = (size_t)64 * lda, bstr = (size_t)64 * K;
  ra0 = *(const uint4*)(Ap); ra1 = *(const uint4*)(Ap + astr);
  if constexpr (AE == 4) { ra2 = *(const uint4*)(Ap + 2 * astr); ra3 = *(const uint4*)(Ap + 3 * astr); }
  rb0 = *(const uint4*)(Bp); rb1 = *(const uint4*)(Bp + bstr);
  const int sto = (tid >> 3) * 144 + (tid & 7) * 16;
  {
    char* sn = lds;
    *(uint4*)(sn + sto) = ra0; *(uint4*)(sn + sto + 64 * 144) = ra1;
    if constexpr (AE == 4) { *(uint4*)(sn + sto + 128 * 144) = ra2; *(uint4*)(sn + sto + 192 * 144) = ra3; }
    *(uint4*)(sn + BM * 144 + sto) = rb0; *(uint4*)(sn + BM * 144 + sto + 64 * 144) = rb1;
  }
  __syncthreads();
  const int aoff = (64 * wm + r) * 144 + 16 * h;
  const int boff = BM * 144 + (WN * wn + r) * 144 + 16 * h;
#pragma unroll 1
  for (int kt = 0; kt < KT; ++kt) {
    const bool more = kt + 1 < KT;
    if (more) {
      const int ko = (kt + 1) * 64;
      ra0 = *(const uint4*)(Ap + ko); ra1 = *(const uint4*)(Ap + astr + ko);
      if constexpr (AE == 4) { ra2 = *(const uint4*)(Ap + 2 * astr + ko); ra3 = *(const uint4*)(Ap + 3 * astr + ko); }
      rb0 = *(const uint4*)(Bp + ko); rb1 = *(const uint4*)(Bp + bstr + ko);
    }
    const char* sbase = lds + (kt & 1) * STG;
#pragma unroll
    for (int s = 0; s < 4; ++s) {
      bf16x8 a0 = *(const bf16x8*)(sbase + aoff + s * 32);
      bf16x8 a1 = *(const bf16x8*)(sbase + aoff + 32 * 144 + s * 32);
      bf16x8 b0 = *(const bf16x8*)(sbase + boff + s * 32);
      acc[0][0] = MFMA32(a0, b0, acc[0][0]);
      acc[1][0] = MFMA32(a1, b0, acc[1][0]);
      if constexpr (WNT == 2) {
        bf16x8 b1 = *(const bf16x8*)(sbase + boff + 32 * 144 + s * 32);
        acc[0][1] = MFMA32(a0, b1, acc[0][1]);
        acc[1][1] = MFMA32(a1, b1, acc[1][1]);
      }
    }
    if (more) {
      char* sn = lds + ((kt + 1) & 1) * STG;
      *(uint4*)(sn + sto) = ra0; *(uint4*)(sn + sto + 64 * 144) = ra1;
      if constexpr (AE == 4) { *(uint4*)(sn + sto + 128 * 144) = ra2; *(uint4*)(sn + sto + 192 * 144) = ra3; }
      *(uint4*)(sn + BM * 144 + sto) = rb0; *(uint4*)(sn + BM * 144 + sto + 64 * 144) = rb1;
    }
    __syncthreads();
  }
}
template <int WNT> DI void zero_acc(f32x16 (&acc)[2][WNT]) {
#pragma unroll
  for (int a = 0; a < 2; ++a)
#pragma unroll
    for (int b = 0; b < WNT; ++b)
#pragma unroll
      for (int i = 0; i < 16; ++i) acc[a][b][i] = 0.f;
}
template <int BM, int WNT>
DI void store_bf16(const f32x16 (&acc)[2][WNT], u16* C, int ldc, int m0, int n0) {
  const int lane = tidx() & 63, wave = tidx() >> 6, r = lane & 31, h = lane >> 5;
  const int wm = (BM == 256) ? (wave >> 1) : (wave >> 2);
  const int wn = (BM == 256) ? (wave & 1) : (wave & 3);
#pragma unroll
  for (int mt = 0; mt < 2; ++mt)
#pragma unroll
    for (int nt = 0; nt < WNT; ++nt)
#pragma unroll
      for (int i = 0; i < 16; ++i) {
        int row = m0 + 64 * wm + 32 * mt + crow(i, h);
        int col = n0 + 32 * WNT * wn + 32 * nt + r;
        C[(size_t)row * ldc + col] = f2bf(acc[mt][nt][i]);
      }
}
template <int BM, int WNT>
DI void gemm_bf16_tile(const u16* A, int lda, const u16* BT, int K, u16* C, int ldc, int m0, int n0, char* lds) {
  f32x16 acc[2][WNT];
  zero_acc<WNT>(acc);
  gemm_main<BM, WNT>(A, lda, BT, K, m0, n0, lds, acc);
  store_bf16<BM, WNT>(acc, C, ldc, m0, n0);
}

DI void ph_ffn1(CP p, int f, char* smem) {
  const u16* H = (const u16*)(p->ws + O_H);
  const u16* W = (const u16*)(p->ws + O_WFFN1) + (size_t)f * 5632 * 1024;
  u16* ACT = (u16*)(p->ws + S_ACT);
  const int lane = tidx() & 63, wave = tidx() >> 6, r = lane & 31, h = lane >> 5;
  const int wm = wave >> 1, wn = wave & 1;
  for (int t = blockIdx.x; t < 130 * 44; t += gridDim.x) {
    int mt_ = t / 44, nt_ = t % 44;
    int m0 = mt_ * 256, n0 = nt_ * 128;
    f32x16 acc[2][2];
    zero_acc<2>(acc);
    gemm_main<256, 2>(H, 1024, W, 1024, m0, n0, smem, acc);
#pragma unroll
    for (int mt = 0; mt < 2; ++mt)
#pragma unroll
      for (int i = 0; i < 16; ++i) {
        float a = acc[mt][0][i], b = acc[mt][1][i];
        float v = a / (1.f + __expf(-a)) * b;
        int row = m0 + 64 * wm + 32 * mt + crow(i, h);
        int col = nt_ * 64 + 32 * wn + r;
        ACT[(size_t)row * DFF + col] = f2bf(v);
      }
  }
}
DI void ph_ffn2(CP p, int f, char* smem) {
  const u16* ACT = (const u16*)(p->ws + S_ACT);
  const u16* W = (const u16*)(p->ws + O_WFFN2) + (size_t)f * 1024 * 2816;
  u16* Y = (u16*)(p->ws + S_Y);
  for (int t = blockIdx.x; t < 260 * 8; t += gridDim.x) {
    int m0 = (t >> 3) * 128, n0 = (t & 7) * 128;
    gemm_bf16_tile<128, 1>(ACT, DFF, W, DFF, Y, 1024, m0, n0, smem);
  }
}
DI void ph_t1(CP p, char* smem) {
  const u16* H = (const u16*)(p->ws + O_H);
  const u16* W = (const u16*)(p->ws + O_WIN);
  u16* P = (u16*)(p->ws + S_P);
  for (int t = blockIdx.x; t < 130 * 24; t += gridDim.x) {
    int m0 = (t / 24) * 256, n0 = (t % 24) * 128;
    gemm_bf16_tile<256, 2>(H, 1024, W, 1024, P, PS, m0, n0, smem);
  }
}

DI void rope32(float (&x)[32], int row, int col) {
#pragma unroll
  for (int i = 0; i < 8; ++i) {
    float inv = rope_inv(i);
    float sr, cr, sc, cc;
    sincosf((float)row * inv, &sr, &cr);
    sincosf((float)col * inv, &sc, &cc);
    float a = x[i], b = x[i + 8];
    x[i] = a * cr - b * sr; x[i + 8] = b * cr + a * sr;
    float c = x[16 + i], d = x[24 + i];
    x[16 + i] = c * cc - d * sc; x[24 + i] = d * cc + c * sc;
  }
}
DI void ld32(const u16* p, float (&x)[32]) {
#pragma unroll
  for (int q = 0; q < 4; ++q) {
    uint4 v = *(const uint4*)(p + 8 * q);
    x[8 * q + 0] = __uint_as_float(v.x << 16); x[8 * q + 1] = __uint_as_float(v.x & 0xffff0000u);
    x[8 * q + 2] = __uint_as_float(v.y << 16); x[8 * q + 3] = __uint_as_float(v.y & 0xffff0000u);
    x[8 * q + 4] = __uint_as_float(v.z << 16); x[8 * q + 5] = __uint_as_float(v.z & 0xffff0000u);
    x[8 * q + 6] = __uint_as_float(v.w << 16); x[8 * q + 7] = __uint_as_float(v.w & 0xffff0000u);
  }
}
DI void st32(u16* p, const float (&x)[32]) {
#pragma unroll
  for (int q = 0; q < 4; ++q) {
    uint4 v;
    v.x = pk2(x[8 * q], x[8 * q + 1]); v.y = pk2(x[8 * q + 2], x[8 * q + 3]);
    v.z = pk2(x[8 * q + 4], x[8 * q + 5]); v.w = pk2(x[8 * q + 6], x[8 * q + 7]);
    *(uint4*)(p + 8 * q) = v;
  }
}

DI void t2a_tile(CP p, int l, int tl, char* smem) {
  const int tid = tidx();
  const int m0 = tl * 64;
  const bool lat = m0 < ML;
  int b, t0, n;
  if (lat) { b = m0 >> 14; t0 = m0 & 16383; n = 16384; } else { int mc = m0 - ML; b = mc >> 8; t0 = mc & 255; n = 256; }
  const int key0 = lat ? t0 : 16384 + t0;
  const u16* P = (const u16*)(p->ws + S_P);
  u16* Rb = (u16*)(p->ws + S_R); u16* KRAW = (u16*)(p->ws + S_KRAW); u16* Vb = (u16*)(p->ws + S_V); u16* KK = (u16*)(p->ws + S_KK);
  u16* LIN = (u16*)(p->ws + S_LIN); u16* CQN = (u16*)(p->ws + S_CQN); u16* CKVN = (u16*)(p->ws + S_CKVN);
  u16* KM = (u16*)(p->ws + S_KM); u16* QD = (u16*)(p->ws + O_QD); u16* KD = (u16*)(p->ws + O_KD); u16* VDT = (u16*)(p->ws + O_VDT);
  u16* ZT = (u16*)(p->ws + O_ZT); u16* X0T = (u16*)(p->ws + S_X0T);
  float* ZC = (float*)(p->ws + O_ZC); float* X0C = (float*)(p->ws + O_X0C);
  u16* zb = (u16*)smem;
  u16* xb = zb + 256 * 72;
  u16* vb = xb + 256 * 72;
  const float* mu = p->in[11] + l * 1152;
  const float* k_k = p->in[17] + l * 256;
#pragma unroll 1
  for (int e = 0; e < 18; ++e) {
    int it = tid + NT * e;
    int tok = it / 144, cg = it % 144;
    int t = t0 + tok, m = m0 + tok, c0 = cg * 8;
    const u16* pc = P + (size_t)m * PS + c0;
    float xc_[8], xp[8], xn[8], u[8], muv[8];
    ld8(pc, xc_);
    if (t > 0) ld8(pc - PS, xp); else {
#pragma unroll
      for (int j = 0; j < 8; ++j) xp[j] = 0.f;
    }
    if (t < n - 1) ld8(pc + PS, xn); else {
#pragma unroll
      for (int j = 0; j < 8; ++j) xn[j] = 0.f;
    }
    ld8f(mu + c0, muv);
#pragma unroll
    for (int j = 0; j < 8; ++j) u[j] = 0.5f * muv[j] * (xp[j] + xn[j]) + (1.f - muv[j]) * xc_[j];
    if (cg < 32) st8(Rb + (size_t)m * 256 + c0, u);
    else if (cg < 64) {
      int c = c0 - 256;
      st8(KRAW + (size_t)m * 256 + c, u);
      float kkv[8], kc[8];
      ld8f(k_k + c, kc);
      float ss = 0.f;
#pragma unroll
      for (int j = 0; j < 8; ++j) { kkv[j] = u[j] * kc[j]; ss += kkv[j] * kkv[j]; }
      ss = grp8_sum(ss);
      float inv = 1.f / fmaxf(sqrtf(ss), 1e-12f);
#pragma unroll
      for (int j = 0; j < 8; ++j) kkv[j] *= inv;
      st8(KK + (size_t)m * 256 + c, kkv);
    } else if (cg < 96) st8(Vb + (size_t)m * 256 + c0 - 512, u);
    else {
      int dst;
      if (cg < 112) { dst = 256 + c0 - 768;
#pragma unroll
        for (int j = 0; j < 8; ++j) u[j] = sigmoidf_(u[j]);
      } else if (cg < 120) { dst = c0 - 896;
#pragma unroll
        for (int j = 0; j < 8; ++j) u[j] = tanhf(u[j]);
      } else if (cg < 128) { dst = 128 + c0 - 960;
#pragma unroll
        for (int j = 0; j < 8; ++j) u[j] = tanhf(u[j]);
      } else if (cg < 136) dst = 64 + c0 - 1024;
      else dst = 192 + c0 - 1088;
      st8(LIN + (size_t)m * 384 + dst, u);
    }
  }
  const float* cw = p->in[22] + l * 3 * 768;
  const float* cb = p->in[23] + l * 768;
#pragma unroll 1
  for (int e = 0; e < 4; ++e) {
    int it = tid + NT * e;
    int tok = it >> 5, cg = it & 31;
    int t = t0 + tok, m = m0 + tok, c0 = cg * 8;
    float uu[3][8];
#pragma unroll
    for (int s = 0; s < 3; ++s) {
      int col = s * 256 + c0;
      const u16* pc = P + (size_t)m * PS + 1152 + col;
      float xc_[8], xp[8], xn[8], w0[8], w1[8], w2[8], bb[8];
      ld8(pc, xc_);
      if (t > 0) ld8(pc - PS, xp); else {
#pragma unroll
        for (int j = 0; j < 8; ++j) xp[j] = 0.f;
      }
      if (t < n - 1) ld8(pc + PS, xn); else {
#pragma unroll
        for (int j = 0; j < 8; ++j) xn[j] = 0.f;
      }
      ld8f(cw + col, w0); ld8f(cw + 768 + col, w1); ld8f(cw + 1536 + col, w2); ld8f(cb + col, bb);
#pragma unroll
      for (int j = 0; j < 8; ++j) uu[s][j] = xp[j] * w0[j] + xc_[j] * w1[j] + xn[j] * w2[j] + bb[j];
    }
    if (lat) {
#pragma unroll
      for (int j = 0; j < 8; ++j) {
        zb[(c0 + j) * 72 + tok] = f2bf(uu[2][j] * uu[1][j]);
        xb[(c0 + j) * 72 + tok] = f2bf(uu[0][j]);
      }
    } else {
      int mc = m - ML;
#pragma unroll
      for (int j = 0; j < 8; ++j) { ZC[mc * 256 + c0 + j] = uu[2][j] * uu[1][j]; X0C[mc * 256 + c0 + j] = uu[0][j]; }
    }
    uint4 vv = *(const uint4*)(P + (size_t)m * PS + 2784 + c0);
    const u16* vs = (const u16*)&vv;
#pragma unroll
    for (int j = 0; j < 8; ++j) vb[(c0 + j) * 72 + tok] = vs[j];
  }
  {
    int tok = tid >> 3, sub = tid & 7;
    int m = m0 + tok;
    const u16* pr = P + (size_t)m * PS;
    {
      float v[24];
#pragma unroll
      for (int q = 0; q < 3; ++q) ld8(pr + 1920 + 24 * sub + 8 * q, *(float(*)[8])&v[8 * q]);
      float ss = 0.f;
#pragma unroll
      for (int j = 0; j < 24; ++j) ss += v[j] * v[j];
      ss = grp8_sum(ss);
      float rs = rsqrtf(ss * (1.f / 192.f) + 1e-6f);
      const float* g = p->in[32] + l * 192 + 24 * sub;
#pragma unroll
      for (int q = 0; q < 3; ++q) {
        float o[8];
#pragma unroll
        for (int j = 0; j < 8; ++j) o[j] = v[8 * q + j] * rs * g[8 * q + j];
        st8(CQN + (size_t)m * 192 + 24 * sub + 8 * q, o);
      }
    }
    {
      float v[16];
#pragma unroll
      for (int q = 0; q < 2; ++q) ld8(pr + 2112 + 16 * sub + 8 * q, *(float(*)[8])&v[8 * q]);
      float ss = 0.f;
#pragma unroll
      for (int j = 0; j < 16; ++j) ss += v[j] * v[j];
      ss = grp8_sum(ss);
      float rs = rsqrtf(ss * (1.f / 128.f) + 1e-6f);
      const float* g = p->in[34] + l * 128 + 16 * sub;
#pragma unroll
      for (int q = 0; q < 2; ++q) {
        float o[8];
#pragma unroll
        for (int j = 0; j < 8; ++j) o[j] = v[8 * q + j] * rs * g[8 * q + j];
        st8(CKVN + (size_t)m * 128 + 16 * sub + 8 * q, o);
      }
    }
  }
  if (tid < 64) {
    int tok = tid, m = m0 + tok, t = t0 + tok;
    float x[32];
    ld32(P + (size_t)m * PS + 2240, x);
    if (lat) rope32(x, t >> 6, t & 63);
#pragma unroll
    for (int hh = 0; hh < 4; ++hh) st32(KM + ((size_t)(b * 4 + hh) * TK + key0 + tok) * 96 + 64, x);
  }
  {
    int tok = tid >> 3, h8 = tid & 7;
    int m = m0 + tok, t = t0 + tok;
    float x[32];
    ld32(P + (size_t)m * PS + 2272 + 32 * h8, x);
    if (lat) rope32(x, t >> 6, t & 63);
    const float sc = 0.17677669529663687f * 1.4426950408889634f;
#pragma unroll
    for (int j = 0; j < 32; ++j) x[j] *= sc;
    st32(QD + ((size_t)(b * 8 + h8) * TK + key0 + tok) * 32, x);
    ld32(P + (size_t)m * PS + 2528 + 32 * h8, x);
    if (lat) rope32(x, t >> 6, t & 63);
    st32(KD + ((size_t)(b * 8 + h8) * TK + key0 + tok) * 32, x);
  }
  __syncthreads();
#pragma unroll 1
  for (int e = 0; e < 4; ++e) {
    int id = tid + NT * e;
    int ch = id >> 3, tc8 = id & 7;
    if (lat) {
      *(uint4*)(ZT + ((size_t)ch * 2 + b) * 16384 + t0 + 8 * tc8) = *(const uint4*)(zb + ch * 72 + 8 * tc8);
      *(uint4*)(X0T + ((size_t)ch * 2 + b) * 16384 + t0 + 8 * tc8) = *(const uint4*)(xb + ch * 72 + 8 * tc8);
    }
    *(uint4*)(VDT + ((size_t)b * 256 + ch) * TK + key0 + 8 * tc8) = *(const uint4*)(vb + ch * 72 + 8 * tc8);
  }
  __syncthreads();
}

DI void ph_t2b(CP p, char* smem) {
  const u16* LIN = (const u16*)(p->ws + S_LIN);
  u16* LOUT = (u16*)(p->ws + S_LOUT);
  for (int t = blockIdx.x; t < 130 * 17; t += gridDim.x) {
    int m0 = (t / 17) * 256, j = t % 17;
    if (j < 10) {
      int g = j >> 1, n0 = (j & 1) * 128;
      const u16* A; const u16* BT; int K;
      if (g == 0) { A = LIN; BT = (const u16*)(p->ws + O_W2); K = 64; }
      else if (g == 1) { A = LIN + 64; BT = (const u16*)(p->ws + O_A2); K = 64; }
      else if (g == 2) { A = LIN + 128; BT = (const u16*)(p->ws + O_W2) + 256 * 64; K = 64; }
      else if (g == 3) { A = LIN + 192; BT = (const u16*)(p->ws + O_A2) + 256 * 64; K = 64; }
      else { A = LIN + 256; BT = (const u16*)(p->ws + O_G2); K = 128; }
      gemm_bf16_tile<256, 2>(A, 384, BT, K, LOUT + g * 256, 1280, m0, n0, smem);
    } else if (j < 13) {
      gemm_bf16_tile<256, 2>((const u16*)(p->ws + S_CQN), 192, (const u16*)(p->ws + O_WQB), 192, (u16*)(p->ws + S_QRAW), 384, m0, (j - 10) * 128, smem);
    } else {
      gemm_bf16_tile<256, 2>((const u16*)(p->ws + S_CKVN), 128, (const u16*)(p->ws + O_WKVB), 128, (u16*)(p->ws + S_KVRAW), 512, m0, (j - 13) * 128, smem);
    }
  }
}

DI void t2c_tile(CP p, int l, int tl, char* smem) {
  const int tid = tidx();
  const int m0 = tl * 64;
  const bool lat = m0 < ML;
  int b, t0;
  if (lat) { b = m0 >> 14; t0 = m0 & 16383; } else { int mc = m0 - ML; b = mc >> 8; t0 = mc & 255; }
  const int key0 = lat ? t0 : 16384 + t0;
  const u16* QRAW = (const u16*)(p->ws + S_QRAW);
  const u16* KVRAW = (const u16*)(p->ws + S_KVRAW);
  u16* QM = (u16*)(p->ws + S_QM); u16* KM = (u16*)(p->ws + S_KM); u16* VMT = (u16*)(p->ws + S_VMT);
  u16* vb = (u16*)smem;
  if (tid < 256) {
    int tok = tid >> 2, hh = tid & 3;
    int m = m0 + tok, t = t0 + tok;
    const u16* src = QRAW + (size_t)m * 384 + 96 * hh;
    u16* dst = QM + ((size_t)(b * 4 + hh) * TK + key0 + tok) * 96;
    const float sc = 0.10206207261596577f * 1.4426950408889634f;
#pragma unroll
    for (int q = 0; q < 8; ++q) {
      float v[8];
      ld8(src + 8 * q, v);
#pragma unroll
      for (int j = 0; j < 8; ++j) v[j] *= sc;
      st8(dst + 8 * q, v);
    }
    float x[32];
    ld32(src + 64, x);
    if (lat) rope32(x, t >> 6, t & 63);
#pragma unroll
    for (int j = 0; j < 32; ++j) x[j] *= sc;
    st32(dst + 64, x);
  }
  {
    int tok = tid >> 3, hh = (tid >> 1) & 3, part = tid & 1;
    int m = m0 + tok;
    const u16* src = KVRAW + (size_t)m * 512 + 128 * hh + 64 * part;
    if (part == 0) {
      u16* dst = KM + ((size_t)(b * 4 + hh) * TK + key0 + tok) * 96;
#pragma unroll
      for (int q = 0; q < 8; ++q) *(uint4*)(dst + 8 * q) = *(const uint4*)(src + 8 * q);
    } else {
#pragma unroll
      for (int q = 0; q < 8; ++q) {
        uint4 vv = *(const uint4*)(src + 8 * q);
        const u16* vs = (const u16*)&vv;
#pragma unroll
        for (int j = 0; j < 8; ++j) vb[(64 * hh + 8 * q + j) * 72 + tok] = vs[j];
      }
    }
  }
  __syncthreads();
#pragma unroll 1
  for (int e = 0; e < 4; ++e) {
    int id = tid + NT * e;
    int ch = id >> 3, tc8 = id & 7;
    *(uint4*)(VMT + ((size_t)b * 256 + ch) * TK + key0 + 8 * tc8) = *(const uint4*)(vb + ch * 72 + 8 * tc8);
  }
  __syncthreads();
}

template <int DQK>
DI void attn_pass(const u16* __restrict__ Qp, const u16* __restrict__ Kp, const u16* __restrict__ VTp, int kt0, int nkt,
                  char* lds, f32x16 (&o)[2], float& lsum) {
  constexpr int KS = DQK / 16;
  constexpr int KROW = DQK * 2 + 16;
  constexpr int KCH = DQK / 8;
  constexpr int NKC = 64 * KCH;
  constexpr int STG = 64 * KROW + 64 * 144;
  const int tid = tidx(), lane = tid & 63, wave = tid >> 6, r = lane & 31, h = lane >> 5;
  bf16x8 qf[KS];
#pragma unroll
  for (int s = 0; s < KS; ++s) qf[s] = *(const bf16x8*)(Qp + (size_t)(32 * wave + r) * DQK + 16 * s + 8 * h);
#pragma unroll
  for (int dt = 0; dt < 2; ++dt)
#pragma unroll
    for (int i = 0; i < 16; ++i) o[dt][i] = 0.f;
  float mrun = -1e30f;
  lsum = 0.f;
  const int kq0 = tid, kq1 = tid + NT;
  const bool has1 = kq1 < NKC, has0 = kq0 < NKC;
  const int kr0 = kq0 / KCH, kc0 = kq0 % KCH, kr1 = kq1 / KCH, kc1 = kq1 % KCH;
  const int vr = tid >> 3, vc = tid & 7;
  uint4 rk0 = make_uint4(0, 0, 0, 0), rk1 = make_uint4(0, 0, 0, 0), rv;
  {
    const int key0 = kt0 * 64;
    if (has0) rk0 = *(const uint4*)(Kp + (size_t)(key0 + kr0) * DQK + kc0 * 8);
    if (has1) rk1 = *(const uint4*)(Kp + (size_t)(key0 + kr1) * DQK + kc1 * 8);
    rv = *(const uint4*)(VTp + (size_t)vr * TK + key0 + vc * 8);
  }
  __syncthreads();
  if (has0) *(uint4*)(lds + kr0 * KROW + kc0 * 16) = rk0;
  if (has1) *(uint4*)(lds + kr1 * KROW + kc1 * 16) = rk1;
  *(uint4*)(lds + 64 * KROW + vr * 144 + vc * 16) = rv;
  __syncthreads();
#pragma unroll 1
  for (int kt = 0; kt < nkt; ++kt) {
    const bool more = kt + 1 < nkt;
    if (more) {
      const int key0 = (kt0 + kt + 1) * 64;
      if (has0) rk0 = *(const uint4*)(Kp + (size_t)(key0 + kr0) * DQK + kc0 * 8);
      if (has1) rk1 = *(const uint4*)(Kp + (size_t)(key0 + kr1) * DQK + kc1 * 8);
      rv = *(const uint4*)(VTp + (size_t)vr * TK + key0 + vc * 8);
    }
    const char* sK = lds + (kt & 1) * STG;
    const char* sV = sK + 64 * KROW;
    f32x16 sacc[2];
#pragma unroll
    for (int mt = 0; mt < 2; ++mt) {
#pragma unroll
      for (int i = 0; i < 16; ++i) sacc[mt][i] = 0.f;
#pragma unroll
      for (int s = 0; s < KS; ++s) {
        bf16x8 a = *(const bf16x8*)(sK + (32 * mt + r) * KROW + 32 * s + 16 * h);
        sacc[mt] = MFMA32(a, qf[s], sacc[mt]);
      }
    }
    float mloc = sacc[0][0];
#pragma unroll
    for (int i = 1; i < 16; ++i) mloc = fmaxf(mloc, sacc[0][i]);
#pragma unroll
    for (int i = 0; i < 16; ++i) mloc = fmaxf(mloc, sacc[1][i]);
    mloc = fmaxf(mloc, __shfl_xor(mloc, 32));
    const float mnew = fmaxf(mrun, mloc);
    const float alpha = __builtin_amdgcn_exp2f(mrun - mnew);
    mrun = mnew;
    float ps = 0.f;
#pragma unroll
    for (int mt = 0; mt < 2; ++mt)
#pragma unroll
      for (int i = 0; i < 16; ++i) { float pv = __builtin_amdgcn_exp2f(sacc[mt][i] - mnew); sacc[mt][i] = pv; ps += pv; }
    lsum = lsum * alpha + ps;
#pragma unroll
    for (int dt = 0; dt < 2; ++dt)
#pragma unroll
      for (int i = 0; i < 16; ++i) o[dt][i] *= alpha;
#pragma unroll
    for (int mt = 0; mt < 2; ++mt)
#pragma unroll
      for (int s2 = 0; s2 < 2; ++s2) {
        uint4 pw;
        pw.x = pk2(sacc[mt][8 * s2 + 0], sacc[mt][8 * s2 + 1]);
        pw.y = pk2(sacc[mt][8 * s2 + 2], sacc[mt][8 * s2 + 3]);
        pw.z = pk2(sacc[mt][8 * s2 + 4], sacc[mt][8 * s2 + 5]);
        pw.w = pk2(sacc[mt][8 * s2 + 6], sacc[mt][8 * s2 + 7]);
        bf16x8 pb = __builtin_bit_cast(bf16x8, pw);
#pragma unroll
        for (int dt = 0; dt < 2; ++dt) {
          const char* vp = sV + (32 * dt + r) * 144 + (32 * mt + 16 * s2 + 4 * h) * 2;
          s16x4 lo = *(const s16x4*)vp;
          s16x4 hi = *(const s16x4*)(vp + 16);
          bf16x8 va = __builtin_shufflevector(lo, hi, 0, 1, 2, 3, 4, 5, 6, 7);
          o[dt] = MFMA32(va, pb, o[dt]);
        }
      }
    if (more) {
      char* sn = lds + ((kt + 1) & 1) * STG;
      if (has0) *(uint4*)(sn + kr0 * KROW + kc0 * 16) = rk0;
      if (has1) *(uint4*)(sn + kr1 * KROW + kc1 * 16) = rk1;
      *(uint4*)(sn + 64 * KROW + vr * 144 + vc * 16) = rv;
    }
    __syncthreads();
  }
  lsum += __shfl_xor(lsum, 32);
}

DI void mla_item(CP p, int b, int hh, int qt, char* smem) {
  const u16* QM = (const u16*)(p->ws + S_QM);
  const u16* KM = (const u16*)(p->ws + S_KM);
  const u16* VMT = (const u16*)(p->ws + S_VMT);
  u16* OALL = (u16*)(p->ws + S_OALL);
  const bool ctx = qt == 64;
  const int q0 = ctx ? 16384 : qt * 256;
  const size_t hb = (size_t)(b * 4 + hh);
  f32x16 o[2]; float l;
  attn_pass<96>(QM + (hb * TK + q0) * 96, KM + hb * TK * 96, VMT + hb * 64 * TK, ctx ? 256 : 0, ctx ? 4 : 260, smem, o, l);
  const int lane = tidx() & 63, wave = tidx() >> 6, r = lane & 31, h = lane >> 5;
  const int q = 32 * wave + r;
  const int m = ctx ? (ML + b * 256 + q) : (b * 16384 + q0 + q);
  const float il = 1.f / l;
#pragma unroll
  for (int dt = 0; dt < 2; ++dt)
#pragma unroll
    for (int g = 0; g < 4; ++g) {
      uint2 w;
      w.x = pk2(o[dt][4 * g] * il, o[dt][4 * g + 1] * il);
      w.y = pk2(o[dt][4 * g + 2] * il, o[dt][4 * g + 3] * il);
      *(uint2*)(OALL + (size_t)m * 1024 + 512 + 64 * hh + 32 * dt + 8 * g + 4 * h) = w;
    }
}
DI void diff_item(CP p, int l_, int b, int hd, int qt, char* smem) {
  const u16* QD = (const u16*)(p->ws + O_QD);
  const u16* KD = (const u16*)(p->ws + O_KD);
  const u16* VDT = (const u16*)(p->ws + O_VDT);
  u16* OALL = (u16*)(p->ws + S_OALL);
  const bool ctx = qt == 64;
  const int q0 = ctx ? 16384 : qt * 256;
  const int kt0 = ctx ? 256 : 0, nkt = ctx ? 4 : 260;
  const u16* VT = VDT + (size_t)(b * 4 + hd) * 64 * TK;
  f32x16 o1[2], o2[2]; float l1, l2;
  {
    const size_t hb = (size_t)(b * 8 + 2 * hd);
    attn_pass<32>(QD + (hb * TK + q0) * 32, KD + hb * TK * 32, VT, kt0, nkt, smem, o1, l1);
  }
  {
    const size_t hb = (size_t)(b * 8 + 2 * hd + 1);
    attn_pass<32>(QD + (hb * TK + q0) * 32, KD + hb * TK * 32, VT, kt0, nkt, smem, o2, l2);
  }
  float s1 = 0.f, s2 = 0.f;
  for (int j = 0; j < 32; ++j) {
    s1 += p->in[36][l_ * 32 + j] * p->in[37][l_ * 32 + j];
    s2 += p->in[38][l_ * 32 + j] * p->in[39][l_ * 32 + j];
  }
  const float li = lam_init_of(l_);
  const float lam = expf(s1) - expf(s2) + li;
  const float i1 = 1.f / l1, i2 = lam / l2;
  float ss = 0.f;
#pragma unroll
  for (int dt = 0; dt < 2; ++dt)
#pragma unroll
    for (int i = 0; i < 16; ++i) { float v = o1[dt][i] * i1 - o2[dt][i] * i2; o1[dt][i] = v; ss += v * v; }
  ss += __shfl_xor(ss, 32);
  const float rs = rsqrtf(ss * (1.f / 64.f) + 1e-5f) * (1.f - li);
  const int lane = tidx() & 63, wave = tidx() >> 6, r = lane & 31, h = lane >> 5;
  const int q = 32 * wave + r;
  const int m = ctx ? (ML + b * 256 + q) : (b * 16384 + q0 + q);
  const float* sub = p->in[40] + l_ * 64;
#pragma unroll
  for (int dt = 0; dt < 2; ++dt)
#pragma unroll
    for (int g = 0; g < 4; ++g) {
      int dv = 32 * dt + 8 * g + 4 * h;
      float4 sg = *(const float4*)(sub + dv);
      uint2 w;
      w.x = pk2(o1[dt][4 * g] * rs * sg.x, o1[dt][4 * g + 1] * rs * sg.y);
      w.y = pk2(o1[dt][4 * g + 2] * rs * sg.z, o1[dt][4 * g + 3] * rs * sg.w);
      *(uint2*)(OALL + (size_t)m * 1024 + 768 + 64 * hd + dv) = w;
    }
}

DI void hyena_item(CP p, int l, int c, char* smem) {
  const int tid = tidx(), lane = tid & 63, wave = tid >> 6, r = lane & 31, h = lane >> 5;
  u16* zl = (u16*)smem;
  char* cp = smem + 2 * 128 * 136 * 2;
  float* red = (float*)(cp + 2 * 2 * 8 * 544);
  const u16* ZT = (const u16*)(p->ws + O_ZT) + (size_t)c * 2 * 16384;
  const u16* X0T = (const u16*)(p->ws + S_X0T) + (size_t)c * 2 * 16384;
  u16* OHT = (u16*)(p->ws + S_OHT) + (size_t)c * 2 * 16384;
  const u16* rkg = (const u16*)(p->ws + O_RKG) + (size_t)c * RKROW;
  __syncthreads();
#pragma unroll
  for (int e = 0; e < 8; ++e) {
    int q = tid + NT * e;
    int bb = q >> 11, t8 = (q & 2047) * 8;
    *(uint4*)(zl + (bb * 128 + (t8 >> 7)) * 136 + (t8 & 127)) = *(const uint4*)(ZT + (size_t)bb * 16384 + t8);
  }
  {
    const float* part = (const float*)(p->ws + O_HPART);
    float v = part[(tid >> 1) * 512 + (tid & 1) * 256 + c];
    v = wave_sum(v);
    if (lane == 0) red[wave] = v;
  }
  const int cwin = tid >> 8, co = (tid >> 5) & 7, cq = tid & 31;
  uint4 cr;
  {
    const int bx = -128 + cwin * 16384;
    __builtin_memcpy(&cr, rkg + OFFC + bx + co + 8 * cq, 16);
  }
  *(uint4*)(cp + ((0 * 2 + cwin) * 8 + co) * 544 + 16 * cq) = cr;
  __syncthreads();
  float rn = 0.f;
#pragma unroll
  for (int q = 0; q < 8; ++q) rn += red[q];
  rn = rsqrtf(rn);
  const int mt = wave & 3, bb = wave >> 2;
  const int i_ = 32 * mt + r;
  const int o_ = (-i_) & 7;
  f32x16 acc[4];
#pragma unroll
  for (int at = 0; at < 4; ++at)
#pragma unroll
    for (int i = 0; i < 16; ++i) acc[at][i] = 0.f;
  const bf16x8 zero8 = {0, 0, 0, 0, 0, 0, 0, 0};
#pragma unroll 1
  for (int dl = 0; dl < 128; ++dl) {
    if (dl + 1 < 128) {
      const int bx = -128 * (dl + 1) - 128 + cwin * 16384;
      __builtin_memcpy(&cr, rkg + OFFC + bx + co + 8 * cq, 16);
    }
    const char* chi = cp + (((dl & 1) * 2 + 0) * 8 + o_) * 544;
    const char* clo = cp + (((dl & 1) * 2 + 1) * 8 + o_) * 544;
#pragma unroll
    for (int s = 0; s < 8; ++s) {
      const int j = 16 * s + 8 * h;
      const int q = (j - i_ + 128 - o_) >> 3;
      bf16x8 ahi = *(const bf16x8*)(chi + 16 * q);
      bf16x8 alo = *(const bf16x8*)(clo + 16 * q);
#pragma unroll
      for (int at = 0; at < 4; ++at) {
        const int a = 32 * at + r;
        const int ap = (a - dl) & 127;
        bf16x8 bf = *(const bf16x8*)(zl + (bb * 128 + ap) * 136 + j);
        if (32 * at >= dl) acc[at] = MFMA32(ahi, bf, acc[at]);
        else if (32 * at + 31 < dl) acc[at] = MFMA32(alo, bf, acc[at]);
        else {
          bf16x8 b1 = (a >= dl) ? bf : zero8;
          bf16x8 b2 = (a >= dl) ? zero8 : bf;
          acc[at] = MFMA32(ahi, b1, acc[at]);
          acc[at] = MFMA32(alo, b2, acc[at]);
        }
      }
    }
    if (dl + 1 < 128) *(uint4*)(cp + ((((dl + 1) & 1) * 2 + cwin) * 8 + co) * 544 + 16 * cq) = cr;
    __syncthreads();
  }
  const float bias = p->in[31][l * 256 + c];
#pragma unroll
  for (int at = 0; at < 4; ++at) {
    const int a = 32 * at + r;
#pragma unroll
    for (int g = 0; g < 4; ++g) {
      const int il = 32 * mt + 8 * g + 4 * h;
      const int t = 128 * a + il;
      uint2 zz = *(const uint2*)(zl + (bb * 128 + a) * 136 + il);
      uint2 xx = *(const uint2*)(X0T + (size_t)bb * 16384 + t);
      float z0 = __uint_as_float(zz.x << 16), z1 = __uint_as_float(zz.x & 0xffff0000u);
      float z2 = __uint_as_float(zz.y << 16), z3 = __uint_as_float(zz.y & 0xffff0000u);
      float x0 = __uint_as_float(xx.x << 16), x1 = __uint_as_float(xx.x & 0xffff0000u);
      float x2 = __uint_as_float(xx.y << 16), x3 = __uint_as_float(xx.y & 0xffff0000u);
      uint2 w;
      w.x = pk2(x0 * (acc[at][4 * g] * rn + z0 * bias), x1 * (acc[at][4 * g + 1] * rn + z1 * bias));
      w.y = pk2(x2 * (acc[at][4 * g + 2] * rn + z2 * bias), x3 * (acc[at][4 * g + 3] * rn + z3 * bias));
      *(uint2*)(OHT + (size_t)bb * 16384 + t) = w;
    }
  }
  __syncthreads();
}

DI void scan_item(CP p, int l, int si, char* smem) {
  const int tid = tidx(), lane = tid & 63, wave = tid >> 6;
  const int half = si & 1, dir = (si >> 1) & 1, hh = (si >> 2) & 3, b = si >> 4;
  const u16* Rb = (const u16*)(p->ws + S_R); const u16* KRAW = (const u16*)(p->ws + S_KRAW);
  const u16* Vb = (const u16*)(p->ws + S_V); const u16* KK = (const u16*)(p->ws + S_KK);
  const u16* LOUT = (const u16*)(p->ws + S_LOUT);
  u16* Yo = (u16*)(p->ws + (dir ? S_YB : S_YF));
  constexpr int BUF = 44 * 1024;
  const int rowl = lane >> 4, jl = lane & 15;
  const int il = 4 * wave + rowl;
  const bool ld_main = tid < 256, ld_v = (tid >= 256 && tid < 384);
  const int lst = ld_main ? (tid >> 3) : ((tid - 256) >> 2);
  const int lcg = ld_main ? (tid & 7) : ((tid - 256) & 3);
  float w0v[8], a0v[8], kav[8];
  {
    const int lc = ld_main ? lcg : 0;
    ld8f(p->in[12] + (l * 2 + dir) * 256 + 64 * hh + 8 * lc, w0v);
    ld8f(p->in[14] + (l * 2 + dir) * 256 + 64 * hh + 8 * lc, a0v);
    ld8f(p->in[18] + l * 256 + 64 * hh + 8 * lc, kav);
  }
#define SCAN_ROW(s_) (((s_) < 256) ? (ML + b * 256 + (dir ? 255 - (s_) : (s_))) : (b * 16384 + (dir ? 16383 - ((s_) - 256) : ((s_) - 256))))
  uint4 q0 = make_uint4(0, 0, 0, 0), q1 = q0, q2 = q0, q3 = q0, q4 = q0;
#define SCAN_ISSUE(ch_)                                                                                  \
  {                                                                                                      \
    const int s__ = 32 * (ch_) + lst;                                                                    \
    const int m__ = SCAN_ROW(s__);                                                                       \
    if (ld_main) {                                                                                       \
      const size_t o__ = (size_t)m__ * 256 + 64 * hh + 8 * lcg;                                          \
      q0 = *(const uint4*)(Rb + o__); q1 = *(const uint4*)(KRAW + o__); q2 = *(const uint4*)(KK + o__);  \
      q3 = *(const uint4*)(LOUT + (size_t)m__ * 1280 + dir * 512 + 64 * hh + 8 * lcg);                   \
      q4 = *(const uint4*)(LOUT + (size_t)m__ * 1280 + dir * 512 + 256 + 64 * hh + 8 * lcg);             \
    } else if (ld_v) {                                                                                   \
      q0 = *(const uint4*)(Vb + (size_t)m__ * 256 + 64 * hh + 32 * half + 8 * lcg);                      \
    }                                                                                                    \
  }
#define SCAN_COMMIT(bufi_)                                                                               \
  {                                                                                                      \
    float* base__ = (float*)(smem + (bufi_) * BUF);                                                      \
    if (ld_main) {                                                                                       \
      float rr[8], kr[8], kk[8], wl[8], al[8];                                                           \
      unpack8(q0, rr); unpack8(q1, kr); unpack8(q2, kk); unpack8(q3, wl); unpack8(q4, al);               \
      float* d__ = base__ + lst * 64 + 8 * lcg;                                                          \
      _Pragma("unroll") for (int j = 0; j < 8; ++j) {                                                    \
        float y = -(w0v[j] + wl[j]);                                                                     \
        float sp = fmaxf(y, 0.f) + log1pf(expf(-fabsf(y)));                                              \
        float wlog = -sp - 0.5f;                                                                         \
        float a = sigmoidf_(a0v[j] + al[j]);                                                             \
        d__[j] = expf(-expf(wlog));                                                                      \
        d__[2048 + j] = kr[j] * (1.f + (a - 1.f) * kav[j]);                                              \
        d__[4096 + j] = -kk[j];                                                                          \
        d__[6144 + j] = kk[j] * a;                                                                       \
        d__[8192 + j] = rr[j];                                                                           \
      }                                                                                                  \
    } else if (ld_v) {                                                                                   \
      float vv[8];                                                                                       \
      unpack8(q0, vv);                                                                                   \
      float* d__ = base__ + 5 * 2048 + lst * 32 + 8 * lcg;                                               \
      _Pragma("unroll") for (int j = 0; j < 8; ++j) d__[j] = vv[j];                                      \
    }                                                                                                    \
  }
  __syncthreads();
  SCAN_ISSUE(0)
  SCAN_COMMIT(0)
  __syncthreads();
  float S0 = 0.f, S1 = 0.f, S2 = 0.f, S3 = 0.f;
#pragma unroll 1
  for (int ch = 0; ch < 520; ++ch) {
    const bool more = ch + 1 < 520;
    if (more) SCAN_ISSUE(ch + 1)
    const float* base = (const float*)(smem + (ch & 1) * BUF);
#pragma unroll 4
    for (int st = 0; st < 32; ++st) {
      const float* sp = base + st * 64 + 4 * jl;
      float4 w4 = *(const float4*)(sp);
      float4 k4 = *(const float4*)(sp + 2048);
      float4 n4 = *(const float4*)(sp + 4096);
      float4 b4 = *(const float4*)(sp + 6144);
      float4 r4 = *(const float4*)(sp + 8192);
      float vi = base[5 * 2048 + st * 32 + il];
      float sa = S0 * n4.x + S1 * n4.y + S2 * n4.z + S3 * n4.w;
      sa = dpp_sum16(sa);
      S0 = S0 * w4.x + sa * b4.x + vi * k4.x;
      S1 = S1 * w4.y + sa * b4.y + vi * k4.y;
      S2 = S2 * w4.z + sa * b4.z + vi * k4.z;
      S3 = S3 * w4.w + sa * b4.w + vi * k4.w;
      float y = S0 * r4.x + S1 * r4.y + S2 * r4.z + S3 * r4.w;
      y = dpp_sum16(y);
      if (jl == 0) {
        const int s2 = 32 * ch + st;
        const int m = SCAN_ROW(s2);
        Yo[(size_t)m * 256 + 64 * hh + 32 * half + il] = f2bf(y);
      }
    }
    if (more) SCAN_COMMIT((ch + 1) & 1)
    __syncthreads();
  }
}

constexpr int T3_SCAN = 32, T3_DIFF = 8 * 65, T3_MLA = 8 * 65, T3_HY = 256;
constexpr int T3_TOTAL = T3_SCAN + T3_DIFF + T3_MLA + T3_HY;
DI void ph_t3(CP p, int l, char* smem, int* s_item) {
  u32* cnt = (u32*)(p->ws + O_CNT) + l;
  for (;;) {
    __syncthreads();
    if (tidx() == 0) *s_item = (int)atomicAdd(cnt, 1u);
    __syncthreads();
    int it = *s_item;
    if (it >= T3_TOTAL) break;
    if (it < T3_SCAN) { if (T3_ON(0)) scan_item(p, l, it, smem); }
    else if (it < T3_SCAN + T3_DIFF) {
      int j = it - T3_SCAN;
      int bh = j / 65, qt = j % 65;
      if (T3_ON(1)) diff_item(p, l, bh >> 2, bh & 3, qt, smem);
    } else if (it < T3_SCAN + T3_DIFF + T3_MLA) {
      int j = it - T3_SCAN - T3_DIFF;
      int bh = j / 65, qt = j % 65;
      if (T3_ON(2)) mla_item(p, bh >> 2, bh & 3, qt, smem);
    } else if (T3_ON(3)) hyena_item(p, l, it - T3_SCAN - T3_DIFF - T3_MLA, smem);
  }
}

DI void t4_tile(CP p, int l, int tl, char* smem) {
  const int tid = tidx();
  const int m0 = tl * 64;
  const bool lat = m0 < ML;
  int b, t0;
  if (lat) { b = m0 >> 14; t0 = m0 & 16383; } else { int mc = m0 - ML; b = mc >> 8; t0 = mc & 255; }
  const u16* Rb = (const u16*)(p->ws + S_R); const u16* KRAW = (const u16*)(p->ws + S_KRAW); const u16* Vb = (const u16*)(p->ws + S_V);
  const u16* LOUT = (const u16*)(p->ws + S_LOUT);
  const u16* YF = (const u16*)(p->ws + S_YF); const u16* YB = (const u16*)(p->ws + S_YB);
  u16* OALL = (u16*)(p->ws + S_OALL);
#pragma unroll 1
  for (int e = 0; e < 4; ++e) {
    int it = tid + NT * e;
    int tok = it >> 5, hh = (it >> 3) & 3, sub = it & 7;
    int m = m0 + tok, c0 = 64 * hh + 8 * sub;
    float yf[8], yb[8], y[8];
    ld8(YF + (size_t)m * 256 + c0, yf); ld8(YB + (size_t)m * 256 + c0, yb);
    float s = 0.f;
#pragma unroll
    for (int j = 0; j < 8; ++j) { y[j] = yf[j] + yb[j]; s += y[j]; }
    float mean = grp8_sum(s) * (1.f / 64.f);
    float vs = 0.f;
#pragma unroll
    for (int j = 0; j < 8; ++j) { float d = y[j] - mean; vs += d * d; }
    float var = grp8_sum(vs) * (1.f / 64.f);
    float rs = rsqrtf(var + 64e-5f);
    float rr[8], kr[8], vv[8], alf[8], alb[8], gg[8], a0f[8], a0b[8], ka[8], rk[8], lw[8], lb[8];
    ld8(Rb + (size_t)m * 256 + c0, rr); ld8(KRAW + (size_t)m * 256 + c0, kr); ld8(Vb + (size_t)m * 256 + c0, vv);
    ld8(LOUT + (size_t)m * 1280 + 256 + c0, alf); ld8(LOUT + (size_t)m * 1280 + 768 + c0, alb); ld8(LOUT + (size_t)m * 1280 + 1024 + c0, gg);
    ld8f(p->in[14] + (l * 2 + 0) * 256 + c0, a0f); ld8f(p->in[14] + (l * 2 + 1) * 256 + c0, a0b);
    ld8f(p->in[18] + l * 256 + c0, ka); ld8f(p->in[19] + l * 256 + c0, rk);
    ld8f(p->in[20] + l * 256 + c0, lw); ld8f(p->in[21] + l * 256 + c0, lb);
    float bs = 0.f;
#pragma unroll
    for (int j = 0; j < 8; ++j) {
      float af = sigmoidf_(a0f[j] + alf[j]), ab = sigmoidf_(a0b[j] + alb[j]);
      float kf = kr[j] * (1.f + (af - 1.f) * ka[j]), kb = kr[j] * (1.f + (ab - 1.f) * ka[j]);
      bs += rr[j] * rk[j] * (kf + kb);
    }
    bs = grp8_sum(bs);
    float o[8];
#pragma unroll
    for (int j = 0; j < 8; ++j) o[j] = ((y[j] - mean) * rs * lw[j] + lb[j] + bs * vv[j]) * gg[j];
    st8(OALL + (size_t)m * 1024 + c0, o);
  }
  if (lat) {
    const u16* OHT = (const u16*)(p->ws + S_OHT);
    u16* tb = (u16*)smem;
#pragma unroll 1
    for (int e = 0; e < 4; ++e) {
      int id = tid + NT * e;
      int ch = id >> 3, tc8 = id & 7;
      uint4 vv = *(const uint4*)(OHT + ((size_t)ch * 2 + b) * 16384 + t0 + 8 * tc8);
      const u16* vs = (const u16*)&vv;
#pragma unroll
      for (int j = 0; j < 8; ++j) tb[(8 * tc8 + j) * 264 + ch] = vs[j];
    }
    __syncthreads();
#pragma unroll 1
    for (int e = 0; e < 4; ++e) {
      int id = tid + NT * e;
      int tok = id >> 5, cg = id & 31;
      *(uint4*)(OALL + (size_t)(m0 + tok) * 1024 + 256 + 8 * cg) = *(const uint4*)(tb + tok * 264 + 8 * cg);
    }
    __syncthreads();
  } else {
    const float* ZC = (const float*)(p->ws + O_ZC);
    const float* X0C = (const float*)(p->ws + O_X0C);
    const float* hfc = (const float*)(p->ws + O_HFC);
    const float* part = (const float*)(p->ws + O_HPART);
    const int c = tid & 255, hf = tid >> 8;
    float nrm = 0.f;
    for (int i = 0; i < 4; ++i) nrm += part[(256 + i) * 512 + c] + part[(256 + i) * 512 + 256 + c];
    const float rn = rsqrtf(nrm);
    const float bias = p->in[31][l * 256 + c];
    float acc[32];
#pragma unroll
    for (int j = 0; j < 32; ++j) acc[j] = 0.f;
    const int tb0 = t0 + hf * 32;
#pragma unroll 1
    for (int s = 0; s < 256; ++s) {
      float z = ZC[(b * 256 + s) * 256 + c];
#pragma unroll
      for (int j = 0; j < 32; ++j) {
        int d = tb0 + j - s;
        float kf = (d >= 0) ? hfc[d * 512 + c] : hfc[(-d - 1) * 512 + 256 + c];
        acc[j] += kf * z;
      }
    }
#pragma unroll
    for (int j = 0; j < 32; ++j) {
      int t = tb0 + j;
      int mc = b * 256 + t;
      float z = ZC[mc * 256 + c], x0 = X0C[mc * 256 + c];
      OALL[(size_t)(ML + mc) * 1024 + 256 + c] = f2bf(x0 * (acc[j] * rn + z * bias));
    }
  }
  {
    const int wave = tid >> 6;
    const float* MOD = (const float*)(p->ws + O_MOD);
    for (int q = 0; q < 8; ++q) {
      int m = m0 + wave * 8 + q;
      const float* modl = MOD + (size_t)l * 27648 + mod_index(m) * 9216;
      const float* xs = (m < ML) ? p->out + (size_t)m * 1024 : (const float*)(p->ws + O_XC) + (size_t)(m - ML) * 1024;
      row_op(p, m, xs, nullptr, nullptr, nullptr, nullptr, 0, 0.f, p->in[6] + (size_t)(l * 3 + 1) * 1024, modl, 1, (u16*)(p->ws + O_H));
    }
  }
}

DI void ph_t5(CP p, int l, char* smem) {
  const u16* H = (const u16*)(p->ws + O_H);
  const u16* OALL = (const u16*)(p->ws + S_OALL);
  u16* ACCM = (u16*)(p->ws + S_ACCM);
  const int lane = tidx() & 63, wave = tidx() >> 6, r = lane & 31;
  const int wn = wave & 3;
  for (int t = blockIdx.x; t < 260 * 8; t += gridDim.x) {
    int m0 = (t >> 3) * 128, n0 = (t & 7) * 128;
    f32x16 accs[2][1];
    zero_acc<1>(accs);
#pragma unroll 1
    for (int n = 0; n < 4; ++n) {
      f32x16 g[2][1], u[2][1];
      zero_acc<1>(g);
      gemm_main<128, 1>(H, 1024, (const u16*)(p->ws + O_WGATE) + (size_t)n * 1024 * 1024, 1024, m0, n0, smem, g);
      float bg = p->in[43][(size_t)(l * 4 + n) * 1024 + n0 + 32 * wn + r];
#pragma unroll
      for (int mt = 0; mt < 2; ++mt)
#pragma unroll
        for (int i = 0; i < 16; ++i) g[mt][0][i] = 1.f / (1.f + __expf(-(g[mt][0][i] + bg)));
      zero_acc<1>(u);
      gemm_main<128, 1>(OALL + 256 * n, 1024, (const u16*)(p->ws + O_WUP) + (size_t)n * 1024 * 256, 256, m0, n0, smem, u);
#pragma unroll
      for (int mt = 0; mt < 2; ++mt)
#pragma unroll
        for (int i = 0; i < 16; ++i) accs[mt][0][i] += g[mt][0][i] * u[mt][0][i];
    }
    store_bf16<128, 1>(accs, ACCM, 1024, m0, n0);
  }
}
DI void ph_t6(CP p, char* smem) {
  for (int t = blockIdx.x; t < 260 * 8; t += gridDim.x) {
    int m0 = (t >> 3) * 128, n0 = (t & 7) * 128;
    gemm_bf16_tile<128, 1>((const u16*)(p->ws + S_ACCM), 1024, (const u16*)(p->ws + O_WO), 1024, (u16*)(p->ws + S_YM), 1024, m0, n0, smem);
  }
}

__global__ void __launch_bounds__(NT) mega(Params p_) {
  __shared__ __attribute__((aligned(16))) char smem[SMEM];
  __shared__ int s_item;
  cg::grid_group grid = cg::this_grid();
  const int ph0 = p_.ph0, ph1 = p_.ph1;
  CP p = (CP)__builtin_amdgcn_kernarg_segment_ptr();
  for (int ph = ph0; ph < ph1; ++ph) {
    asm volatile("" : "+s"(p));
    if (ph == 0) { if (PH_ON(16)) ph_prep(p, smem); }
    else {
      const int l = (ph - 1) >> 4, k = (ph - 1) & 15;
      switch (k) {
        case 0: if (PH_ON(0)) {
          const int nrow = (l == 0) ? (M / 8) : 0;
          const int total = CVT_TOTAL + 260 + nrow;
          for (int it = blockIdx.x; it < total; it += gridDim.x) {
            if (it < CVT_TOTAL) cvt_tile(p, l, it, smem);
            else if (it < CVT_TOTAL + 260) filt_item(p, l, it - CVT_TOTAL, smem);
            else row_dispatch(p, 0, 0, (it - CVT_TOTAL - 260) * 8 + (tidx() >> 6));
          }
        } break;
        case 1: if (PH_ON(1)) ph_ffn1(p, 0, smem); break;
        case 2: if (PH_ON(2)) ph_ffn2(p, 0, smem); break;
        case 3: if (PH_ON(3)) ph_rows(p, l, 1); break;
        case 4: if (PH_ON(4)) ph_t1(p, smem); break;
        case 5: if (PH_ON(5)) for (int t = blockIdx.x; t < 520; t += gridDim.x) t2a_tile(p, l, t, smem); break;
        case 6: if (PH_ON(6)) ph_t2b(p, smem); break;
        case 7: if (PH_ON(7)) for (int t = blockIdx.x; t < 520; t += gridDim.x) t2c_tile(p, l, t, smem); break;
        case 8: if (PH_ON(8)) ph_t3(p, l, smem, &s_item); break;
        case 9: if (PH_ON(9)) for (int t = blockIdx.x; t < 520; t += gridDim.x) t4_tile(p, l, t, smem); break;
        case 10: if (PH_ON(10)) ph_t5(p, l, smem); break;
        case 11: if (PH_ON(11)) ph_t6(p, smem); break;
        case 12: if (PH_ON(12)) ph_rows(p, l, 2); break;
        case 13: if (PH_ON(13)) ph_ffn1(p, 1, smem); break;
        case 14: if (PH_ON(14)) ph_ffn2(p, 1, smem); break;
        default: if (PH_ON(15)) ph_rows(p, l, 3); break;
      }
    }
    if (ph + 1 < ph1) {
      __threadfence();
      grid.sync();
      __threadfence();
    }
  }
}

extern "C" void kernel_launch(void* const* d_in, const int* in_sizes, int n_in, void* d_out, int out_size, void* d_ws,
                              size_t ws_size, hipStream_t stream) {
  if (n_in < 45 || ws_size < WS_NEED) {
    fprintf(stderr, "kernel_launch: bad inputs (n_in=%d ws=%zu need=%zu)\n", n_in, ws_size, (size_t)WS_NEED);
    return;
  }
  Params p{};
  for (int i = 0; i < 45; ++i) p.in[i] = (const float*)d_in[i];
  p.out = (float*)d_out;
  p.ws = (char*)d_ws;
#if COOP
  p.ph0 = 0; p.ph1 = NPH;
  void* args[] = {&p};
  hipError_t e = hipLaunchCooperativeKernel((void*)mega, dim3(256), dim3(NT), args, 0, stream);
  if (e != hipSuccess) fprintf(stderr, "cooperative launch failed: %s\n", hipGetErrorString(e));
#else
  for (int ph = 0; ph < NPH; ++ph) {
    p.ph0 = ph; p.ph1 = ph + 1;
    hipLaunchKernelGGL(mega, dim3(256), dim3(NT), 0, stream, p);
  }
#endif
}
```

```cpp
#include <hip/hip_runtime.h>
#include <hip/hip_cooperative_groups.h>
#include <cstdio>
namespace cg = cooperative_groups;

#define DI __device__ __forceinline__
typedef unsigned short u16;
typedef unsigned int u32;
typedef short bf16x8 __attribute__((ext_vector_type(8)));
typedef short s16x4 __attribute__((ext_vector_type(4)));
typedef float f32x16 __attribute__((ext_vector_type(16)));
typedef __bf16 bf16x2_t __attribute__((ext_vector_type(2)));
typedef float f32x2_t __attribute__((ext_vector_type(2)));
typedef float f2v __attribute__((ext_vector_type(2)));

#ifndef COOP
#define COOP 1
#endif
#ifndef PHSEL
#define PHSEL -1
#endif
#ifndef T3SEL
#define T3SEL -1
#endif
#ifndef REP_T3
#define REP_T3 1
#endif
#ifndef REP_EW
#define REP_EW 1
#endif
#ifndef REP_EW2
#define REP_EW2 1
#endif
#ifndef REP_GEMM
#define REP_GEMM 1
#endif
#ifndef PROBE_MASK
#define PROBE_MASK 0
#endif
#define PH_ON(k) (PHSEL < 0 || PHSEL == (k))
#define T3_ON(k) (T3SEL < 0 || T3SEL == (k))

constexpr int D = 1024, ML = 32768, MC = 512, M = 33280, TK = 16640;
constexpr int DFF = 2816, PS = 3072;
constexpr int NT = 512;
constexpr int RKROW = 33024, OFFC = 16408;
constexpr int NPH = 33;
constexpr int SMEM = 147456;

constexpr size_t O_WFFN1 = 0;
constexpr size_t O_WFFN2 = O_WFFN1 + 2ull * 5632 * 1024 * 2;
constexpr size_t O_WIN = O_WFFN2 + 2ull * 1024 * 2816 * 2;
constexpr size_t O_WGATE = O_WIN + 3072ull * 1024 * 2;
constexpr size_t O_WUP = O_WGATE + 4ull * 1024 * 1024 * 2;
constexpr size_t O_WO = O_WUP + 4ull * 1024 * 256 * 2;
constexpr size_t O_WQB = O_WO + 1024ull * 1024 * 2;
constexpr size_t O_WKVB = O_WQB + 384 * 192 * 2;
constexpr size_t O_W2 = O_WKVB + 512 * 128 * 2;
constexpr size_t O_A2 = O_W2 + 2 * 256 * 64 * 2;
constexpr size_t O_G2 = O_A2 + 2 * 256 * 64 * 2;
constexpr size_t O_MOD = O_G2 + 256 * 128 * 2;
constexpr size_t O_CNT = O_MOD + 2ull * 3 * 9216 * 4;
constexpr size_t O_BAR = O_CNT + 256;
constexpr size_t O_XC = O_BAR + 16384;
constexpr size_t O_H = O_XC + 512ull * 1024 * 4;
constexpr size_t O_RKG = O_H + (size_t)M * 1024 * 2;
constexpr size_t O_HFC = O_RKG + 256ull * RKROW * 2;
constexpr size_t O_HPART = O_HFC + 256ull * 512 * 4;
constexpr size_t O_ZC = O_HPART + 260ull * 512 * 4;
constexpr size_t O_X0C = O_ZC + 512ull * 256 * 4;
constexpr size_t O_S = O_X0C + 512ull * 256 * 4;
constexpr size_t O_QD = O_H;
constexpr size_t O_KD = O_QD + 2ull * 8 * TK * 32 * 2;
constexpr size_t O_VDT = O_KD + 2ull * 8 * TK * 32 * 2;
constexpr size_t O_ZT = O_VDT + 2ull * 4 * 64 * TK * 2;
static_assert(O_ZT + 256ull * 2 * 16384 * 2 <= O_RKG, "H alias overflow");
constexpr size_t SZ256 = (size_t)M * 256 * 2;
constexpr size_t S_R = O_S;
constexpr size_t S_KRAW = S_R + SZ256;
constexpr size_t S_V = S_KRAW + SZ256;
constexpr size_t S_KK = S_V + SZ256;
constexpr size_t S_X0T = S_KK + SZ256;
constexpr size_t S_KM = S_X0T + 256ull * 2 * 16384 * 2;
constexpr size_t S_P = S_KM + 2ull * 4 * TK * 96 * 2;
constexpr size_t S_LIN = S_P + (size_t)M * PS * 2;
constexpr size_t S_CQN = S_LIN + (size_t)M * 384 * 2;
constexpr size_t S_CKVN = S_CQN + (size_t)M * 192 * 2;
constexpr size_t S_END = S_CKVN + (size_t)M * 128 * 2;
constexpr size_t S_LOUT = S_P;
constexpr size_t S_QRAW = S_LOUT + (size_t)M * 1280 * 2;
constexpr size_t S_KVRAW = S_QRAW + (size_t)M * 384 * 2;
constexpr size_t S_QM = S_LIN;
constexpr size_t S_VMT = S_QM + 2ull * 4 * TK * 96 * 2;
static_assert(S_VMT + 2ull * 4 * 64 * TK * 2 <= S_END, "QM/VMT overflow");
constexpr size_t S_OALL = S_QRAW;
constexpr size_t S_YF = S_OALL + (size_t)M * 1024 * 2;
constexpr size_t S_YB = S_YF + SZ256;
constexpr size_t S_OHT = S_YB + SZ256;
static_assert(S_OHT + 256ull * 2 * 16384 * 2 <= S_LIN, "P-region overflow");
constexpr size_t S_ACCM = S_LOUT;
constexpr size_t S_YM = S_R;
static_assert(S_YM + (size_t)M * 1024 * 2 <= S_P, "YM overflow");
constexpr size_t S_ACT = O_S;
constexpr size_t S_Y = S_ACT + (size_t)M * DFF * 2;
static_assert(S_Y + (size_t)M * 1024 * 2 <= S_END, "FFN overflow");
constexpr size_t WS_NEED = S_END;

struct Params {
  const float* in[45];
  float* out;
  char* ws;
  int ph0, ph1;
};
typedef const __attribute__((address_space(4))) Params* CP;

DI float one_f() { float o = 1.f; asm volatile("" : "+v"(o)); return o; }
DI int tidx() { int t = threadIdx.x; asm volatile("" : "+v"(t)); return t; }
DI u32 pk2(float a, float b) {
  f32x2_t v = {a, b};
  bf16x2_t r = __builtin_convertvector(v, bf16x2_t);
  return __builtin_bit_cast(u32, r);
}
DI u16 f2bf(float f) { return (u16)(pk2(f, 0.f) & 0xffffu); }
DI float bf2f(u16 v) { return __uint_as_float(((u32)v) << 16); }
DI void unpack8(const uint4& v, float (&f)[8]) {
  f[0] = __uint_as_float(v.x << 16); f[1] = __uint_as_float(v.x & 0xffff0000u);
  f[2] = __uint_as_float(v.y << 16); f[3] = __uint_as_float(v.y & 0xffff0000u);
  f[4] = __uint_as_float(v.z << 16); f[5] = __uint_as_float(v.z & 0xffff0000u);
  f[6] = __uint_as_float(v.w << 16); f[7] = __uint_as_float(v.w & 0xffff0000u);
}
DI void ld8(const u16* p, float (&f)[8]) { uint4 v = *(const uint4*)p; unpack8(v, f); }
DI uint4 pack8(const float (&f)[8]) {
  uint4 v; v.x = pk2(f[0], f[1]); v.y = pk2(f[2], f[3]); v.z = pk2(f[4], f[5]); v.w = pk2(f[6], f[7]); return v;
}
DI void st8(u16* p, const float (&f)[8]) { *(uint4*)p = pack8(f); }
DI void ld8f(const float* p, float (&f)[8]) {
  float4 a = *(const float4*)p, b = *(const float4*)(p + 4);
  f[0] = a.x; f[1] = a.y; f[2] = a.z; f[3] = a.w; f[4] = b.x; f[5] = b.y; f[6] = b.z; f[7] = b.w;
}
DI float sigmoidf_(float x) { return __builtin_amdgcn_rcpf(1.f + __expf(-x)); }
DI float tanhf_(float x) { return 1.f - 2.f * __builtin_amdgcn_rcpf(1.f + __expf(2.f * x)); }
DI float siluf_(float x) { return x / (1.f + expf(-x)); }
template <int CTRL> DI float dppf(float v) {
  return __builtin_bit_cast(float, __builtin_amdgcn_update_dpp(0, __builtin_bit_cast(int, v), CTRL, 0xF, 0xF, true));
}
DI float dpp_sum16(float v) {
  v += dppf<0xB1>(v);
  v += dppf<0x4E>(v);
  v += dppf<0x141>(v);
  v += dppf<0x140>(v);
  return v;
}
DI float wave_sum(float v) {
  v = dpp_sum16(v);
  v += __shfl_xor(v, 16);
  v += __shfl_xor(v, 32);
  return v;
}
DI float grp8_sum(float v) {
  v += dppf<0xB1>(v);
  v += dppf<0x4E>(v);
  v += dppf<0x141>(v);
  return v;
}
#define MFMA32(a, b, c) __builtin_amdgcn_mfma_f32_32x32x16_bf16((a), (b), (c), 0, 0, 0)
DI int crow(int i, int h) { return (i & 3) + 8 * (i >> 2) + 4 * h; }
DI int mod_index(int m) { return m < ML ? (m >> 14) : 2; }
DI float lam_init_of(int l) { return l == 0 ? 0.2f : 0.35550907f; }

DI float rope_inv(int i) { return exp2f(-(float)i * 1.6609640474436813f); }

DI void ph_prep(CP p, char* smem) {
  const int tid = tidx();
  if (blockIdx.x == 0 && tid < 64) ((u32*)(p->ws + O_CNT))[tid] = 0u;
  float* sv = (float*)smem;
  float* red = sv + 3072;
  for (int i = tid; i < 3072; i += NT) {
    int v = i >> 10, k = i & 1023;
    float c = (v < 2) ? p->in[1][v * 1024 + k] : p->in[3][k];
    sv[i] = siluf_(c);
  }
  __syncthreads();
  float* MOD = (float*)(p->ws + O_MOD);
  for (int it = blockIdx.x; it < 288; it += gridDim.x) {
    int l = it / 144, cb = (it % 144) * 64;
    int col = cb + (tid & 63), ks = tid >> 6;
    const float* w = p->in[4] + (size_t)l * 1024 * 9216 + col;
    float a0 = 0.f, a1 = 0.f, a2 = 0.f;
#pragma unroll 8
    for (int k = ks * 128; k < ks * 128 + 128; ++k) {
      float wv = w[(size_t)k * 9216];
      a0 += sv[k] * wv; a1 += sv[1024 + k] * wv; a2 += sv[2048 + k] * wv;
    }
    red[(0 * 8 + ks) * 64 + (tid & 63)] = a0;
    red[(1 * 8 + ks) * 64 + (tid & 63)] = a1;
    red[(2 * 8 + ks) * 64 + (tid & 63)] = a2;
    __syncthreads();
    if (tid < 192) {
      int v = tid >> 6, c = tid & 63;
      float s = 0.f;
#pragma unroll
      for (int q = 0; q < 8; ++q) s += red[(v * 8 + q) * 64 + c];
      MOD[(size_t)l * 27648 + v * 9216 + cb + c] = s + p->in[5][l * 9216 + cb + c];
    }
    __syncthreads();
  }
}

struct CvtJob { const float* src; u16* dst; int K, Nsrc, Ndst, mode; };
DI CvtJob cvt_job(CP p, int l, int j) {
  CvtJob c; c.mode = 0;
  char* ws = p->ws;
  if (j < 2) { c.src = p->in[8] + (size_t)(l * 2 + j) * 1024 * 5632; c.dst = (u16*)(ws + O_WFFN1) + (size_t)j * 5632 * 1024; c.K = 1024; c.Nsrc = 5632; c.Ndst = 5632; c.mode = 1; }
  else if (j < 4) { int f = j - 2; c.src = p->in[9] + (size_t)(l * 2 + f) * 2816 * 1024; c.dst = (u16*)(ws + O_WFFN2) + (size_t)f * 1024 * 2816; c.K = 2816; c.Nsrc = 1024; c.Ndst = 1024; }
  else if (j == 4) { c.src = p->in[10] + (size_t)l * 1024 * 3040; c.dst = (u16*)(ws + O_WIN); c.K = 1024; c.Nsrc = 3040; c.Ndst = 3072; }
  else if (j < 9) { int n = j - 5; c.src = p->in[42] + (size_t)(l * 4 + n) * 1024 * 1024; c.dst = (u16*)(ws + O_WGATE) + (size_t)n * 1024 * 1024; c.K = 1024; c.Nsrc = 1024; c.Ndst = 1024; }
  else if (j < 13) { int n = j - 9; c.src = p->in[41] + (size_t)(l * 4 + n) * 256 * 1024; c.dst = (u16*)(ws + O_WUP) + (size_t)n * 1024 * 256; c.K = 256; c.Nsrc = 1024; c.Ndst = 1024; }
  else if (j == 13) { c.src = p->in[44] + (size_t)l * 1024 * 1024; c.dst = (u16*)(ws + O_WO); c.K = 1024; c.Nsrc = 1024; c.Ndst = 1024; }
  else if (j == 14) { c.src = p->in[33] + (size_t)l * 192 * 384; c.dst = (u16*)(ws + O_WQB); c.K = 192; c.Nsrc = 384; c.Ndst = 384; }
  else if (j == 15) { c.src = p->in[35] + (size_t)l * 128 * 512; c.dst = (u16*)(ws + O_WKVB); c.K = 128; c.Nsrc = 512; c.Ndst = 512; }
  else if (j < 18) { int d = j - 16; c.src = p->in[13] + (size_t)(l * 2 + d) * 64 * 256; c.dst = (u16*)(ws + O_W2) + (size_t)d * 256 * 64; c.K = 64; c.Nsrc = 256; c.Ndst = 256; }
  else if (j < 20) { int d = j - 18; c.src = p->in[15] + (size_t)(l * 2 + d) * 64 * 256; c.dst = (u16*)(ws + O_A2) + (size_t)d * 256 * 64; c.K = 64; c.Nsrc = 256; c.Ndst = 256; }
  else { c.src = p->in[16] + (size_t)l * 128 * 256; c.dst = (u16*)(ws + O_G2); c.K = 128; c.Nsrc = 256; c.Ndst = 256; }
  return c;
}
DI int cvt_tiles(int j) {
  if (j < 2) return 16 * 88;
  if (j < 4) return 44 * 16;
  if (j == 4) return 16 * 48;
  if (j < 9) return 256;
  if (j < 13) return 4 * 16;
  if (j == 13) return 256;
  if (j == 14) return 3 * 6;
  if (j == 15) return 2 * 8;
  if (j < 20) return 4;
  return 2 * 4;
}
constexpr int CVT_TOTAL = 2 * 1408 + 2 * 704 + 768 + 4 * 256 + 4 * 64 + 256 + 18 + 16 + 16 + 8;

DI void cvt_tile(CP p, int l, int tile, char* smem) {
  int j = 0;
  for (; j < 21; ++j) { int n = cvt_tiles(j); if (tile < n) break; tile -= n; }
  CvtJob c = cvt_job(p, l, j);
  const int nkt = c.K >> 6;
  const int k0 = (tile % nkt) * 64, n0 = (tile / nkt) * 64;
  float* t = (float*)smem;
  const int tid = tidx();
#pragma unroll
  for (int e = 0; e < 2; ++e) {
    int idx = tid + NT * e;
    int kk = idx >> 4, n4 = (idx & 15) * 4;
    int nd = n0 + n4;
    int col;
    if (c.mode == 1) {
      int grp = nd >> 5, ab = (nd >> 4) & 1, cc = nd & 15;
      col = ab * 2816 + 16 * grp + cc;
    } else col = nd;
    float4 v = (col < c.Nsrc) ? *(const float4*)(c.src + (size_t)(k0 + kk) * c.Nsrc + col) : make_float4(0.f, 0.f, 0.f, 0.f);
    *(float4*)(t + kk * 68 + n4) = v;
  }
  __syncthreads();
#pragma unroll
  for (int e = 0; e < 4; ++e) {
    int idx = tid + NT * e;
    int nn = idx >> 5, k2 = (idx & 31) * 2;
    u32 v = pk2(t[k2 * 68 + nn], t[(k2 + 1) * 68 + nn]);
    *(u32*)(c.dst + (size_t)(n0 + nn) * c.K + k0 + k2) = v;
  }
  __syncthreads();
}

DI void filt_item(CP p, int l, int fi, char* smem) {
  const int tid = tidx();
  const bool lat = fi < 256;
  const int n = lat ? 16384 : 256;
  const int p0 = lat ? fi * 64 : (fi - 256) * 64;
  float* zf = (float*)smem;
  float* h1 = zf + 64 * 36;
  float* h2 = h1 + 4096;
  const float* w1 = p->in[24] + l * 33 * 64;
  const float* b1 = p->in[25] + l * 64;
  const float* f1 = p->in[26] + l * 64;
  const float* w2 = p->in[27] + l * 64 * 64;
  const float* b2 = p->in[28] + l * 64;
  const float* f2 = p->in[29] + l * 64;
  const float* w3 = p->in[30] + l * 64 * 512;
  for (int it = tid; it < 64 * 33; it += NT) {
    int pos = it / 33, e = it % 33;
    int pp = p0 + pos;
    float tt = (float)pp / (float)(n - 1);
    float wpos = 6.283185307179586f * (float)pp / (float)n;
    float v;
    if (e == 0) v = tt;
    else {
      int bi = (e - 1) & 15;
      float fr = 1e-4f + (float)bi * ((15.f - 1e-4f) / 15.f);
      float ang = wpos * fr;
      v = (e <= 16) ? __cosf(ang) : -__sinf(ang);
    }
    zf[pos * 36 + e] = v;
  }
  __syncthreads();
#pragma unroll 1
  for (int e = 0; e < 8; ++e) {
    int it = tid + NT * e;
    int pos = it >> 6, k = it & 63;
    float a = b1[k];
#pragma unroll 3
    for (int q = 0; q < 33; ++q) a += zf[pos * 36 + q] * w1[q * 64 + k];
    h1[pos * 64 + k] = __sinf(f1[k] * a);
  }
  __syncthreads();
#pragma unroll 1
  for (int e = 0; e < 8; ++e) {
    int it = tid + NT * e;
    int pos = it >> 6, k = it & 63;
    float a = b2[k];
#pragma unroll 4
    for (int q = 0; q < 64; ++q) a += h1[pos * 64 + q] * w2[q * 64 + k];
    h2[k * 64 + pos] = __sinf(f2[k] * a);
  }
  __syncthreads();
  {
    const int c2 = tid, c = c2 & 255;
    const bool bwd = c2 >= 256;
    const float mind = -3.0701134573253945f, maxd = -15.350567286626973f;
    const float dl = fabsf(mind + (float)c * ((maxd - mind) / 255.f));
    float ssq = 0.f;
    u16* rk = (u16*)(p->ws + O_RKG) + (size_t)c * RKROW;
    float* hfc = (float*)(p->ws + O_HFC);
#pragma unroll 1
    for (int g = 0; g < 4; ++g) {
      float acc[16];
#pragma unroll
      for (int j = 0; j < 16; ++j) acc[j] = 0.f;
#pragma unroll 2
      for (int k = 0; k < 64; ++k) {
        const float w = w3[k * 512 + c2];
        const float* hp = h2 + k * 64 + g * 16;
        float4 v0 = *(const float4*)(hp), v1 = *(const float4*)(hp + 4), v2 = *(const float4*)(hp + 8), v3 = *(const float4*)(hp + 12);
        acc[0] += v0.x * w; acc[1] += v0.y * w; acc[2] += v0.z * w; acc[3] += v0.w * w;
        acc[4] += v1.x * w; acc[5] += v1.y * w; acc[6] += v1.z * w; acc[7] += v1.w * w;
        acc[8] += v2.x * w; acc[9] += v2.y * w; acc[10] += v2.z * w; acc[11] += v2.w * w;
        acc[12] += v3.x * w; acc[13] += v3.y * w; acc[14] += v3.z * w; acc[15] += v3.w * w;
      }
#pragma unroll
      for (int j = 0; j < 16; ++j) {
        int pp = p0 + g * 16 + j;
        float tt = (float)pp / (float)(n - 1);
        float val = acc[j] * expf(-tt * dl);
        bool used = !(bwd && pp == n - 1);
        if (used) ssq += val * val;
        if (lat) {
          if (!bwd) rk[OFFC - pp] = f2bf(val);
          else if (used) rk[OFFC + pp + 1] = f2bf(val);
        } else {
          hfc[pp * 512 + c2] = val;
        }
      }
    }
    ((float*)(p->ws + O_HPART))[fi * 512 + c2] = ssq;
  }
  if (fi == 0) {
    u16* rkg = (u16*)(p->ws + O_RKG);
    for (int it = tid; it < 256 * 257; it += NT) {
      int c = it / 257, e = it % 257;
      int idx = e < 25 ? e : 32792 + (e - 25);
      rkg[(size_t)c * RKROW + idx] = 0;
    }
  }
  __syncthreads();
}

template <int NR>
DI void row_opN(const int (&m)[NR], const float* const (&xs)[NR], float* const (&xd)[NR], const u16* Y, const float* gpost,
                const float* const (&modpost)[NR], int sub_post, float wgt, const float* gpre, const float* const (&modpre)[NR], int sub_pre, u16* H) {
  const int lane = tidx() & 63;
  float xa[NR][8], xb[NR][8], ya[NR][8], yb[NR][8];
#pragma unroll
  for (int q = 0; q < NR; ++q) {
    ld8f(xs[q] + lane * 8, xa[q]);
    ld8f(xs[q] + 512 + lane * 8, xb[q]);
    if (Y) {
      ld8(Y + (size_t)m[q] * 1024 + lane * 8, ya[q]);
      ld8(Y + (size_t)m[q] * 1024 + 512 + lane * 8, yb[q]);
    }
  }
  if (Y) {
    float ss[NR];
#pragma unroll
    for (int q = 0; q < NR; ++q) {
      ss[q] = 0.f;
#pragma unroll
      for (int j = 0; j < 8; ++j) ss[q] += ya[q][j] * ya[q][j] + yb[q][j] * yb[q][j];
    }
#pragma unroll
    for (int o = 32; o; o >>= 1)
#pragma unroll
      for (int q = 0; q < NR; ++q) ss[q] += __shfl_xor(ss[q], o);
    float gp0[8], gp1[8];
    ld8f(gpost + lane * 8, gp0); ld8f(gpost + 512 + lane * 8, gp1);
#pragma unroll
    for (int q = 0; q < NR; ++q) {
      const float rs = rsqrtf(ss[q] * (1.f / 1024.f) + 1e-6f);
      const float* gate = modpost[q] + (sub_post * 3 + 2) * 1024;
      float g[8];
      ld8f(gate + lane * 8, g);
#pragma unroll
      for (int j = 0; j < 8; ++j) xa[q][j] += wgt * g[j] * (ya[q][j] * rs * gp0[j]);
      ld8f(gate + 512 + lane * 8, g);
#pragma unroll
      for (int j = 0; j < 8; ++j) xb[q][j] += wgt * g[j] * (yb[q][j] * rs * gp1[j]);
    }
  }
#pragma unroll
  for (int q = 0; q < NR; ++q)
    if (xd[q]) {
      *(float4*)(xd[q] + lane * 8) = make_float4(xa[q][0], xa[q][1], xa[q][2], xa[q][3]);
      *(float4*)(xd[q] + lane * 8 + 4) = make_float4(xa[q][4], xa[q][5], xa[q][6], xa[q][7]);
      *(float4*)(xd[q] + 512 + lane * 8) = make_float4(xb[q][0], xb[q][1], xb[q][2], xb[q][3]);
      *(float4*)(xd[q] + 512 + lane * 8 + 4) = make_float4(xb[q][4], xb[q][5], xb[q][6], xb[q][7]);
    }
  if (gpre) {
    float ss[NR];
#pragma unroll
    for (int q = 0; q < NR; ++q) {
      ss[q] = 0.f;
#pragma unroll
      for (int j = 0; j < 8; ++j) ss[q] += xa[q][j] * xa[q][j] + xb[q][j] * xb[q][j];
    }
#pragma unroll
    for (int o = 32; o; o >>= 1)
#pragma unroll
      for (int q = 0; q < NR; ++q) ss[q] += __shfl_xor(ss[q], o);
    float g0[8], g1[8];
    ld8f(gpre + lane * 8, g0); ld8f(gpre + 512 + lane * 8, g1);
#pragma unroll
    for (int q = 0; q < NR; ++q) {
      const float rs = rsqrtf(ss[q] * (1.f / 1024.f) + 1e-6f);
      const float* shift = modpre[q] + (sub_pre * 3 + 0) * 1024;
      const float* scale = modpre[q] + (sub_pre * 3 + 1) * 1024;
      float sc[8], sh[8], hv[8];
      ld8f(scale + lane * 8, sc); ld8f(shift + lane * 8, sh);
#pragma unroll
      for (int j = 0; j < 8; ++j) hv[j] = xa[q][j] * rs * g0[j] * (1.f + sc[j]) + sh[j];
      st8(H + (size_t)m[q] * 1024 + lane * 8, hv);
      ld8f(scale + 512 + lane * 8, sc); ld8f(shift + 512 + lane * 8, sh);
#pragma unroll
      for (int j = 0; j < 8; ++j) hv[j] = xb[q][j] * rs * g1[j] * (1.f + sc[j]) + sh[j];
      st8(H + (size_t)m[q] * 1024 + 512 + lane * 8, hv);
    }
  }
}
DI void row_op(CP p, int m, const float* xs, float* xd, const u16* Y, const float* gpost, const float* modpost, int sub_post,
               float wgt, const float* gpre, const float* modpre, int sub_pre, u16* H) {
  const int mm[1] = {m};
  const float* const xss[1] = {xs};
  float* const xdd[1] = {xd};
  const float* const mp[1] = {modpost};
  const float* const mq[1] = {modpre};
  row_opN<1>(mm, xss, xdd, Y, gpost, mp, sub_post, wgt, gpre, mq, sub_pre, H);
}

DI void row_dispatch(CP p, int l, int kind, int m) {
  const float* MOD = (const float*)(p->ws + O_MOD);
  const int mi = mod_index(m);
  const float* modl = MOD + (size_t)l * 27648 + mi * 9216;
  float* xc = (float*)(p->ws + O_XC);
  float* xcur = (m < ML) ? p->out + (size_t)m * 1024 : xc + (size_t)(m - ML) * 1024;
  const float* xin = (m < ML) ? p->in[0] + (size_t)m * 1024 : p->in[2] + (size_t)(m - ML) * 1024;
  u16* H = (u16*)(p->ws + O_H);
  const float* npre = p->in[6] + (size_t)l * 3 * 1024;
  const float* npost = p->in[7] + (size_t)l * 3 * 1024;
  if (kind == 0) {
    row_op(p, m, xin, nullptr, nullptr, nullptr, nullptr, 0, 0.f, npre, modl, 0, H);
  } else if (kind == 1) {
    const float* xs = (l == 0) ? xin : xcur;
    row_op(p, m, xs, xcur, (const u16*)(p->ws + S_Y), npost, modl, 0, 0.5f, npre + 1024, modl, 1, H);
  } else if (kind == 2) {
    row_op(p, m, xcur, xcur, (const u16*)(p->ws + S_YM), npost + 1024, modl, 1, 1.0f, npre + 2048, modl, 2, H);
  } else {
    if (l == 0) {
      const float* modn = MOD + (size_t)1 * 27648 + mi * 9216;
      row_op(p, m, xcur, xcur, (const u16*)(p->ws + S_Y), npost + 2048, modl, 2, 0.5f, p->in[6] + 3 * 1024, modn, 0, H);
    } else {
      row_op(p, m, xcur, xcur, (const u16*)(p->ws + S_Y), npost + 2048, modl, 2, 0.5f, nullptr, nullptr, 0, nullptr);
    }
  }
}
DI void row_dispatch2(CP p, int l, int kind, int m0, int m1) {
  const float* MOD = (const float*)(p->ws + O_MOD);
  float* xc = (float*)(p->ws + O_XC);
  const int mm[2] = {m0, m1};
  const float* modl[2]; const float* modn[2]; float* xcur[2]; const float* xin[2];
#pragma unroll
  for (int q = 0; q < 2; ++q) {
    const int m = mm[q], mi = mod_index(m);
    modl[q] = MOD + (size_t)l * 27648 + mi * 9216;
    modn[q] = MOD + (size_t)1 * 27648 + mi * 9216;
    xcur[q] = (m < ML) ? p->out + (size_t)m * 1024 : xc + (size_t)(m - ML) * 1024;
    xin[q] = (m < ML) ? p->in[0] + (size_t)m * 1024 : p->in[2] + (size_t)(m - ML) * 1024;
  }
  u16* H = (u16*)(p->ws + O_H);
  const float* npre = p->in[6] + (size_t)l * 3 * 1024;
  const float* npost = p->in[7] + (size_t)l * 3 * 1024;
  const float* const ml[2] = {modl[0], modl[1]};
  const float* const mn[2] = {modn[0], modn[1]};
  float* const xd[2] = {xcur[0], xcur[1]};
  const float* const xsc[2] = {xcur[0], xcur[1]};
  const float* const xsi[2] = {xin[0], xin[1]};
  if (kind == 1) {
    if (l == 0) row_opN<2>(mm, xsi, xd, (const u16*)(p->ws + S_Y), npost, ml, 0, 0.5f, npre + 1024, ml, 1, H);
    else row_opN<2>(mm, xsc, xd, (const u16*)(p->ws + S_Y), npost, ml, 0, 0.5f, npre + 1024, ml, 1, H);
  } else if (kind == 2) {
    row_opN<2>(mm, xsc, xd, (const u16*)(p->ws + S_YM), npost + 1024, ml, 1, 1.0f, npre + 2048, ml, 2, H);
  } else {
    if (l == 0) row_opN<2>(mm, xsc, xd, (const u16*)(p->ws + S_Y), npost + 2048, ml, 2, 0.5f, p->in[6] + 3 * 1024, mn, 0, H);
    else row_opN<2>(mm, xsc, xd, (const u16*)(p->ws + S_Y), npost + 2048, ml, 2, 0.5f, nullptr, mn, 0, nullptr);
  }
}
DI void ph_rows(CP p, int l, int kind, int mlim = M) {
  const int wave = tidx() >> 6;
  const int stride = gridDim.x * 8;
  int m = blockIdx.x * 8 + wave;
  for (; m + stride < mlim; m += 2 * stride) row_dispatch2(p, l, kind, m, m + stride);
  if (m < mlim) row_dispatch(p, l, kind, m);
}

template <int BM, int WNT>
DI void gemm_main(const u16* __restrict__ A, int lda, const u16* __restrict__ BT, int K, int m0, int n0, char* lds,
                  f32x16 (&acc)[2][WNT]) {
  constexpr int AE = BM / 64;
  constexpr int STG = (BM + 128) * 144;
  constexpr int WN = 32 * WNT;
  const int tid = tidx(), lane = tid & 63, wave = tid >> 6, r = lane & 31, h = lane >> 5;
  const int wm = (BM == 256) ? (wave >> 1) : (wave >> 2);
  const int wn = (BM == 256) ? (wave & 1) : (wave & 3);
  const int KT = K >> 6;
  uint4 ra0, ra1, ra2 = make_uint4(0, 0, 0, 0), ra3 = make_uint4(0, 0, 0, 0), rb0, rb1;
  const u16* Ap = A + (size_t)(m0 + (tid >> 3)) * lda + (tid & 7) * 8;
  const u16* Bp = BT + (size_t)(n0 + (tid >> 3)) * K + (tid & 7) * 8;
  const size_t astr = (size_t)64 * lda, bstr = (size_t)64 * K;
  ra0 = *(const uint4*)(Ap); ra1 = *(const uint4*)(Ap + astr);
  if constexpr (AE == 4) { ra2 = *(const uint4*)(Ap + 2 * astr); ra3 = *(const uint4*)(Ap + 3 * astr); }
  rb0 = *(const uint4*)(Bp); rb1 = *(const uint4*)(Bp + bstr);
  const int sto = (tid >> 3) * 144 + (tid & 7) * 16;
  {
    char* sn = lds;
    *(uint4*)(sn + sto) = ra0; *(uint4*)(sn + sto + 64 * 144) = ra1;
    if constexpr (AE == 4) { *(uint4*)(sn + sto + 128 * 144) = ra2; *(uint4*)(sn + sto + 192 * 144) = ra3; }
    *(uint4*)(sn + BM * 144 + sto) = rb0; *(uint4*)(sn + BM * 144 + sto + 64 * 144) = rb1;
  }
  __syncthreads();
  const int aoff = (64 * wm + r) * 144 + 16 * h;
  const int boff = BM * 144 + (WN * wn + r) * 144 + 16 * h;
#pragma unroll 1
  for (int kt = 0; kt < KT; ++kt) {
    const bool more = kt + 1 < KT;
    if (more) {
      const int ko = (kt + 1) * 64;
      ra0 = *(const uint4*)(Ap + ko); ra1 = *(const uint4*)(Ap + astr + ko);
      if constexpr (AE == 4) { ra2 = *(const uint4*)(Ap + 2 * astr + ko); ra3 = *(const uint4*)(Ap + 3 * astr + ko); }
      rb0 = *(const uint4*)(Bp + ko); rb1 = *(const uint4*)(Bp + bstr + ko);
    }
    const char* sbase = lds + (kt & 1) * STG;
#pragma unroll
    for (int s = 0; s < 4; ++s) {
      bf16x8 a0 = *(const bf16x8*)(sbase + aoff + s * 32);
      bf16x8 a1 = *(const bf16x8*)(sbase + aoff + 32 * 144 + s * 32);
      bf16x8 b0 = *(const bf16x8*)(sbase + boff + s * 32);
      acc[0][0] = MFMA32(a0, b0, acc[0][0]);
      acc[1][0] = MFMA32(a1, b0, acc[1][0]);
      if constexpr (WNT == 2) {
        bf16x8 b1 = *(const bf16x8*)(sbase + boff + 32 * 144 + s * 32);
        acc[0][1] = MFMA32(a0, b1, acc[0][1]);
        acc[1][1] = MFMA32(a1, b1, acc[1][1]);
      }
    }
    if (more) {
      char* sn = lds + ((kt + 1) & 1) * STG;
      *(uint4*)(sn + sto) = ra0; *(uint4*)(sn + sto + 64 * 144) = ra1;
      if constexpr (AE == 4) { *(uint4*)(sn + sto + 128 * 144) = ra2; *(uint4*)(sn + sto + 192 * 144) = ra3; }
      *(uint4*)(sn + BM * 144 + sto) = rb0; *(uint4*)(sn + BM * 144 + sto + 64 * 144) = rb1;
    }
    __syncthreads();
  }
}
template <int WNT> DI void zero_acc(f32x16 (&acc)[2][WNT]) {
#pragma unroll
  for (int a = 0; a < 2; ++a)
#pragma unroll
    for (int b = 0; b < WNT; ++b)
#pragma unroll
      for (int i = 0; i < 16; ++i) acc[a][b][i] = 0.f;
}
DI void store_tile_pk(const f32x16& v, u16* C, int ldc, int row0, int col0, int r, int h) {
  const bool odd = r & 1;
#pragma unroll
  for (int i = 0; i < 16; i += 2) {
    float t0 = dppf<0xB1>(v[i]);
    float t1 = dppf<0xB1>(v[i + 1]);
    u32 w = odd ? pk2(t1, v[i + 1]) : pk2(v[i], t0);
    int row = row0 + (odd ? crow(i + 1, h) : crow(i, h));
    *(u32*)(C + (size_t)row * ldc + col0 + (r & ~1)) = w;
  }
}
template <int BM, int WNT>
DI void store_bf16(const f32x16 (&acc)[2][WNT], u16* C, int ldc, int m0, int n0) {
  const int lane = tidx() & 63, wave = tidx() >> 6, r = lane & 31, h = lane >> 5;
  const int wm = (BM == 256) ? (wave >> 1) : (wave >> 2);
  const int wn = (BM == 256) ? (wave & 1) : (wave & 3);
#pragma unroll
  for (int mt = 0; mt < 2; ++mt)
#pragma unroll
    for (int nt = 0; nt < WNT; ++nt)
      store_tile_pk(acc[mt][nt], C, ldc, m0 + 64 * wm + 32 * mt, n0 + 32 * WNT * wn + 32 * nt, r, h);
}
DI void gemm_main_256(const u16* __restrict__ A, int lda, const u16* __restrict__ BT, int K, int m0, int n0, char* lds,
                      f32x16 (&acc)[4][2]) {
  constexpr int STG = 512 * 144;
  const int tid = tidx(), lane = tid & 63, wave = tid >> 6, r = lane & 31, h = lane >> 5;
  const int wm = wave >> 2, wn = wave & 3;
  const int KT = K >> 6;
  const u16* Ap = A + (size_t)(m0 + (tid >> 3)) * lda + (tid & 7) * 8;
  const u16* Bp = BT + (size_t)(n0 + (tid >> 3)) * K + (tid & 7) * 8;
  const size_t astr = (size_t)64 * lda, bstr = (size_t)64 * K;
  uint4 ra0, ra1, ra2, ra3, rb0, rb1, rb2, rb3;
  ra0 = *(const uint4*)(Ap); ra1 = *(const uint4*)(Ap + astr); ra2 = *(const uint4*)(Ap + 2 * astr); ra3 = *(const uint4*)(Ap + 3 * astr);
  rb0 = *(const uint4*)(Bp); rb1 = *(const uint4*)(Bp + bstr); rb2 = *(const uint4*)(Bp + 2 * bstr); rb3 = *(const uint4*)(Bp + 3 * bstr);
  const int sto = (tid >> 3) * 144 + (tid & 7) * 16;
  {
    char* sn = lds;
    *(uint4*)(sn + sto) = ra0; *(uint4*)(sn + sto + 64 * 144) = ra1; *(uint4*)(sn + sto + 128 * 144) = ra2; *(uint4*)(sn + sto + 192 * 144) = ra3;
    sn += 256 * 144;
    *(uint4*)(sn + sto) = rb0; *(uint4*)(sn + sto + 64 * 144) = rb1; *(uint4*)(sn + sto + 128 * 144) = rb2; *(uint4*)(sn + sto + 192 * 144) = rb3;
  }
  __syncthreads();
  const int aoff = (128 * wm + r) * 144 + 16 * h;
  const int boff = 256 * 144 + (64 * wn + r) * 144 + 16 * h;
#pragma unroll 1
  for (int kt = 0; kt < KT; ++kt) {
    const bool more = kt + 1 < KT;
    if (more) {
      const int ko = (kt + 1) * 64;
      ra0 = *(const uint4*)(Ap + ko); ra1 = *(const uint4*)(Ap + astr + ko); ra2 = *(const uint4*)(Ap + 2 * astr + ko); ra3 = *(const uint4*)(Ap + 3 * astr + ko);
      rb0 = *(const uint4*)(Bp + ko); rb1 = *(const uint4*)(Bp + bstr + ko); rb2 = *(const uint4*)(Bp + 2 * bstr + ko); rb3 = *(const uint4*)(Bp + 3 * bstr + ko);
    }
    const char* sbase = lds + (kt & 1) * STG;
#pragma unroll
    for (int s = 0; s < 4; ++s) {
      bf16x8 b0 = *(const bf16x8*)(sbase + boff + s * 32);
      bf16x8 b1 = *(const bf16x8*)(sbase + boff + 32 * 144 + s * 32);
#pragma unroll
      for (int mt = 0; mt < 4; ++mt) {
        bf16x8 a = *(const bf16x8*)(sbase + aoff + mt * 32 * 144 + s * 32);
        acc[mt][0] = MFMA32(a, b0, acc[mt][0]);
        acc[mt][1] = MFMA32(a, b1, acc[mt][1]);
      }
    }
    if (more) {
      char* sn = lds + ((kt + 1) & 1) * STG;
      *(uint4*)(sn + sto) = ra0; *(uint4*)(sn + sto + 64 * 144) = ra1; *(uint4*)(sn + sto + 128 * 144) = ra2; *(uint4*)(sn + sto + 192 * 144) = ra3;
      sn += 256 * 144;
      *(uint4*)(sn + sto) = rb0; *(uint4*)(sn + sto + 64 * 144) = rb1; *(uint4*)(sn + sto + 128 * 144) = rb2; *(uint4*)(sn + sto + 192 * 144) = rb3;
    }
    __syncthreads();
  }
}
template <int BM, int WNT>
DI void gemm_bf16_tile(const u16* A, int lda, const u16* BT, int K, u16* C, int ldc, int m0, int n0, char* lds) {
  f32x16 acc[2][WNT];
  zero_acc<WNT>(acc);
  gemm_main<BM, WNT>(A, lda, BT, K, m0, n0, lds, acc);
  store_bf16<BM, WNT>(acc, C, ldc, m0, n0);
}

typedef float f32x4v __attribute__((ext_vector_type(4)));
#define LAS3 __attribute__((address_space(3)))
DI int g8_lds_byte(int r, int c) {
  int st = (r >> 4) * 2 + (c >> 5), rr = r & 15, cc = c & 31, ob = rr * 64 + cc * 2;
  return st * 1024 + (ob ^ (((ob >> 9) & 1) << 5));
}
DI void g8_stage_rc(int b, int& R, int& C) {
  int st = b / 1024, sb = b % 1024, swz = sb ^ (((sb >> 9) & 1) << 5);
  R = (st >> 1) * 16 + swz / 64; C = (st & 1) * 32 + (swz % 64) / 2;
}
DI void gemm8p(const u16* __restrict__ A, const u16* __restrict__ Bt, int K, int brow, int bcol, char* shmc,
               f32x4v (&acc)[2][2][4][2]) {
  constexpr int BK = 64, HALF = 128, HT = HALF * BK;
  u16* shm = (u16*)shmc;
  const int tid = tidx();
#define G8_SA(b, h) (shm + ((b) * 2 + (h)) * HT)
#define G8_SB(b, h) (shm + (4 + (b) * 2 + (h)) * HT)
  int g8_off0, g8_off1;
  { int _r, _c; g8_stage_rc(tid * 16, _r, _c); g8_off0 = _r * K + _c; g8_stage_rc(tid * 16 + 8192, _r, _c); g8_off1 = _r * K + _c; }
#define G8_STAGE(P, BASE, br, kt) do { const u16* _gb = (BASE) + ((long)(br) * K + (long)(kt) * BK); \
      __builtin_amdgcn_global_load_lds((const unsigned*)(_gb + g8_off0), (LAS3 unsigned*)((char*)(P) + tid * 16), 16, 0, 0); \
      __builtin_amdgcn_global_load_lds((const unsigned*)(_gb + g8_off1), (LAS3 unsigned*)((char*)(P) + tid * 16 + 8192), 16, 0, 0); } while (0)
#define G8_LDA(dst, b, h) _Pragma("unroll") for (int m = 0; m < 4; ++m) _Pragma("unroll") for (int k = 0; k < 2; ++k) \
    dst[m][k] = *reinterpret_cast<const bf16x8*>((char*)G8_SA(b, h) + g8_lds_byte(wr * 64 + m * 16 + fr, k * 32 + fq * 8))
#define G8_LDB(dst, b, h) _Pragma("unroll") for (int n = 0; n < 2; ++n) _Pragma("unroll") for (int k = 0; k < 2; ++k) \
    dst[n][k] = *reinterpret_cast<const bf16x8*>((char*)G8_SB(b, h) + g8_lds_byte(wc * 32 + n * 16 + fr, k * 32 + fq * 8))
#define G8_MMA(ai, bj, At_, Bt_) do { __builtin_amdgcn_s_setprio(1); \
    _Pragma("unroll") for (int m = 0; m < 4; ++m) _Pragma("unroll") for (int n = 0; n < 2; ++n) _Pragma("unroll") for (int k = 0; k < 2; ++k) \
      acc[ai][bj][m][n] = __builtin_amdgcn_mfma_f32_16x16x32_bf16(At_[m][k], Bt_[n][k], acc[ai][bj][m][n], 0, 0, 0); \
    __builtin_amdgcn_s_setprio(0); } while (0)
#define G8_WAIT_V(n) asm volatile("s_waitcnt vmcnt(" #n ")" ::: "memory")
#define G8_WAIT_L(n) asm volatile("s_waitcnt lgkmcnt(" #n ")" ::: "memory")
#define G8_BAR __builtin_amdgcn_s_barrier()
#define G8_SCHED __builtin_amdgcn_sched_barrier(0)
  const int wid = tid >> 6, lane = tid & 63, wr = wid >> 2, wc = wid & 3, fr = lane & 15, fq = lane >> 4;
  bf16x8 At[4][2], B0[2][2], B1[2][2];
  const int nt = K / BK;
  G8_STAGE(G8_SB(0, 0), Bt, bcol, 0); G8_STAGE(G8_SA(0, 0), A, brow, 0);
  G8_STAGE(G8_SB(0, 1), Bt, bcol + HALF, 0); G8_STAGE(G8_SA(0, 1), A, brow + HALF, 0);
  if (wr == 1) G8_BAR;
  G8_WAIT_V(4); G8_BAR;
  G8_STAGE(G8_SB(1, 0), Bt, bcol, 1); G8_STAGE(G8_SA(1, 0), A, brow, 1); G8_STAGE(G8_SB(1, 1), Bt, bcol + HALF, 1);
  G8_WAIT_V(6); G8_BAR;
#pragma unroll 1
  for (int t = 0; t < nt - 2; t += 2) {
    G8_LDB(B0, 0, 0); G8_SCHED; G8_LDA(At, 0, 0); G8_STAGE(G8_SA(1, 1), A, brow + HALF, t + 1);
    G8_WAIT_L(8); G8_BAR; G8_WAIT_L(0); G8_MMA(0, 0, At, B0); G8_BAR; G8_SCHED;
    G8_LDB(B1, 0, 1); G8_STAGE(G8_SB(0, 0), Bt, bcol, t + 2);
    G8_BAR; G8_WAIT_L(0); G8_MMA(0, 1, At, B1); G8_BAR;
    G8_LDA(At, 0, 1); G8_STAGE(G8_SA(0, 0), A, brow, t + 2);
    G8_BAR; G8_WAIT_L(0); G8_MMA(1, 0, At, B0); G8_BAR; G8_SCHED;
    G8_STAGE(G8_SB(0, 1), Bt, bcol + HALF, t + 2);
    G8_WAIT_V(6); G8_BAR; G8_MMA(1, 1, At, B1); G8_BAR;
    G8_LDB(B0, 1, 0); G8_SCHED; G8_LDA(At, 1, 0); G8_STAGE(G8_SA(0, 1), A, brow + HALF, t + 2);
    G8_WAIT_L(8); G8_BAR; G8_WAIT_L(0); G8_MMA(0, 0, At, B0); G8_BAR; G8_SCHED;
    G8_LDB(B1, 1, 1); G8_STAGE(G8_SB(1, 0), Bt, bcol, t + 3);
    G8_BAR; G8_WAIT_L(0); G8_MMA(0, 1, At, B1); G8_BAR;
    G8_LDA(At, 1, 1); G8_STAGE(G8_SA(1, 0), A, brow, t + 3);
    G8_BAR; G8_WAIT_L(0); G8_MMA(1, 0, At, B0); G8_BAR; G8_SCHED;
    G8_STAGE(G8_SB(1, 1), Bt, bcol + HALF, t + 3);
    G8_WAIT_V(6); G8_BAR; G8_MMA(1, 1, At, B1); G8_BAR;
  }
  { G8_LDB(B0, 0, 0); G8_LDA(At, 0, 0); G8_STAGE(G8_SA(1, 1), A, brow + HALF, nt - 1);
    G8_BAR; G8_WAIT_L(0); G8_MMA(0, 0, At, B0); G8_BAR;
    G8_LDB(B1, 0, 1); G8_BAR; G8_WAIT_L(0); G8_MMA(0, 1, At, B1); G8_BAR;
    G8_LDA(At, 0, 1); G8_WAIT_V(4); G8_BAR; G8_WAIT_L(0); G8_MMA(1, 0, At, B0); G8_MMA(1, 1, At, B1); G8_BAR; }
  { G8_LDB(B0, 1, 0); G8_LDA(At, 1, 0); G8_WAIT_V(2); G8_BAR; G8_WAIT_L(0); G8_MMA(0, 0, At, B0); G8_BAR;
    G8_LDB(B1, 1, 1); G8_WAIT_V(0); G8_BAR; G8_WAIT_L(0); G8_MMA(0, 1, At, B1); G8_BAR;
    G8_LDA(At, 1, 1); G8_BAR; G8_WAIT_L(0); G8_MMA(1, 0, At, B0); G8_MMA(1, 1, At, B1); G8_BAR; }
  if (wr == 0) G8_BAR;
}
DI void g8_store(const f32x4v& v, u16* C, int ldc, int row0, int col0, int fr, int fq) {
  const bool odd = fr & 1;
#pragma unroll
  for (int j = 0; j < 4; j += 2) {
    float t0 = dppf<0xB1>(v[j]);
    float t1 = dppf<0xB1>(v[j + 1]);
    u32 w = odd ? pk2(t1, v[j + 1]) : pk2(v[j], t0);
    int row = row0 + fq * 4 + j + (odd ? 1 : 0);
    *(u32*)(C + (size_t)row * ldc + col0 + (fr & ~1)) = w;
  }
}

DI int xcd_seq(int it) {
  if (gridDim.x != 256) return it;
  const int b = it & 255;
  return (it & ~255) + (b & 7) * 32 + (b >> 3);
}
DI void patch_mn(int q, int NM, int NN, int& mt, int& nt) {
  const int per = 4 * NN;
  const int g = q / per, rem = q - g * per;
  const int mrem = NM - 4 * g;
  const int mg = mrem < 4 ? mrem : 4;
  nt = rem / mg;
  mt = 4 * g + (rem - nt * mg);
}
DI void ph_ffn1(CP p, int f, char* smem, int nm = 130) {
  for (int it = blockIdx.x; it < 3072; it += gridDim.x) {
    CP q = p;
    asm volatile("" : "+s"(q));
    const u16* H = (const u16*)(q->ws + O_H);
    const u16* W = (const u16*)(q->ws + O_WFFN1) + (size_t)f * 5632 * 1024;
    const int t = xcd_seq(it);
    if (t >= nm * 22) continue;
    int mt_, nt_;
    patch_mn(t, nm, 22, mt_, nt_);
    const int brow = mt_ * 256, bcol = nt_ * 256;
    f32x4v acc[2][2][4][2];
#pragma unroll
    for (int a_ = 0; a_ < 2; ++a_)
#pragma unroll
      for (int b_ = 0; b_ < 2; ++b_)
#pragma unroll
        for (int m = 0; m < 4; ++m)
#pragma unroll
          for (int n = 0; n < 2; ++n) acc[a_][b_][m][n] = (f32x4v){0.f, 0.f, 0.f, 0.f};
    gemm8p(H, W, 1024, brow, bcol, smem, acc);
    asm volatile("" : "+s"(q));
    u16* ACT = (u16*)(q->ws + S_ACT);
    const int tid = tidx(), wid = tid >> 6, lane = tid & 63, wr = wid >> 2, wc = wid & 3, fr = lane & 15, fq = lane >> 4;
#pragma unroll
    for (int ai = 0; ai < 2; ++ai)
#pragma unroll
      for (int bj = 0; bj < 2; ++bj)
#pragma unroll
        for (int m = 0; m < 4; ++m) {
          f32x4v v;
#pragma unroll
          for (int j = 0; j < 4; ++j) {
            float a = acc[ai][bj][m][0][j], b = acc[ai][bj][m][1][j];
            v[j] = a * b * __builtin_amdgcn_rcpf(1.f + __expf(-a));
          }
          g8_store(v, ACT, DFF, brow + ai * 128 + wr * 64 + m * 16, (bcol + bj * 128 + wc * 32) / 2, fr, fq);
        }
  }
}
DI void g8_phase(CP p, size_t offA, size_t offB, size_t offC, int K, int NN, int ldc, char* smem, int nm = 130) {
  const int total = nm * NN;
  const int full = (gridDim.x == 256) ? (total & ~255) : total;
  for (int it = blockIdx.x; it < full; it += gridDim.x) {
    const int t = xcd_seq(it);
    int mt_, nt_;
    patch_mn(t, nm, NN, mt_, nt_);
    const int brow = mt_ * 256, bcol = nt_ * 256;
    CP q = p;
    asm volatile("" : "+s"(q));
    const u16* A = (const u16*)(q->ws + offA);
    const u16* Bt = (const u16*)(q->ws + offB);
    f32x4v acc[2][2][4][2];
#pragma unroll
    for (int a_ = 0; a_ < 2; ++a_)
#pragma unroll
      for (int b_ = 0; b_ < 2; ++b_)
#pragma unroll
        for (int m = 0; m < 4; ++m)
#pragma unroll
          for (int n = 0; n < 2; ++n) acc[a_][b_][m][n] = (f32x4v){0.f, 0.f, 0.f, 0.f};
    gemm8p(A, Bt, K, brow, bcol, smem, acc);
    asm volatile("" : "+s"(q));
    u16* C = (u16*)(q->ws + offC);
    const int tid = tidx(), wid = tid >> 6, lane = tid & 63, wr = wid >> 2, wc = wid & 3, fr = lane & 15, fq = lane >> 4;
#pragma unroll
    for (int ai = 0; ai < 2; ++ai)
#pragma unroll
      for (int bj = 0; bj < 2; ++bj)
#pragma unroll
        for (int m = 0; m < 4; ++m)
#pragma unroll
          for (int n = 0; n < 2; ++n)
            g8_store(acc[ai][bj][m][n], C, ldc, brow + ai * 128 + wr * 64 + m * 16, bcol + bj * 128 + wc * 32 + n * 16, fr, fq);
  }
  const int nsub = (total - full) * 4;
  for (int it = blockIdx.x; it < nsub; it += gridDim.x) {
    const int t = full + (it >> 2), sub = it & 3;
    int mt_, nt_;
    patch_mn(t, nm, NN, mt_, nt_);
    const int m0 = mt_ * 256 + (sub >> 1) * 128, n0 = nt_ * 256 + (sub & 1) * 128;
    gemm_bf16_tile<128, 1>((const u16*)(p->ws + offA), K, (const u16*)(p->ws + offB), K, (u16*)(p->ws + offC), ldc, m0, n0, smem);
  }
}
DI void ph_ffn2(CP p, int f, char* smem, int nm = 130) {
  g8_phase(p, S_ACT, O_WFFN2 + (size_t)f * 1024 * 2816 * 2, S_Y, DFF, 4, 1024, smem, nm);
}
DI void ph_t1(CP p, char* smem) { g8_phase(p, O_H, O_WIN, S_P, 1024, 12, PS, smem); }

DI void rope32(float (&x)[32], int row, int col) {
#pragma unroll
  for (int i = 0; i < 8; ++i) {
    float inv = rope_inv(i);
    float sr, cr, sc, cc;
    sr = __sinf((float)row * inv); cr = __cosf((float)row * inv);
    sc = __sinf((float)col * inv); cc = __cosf((float)col * inv);
    float a = x[i], b = x[i + 8];
    x[i] = a * cr - b * sr; x[i + 8] = b * cr + a * sr;
    float c = x[16 + i], d = x[24 + i];
    x[16 + i] = c * cc - d * sc; x[24 + i] = d * cc + c * sc;
  }
}
DI void ld32(const u16* p, float (&x)[32]) {
#pragma unroll
  for (int q = 0; q < 4; ++q) {
    uint4 v = *(const uint4*)(p + 8 * q);
    x[8 * q + 0] = __uint_as_float(v.x << 16); x[8 * q + 1] = __uint_as_float(v.x & 0xffff0000u);
    x[8 * q + 2] = __uint_as_float(v.y << 16); x[8 * q + 3] = __uint_as_float(v.y & 0xffff0000u);
    x[8 * q + 4] = __uint_as_float(v.z << 16); x[8 * q + 5] = __uint_as_float(v.z & 0xffff0000u);
    x[8 * q + 6] = __uint_as_float(v.w << 16); x[8 * q + 7] = __uint_as_float(v.w & 0xffff0000u);
  }
}
DI void st32(u16* p, const float (&x)[32]) {
#pragma unroll
  for (int q = 0; q < 4; ++q) {
    uint4 v;
    v.x = pk2(x[8 * q], x[8 * q + 1]); v.y = pk2(x[8 * q + 2], x[8 * q + 3]);
    v.z = pk2(x[8 * q + 4], x[8 * q + 5]); v.w = pk2(x[8 * q + 6], x[8 * q + 7]);
    *(uint4*)(p + 8 * q) = v;
  }
}

DI void t2a_tile(CP p, int l, int tl, char* smem) {
  const int tid = tidx();
  const int m0 = tl * 64;
  const bool lat = m0 < ML;
  int b, t0, n;
  if (lat) { b = m0 >> 14; t0 = m0 & 16383; n = 16384; } else { int mc = m0 - ML; b = mc >> 8; t0 = mc & 255; n = 256; }
  const int key0 = lat ? t0 : 16384 + t0;
  const u16* P = (const u16*)(p->ws + S_P);
  u16* Rb = (u16*)(p->ws + S_R); u16* KRAW = (u16*)(p->ws + S_KRAW); u16* Vb = (u16*)(p->ws + S_V); u16* KK = (u16*)(p->ws + S_KK);
  u16* LIN = (u16*)(p->ws + S_LIN); u16* CQN = (u16*)(p->ws + S_CQN); u16* CKVN = (u16*)(p->ws + S_CKVN);
  u16* KM = (u16*)(p->ws + S_KM); u16* QD = (u16*)(p->ws + O_QD); u16* KD = (u16*)(p->ws + O_KD); u16* VDT = (u16*)(p->ws + O_VDT);
  u16* ZT = (u16*)(p->ws + O_ZT); u16* X0T = (u16*)(p->ws + S_X0T);
  float* ZC = (float*)(p->ws + O_ZC); float* X0C = (float*)(p->ws + O_X0C);
  u16* zb = (u16*)smem;
  u16* xb = zb + 256 * 72;
  u16* vb = xb + 256 * 72;
  const float* mu = p->in[11] + l * 1152;
  const float* k_k = p->in[17] + l * 256;
#pragma unroll 1
  for (int e = 0; e < 18; ++e) {
    int it = tid + NT * e;
    int tok = it / 144, cg = it % 144;
    int t = t0 + tok, m = m0 + tok, c0 = cg * 8;
    const u16* pc = P + (size_t)m * PS + c0;
    float xc_[8], xp[8], xn[8], u[8], muv[8];
    ld8(pc, xc_);
    if (t > 0) ld8(pc - PS, xp); else {
#pragma unroll
      for (int j = 0; j < 8; ++j) xp[j] = 0.f;
    }
    if (t < n - 1) ld8(pc + PS, xn); else {
#pragma unroll
      for (int j = 0; j < 8; ++j) xn[j] = 0.f;
    }
    ld8f(mu + c0, muv);
#pragma unroll
    for (int j = 0; j < 8; ++j) u[j] = 0.5f * muv[j] * (xp[j] + xn[j]) + (1.f - muv[j]) * xc_[j];
    if (cg < 32) st8(Rb + (size_t)m * 256 + c0, u);
    else if (cg < 64) {
      int c = c0 - 256;
      st8(KRAW + (size_t)m * 256 + c, u);
      float kkv[8], kc[8];
      ld8f(k_k + c, kc);
      float ss = 0.f;
#pragma unroll
      for (int j = 0; j < 8; ++j) { kkv[j] = u[j] * kc[j]; ss += kkv[j] * kkv[j]; }
      ss = grp8_sum(ss);
      float inv = 1.f / fmaxf(sqrtf(ss), 1e-12f);
#pragma unroll
      for (int j = 0; j < 8; ++j) kkv[j] *= inv;
      st8(KK + (size_t)m * 256 + c, kkv);
    } else if (cg < 96) st8(Vb + (size_t)m * 256 + c0 - 512, u);
    else {
      int dst;
      if (cg < 112) { dst = 256 + c0 - 768;
#pragma unroll
        for (int j = 0; j < 8; ++j) u[j] = sigmoidf_(u[j]);
      } else if (cg < 120) { dst = c0 - 896;
#pragma unroll
        for (int j = 0; j < 8; ++j) u[j] = tanhf_(u[j]);
      } else if (cg < 128) { dst = 128 + c0 - 960;
#pragma unroll
        for (int j = 0; j < 8; ++j) u[j] = tanhf_(u[j]);
      } else if (cg < 136) dst = 64 + c0 - 1024;
      else dst = 192 + c0 - 1088;
      st8(LIN + (size_t)m * 384 + dst, u);
    }
  }
  const float* cw = p->in[22] + l * 3 * 768;
  const float* cb = p->in[23] + l * 768;
#pragma unroll 1
  for (int e = 0; e < 4; ++e) {
    int it = tid + NT * e;
    int tok = it >> 5, cg = it & 31;
    int t = t0 + tok, m = m0 + tok, c0 = cg * 8;
    float uu[3][8];
#pragma unroll
    for (int s = 0; s < 3; ++s) {
      int col = s * 256 + c0;
      const u16* pc = P + (size_t)m * PS + 1152 + col;
      float xc_[8], xp[8], xn[8], w0[8], w1[8], w2[8], bb[8];
      ld8(pc, xc_);
      if (t > 0) ld8(pc - PS, xp); else {
#pragma unroll
        for (int j = 0; j < 8; ++j) xp[j] = 0.f;
      }
      if (t < n - 1) ld8(pc + PS, xn); else {
#pragma unroll
        for (int j = 0; j < 8; ++j) xn[j] = 0.f;
      }
      ld8f(cw + col, w0); ld8f(cw + 768 + col, w1); ld8f(cw + 1536 + col, w2); ld8f(cb + col, bb);
#pragma unroll
      for (int j = 0; j < 8; ++j) uu[s][j] = xp[j] * w0[j] + xc_[j] * w1[j] + xn[j] * w2[j] + bb[j];
    }
    if (lat) {
#pragma unroll
      for (int j = 0; j < 8; ++j) {
        zb[(c0 + j) * 72 + tok] = f2bf(uu[2][j] * uu[1][j]);
        xb[(c0 + j) * 72 + tok] = f2bf(uu[0][j]);
      }
    } else {
      int mc = m - ML;
#pragma unroll
      for (int j = 0; j < 8; ++j) { ZC[mc * 256 + c0 + j] = uu[2][j] * uu[1][j]; X0C[mc * 256 + c0 + j] = uu[0][j]; }
    }
    uint4 vv = *(const uint4*)(P + (size_t)m * PS + 2784 + c0);
    const u16* vs = (const u16*)&vv;
#pragma unroll
    for (int j = 0; j < 8; ++j) vb[(c0 + j) * 72 + tok] = vs[j];
  }
  {
    int tok = tid >> 3, sub = tid & 7;
    int m = m0 + tok;
    const u16* pr = P + (size_t)m * PS;
    {
      float v[24];
#pragma unroll
      for (int q = 0; q < 3; ++q) ld8(pr + 1920 + 24 * sub + 8 * q, *(float(*)[8])&v[8 * q]);
      float ss = 0.f;
#pragma unroll
      for (int j = 0; j < 24; ++j) ss += v[j] * v[j];
      ss = grp8_sum(ss);
      float rs = rsqrtf(ss * (1.f / 192.f) + 1e-6f);
      const float* g = p->in[32] + l * 192 + 24 * sub;
#pragma unroll
      for (int q = 0; q < 3; ++q) {
        float o[8];
#pragma unroll
        for (int j = 0; j < 8; ++j) o[j] = v[8 * q + j] * rs * g[8 * q + j];
        st8(CQN + (size_t)m * 192 + 24 * sub + 8 * q, o);
      }
    }
    {
      float v[16];
#pragma unroll
      for (int q = 0; q < 2; ++q) ld8(pr + 2112 + 16 * sub + 8 * q, *(float(*)[8])&v[8 * q]);
      float ss = 0.f;
#pragma unroll
      for (int j = 0; j < 16; ++j) ss += v[j] * v[j];
      ss = grp8_sum(ss);
      float rs = rsqrtf(ss * (1.f / 128.f) + 1e-6f);
      const float* g = p->in[34] + l * 128 + 16 * sub;
#pragma unroll
      for (int q = 0; q < 2; ++q) {
        float o[8];
#pragma unroll
        for (int j = 0; j < 8; ++j) o[j] = v[8 * q + j] * rs * g[8 * q + j];
        st8(CKVN + (size_t)m * 128 + 16 * sub + 8 * q, o);
      }
    }
  }
  if (tid < 64) {
    int tok = tid, m = m0 + tok, t = t0 + tok;
    float x[32];
    ld32(P + (size_t)m * PS + 2240, x);
    if (lat) rope32(x, t >> 6, t & 63);
#pragma unroll
    for (int hh = 0; hh < 4; ++hh) st32(KM + ((size_t)(b * 4 + hh) * TK + key0 + tok) * 96 + 64, x);
  }
  {
    int tok = tid >> 3, h8 = tid & 7;
    int m = m0 + tok, t = t0 + tok;
    float x[32];
    ld32(P + (size_t)m * PS + 2272 + 32 * h8, x);
    if (lat) rope32(x, t >> 6, t & 63);
    const float sc = 0.17677669529663687f * 1.4426950408889634f;
#pragma unroll
    for (int j = 0; j < 32; ++j) x[j] *= sc;
    st32(QD + ((size_t)(b * 8 + h8) * TK + key0 + tok) * 32, x);
    ld32(P + (size_t)m * PS + 2528 + 32 * h8, x);
    if (lat) rope32(x, t >> 6, t & 63);
    st32(KD + ((size_t)(b * 8 + h8) * TK + key0 + tok) * 32, x);
  }
  __syncthreads();
#pragma unroll 1
  for (int e = 0; e < 4; ++e) {
    int id = tid + NT * e;
    int ch = id >> 3, tc8 = id & 7;
    if (lat) {
      *(uint4*)(ZT + ((size_t)ch * 2 + b) * 16384 + t0 + 8 * tc8) = *(const uint4*)(zb + ch * 72 + 8 * tc8);
      *(uint4*)(X0T + ((size_t)ch * 2 + b) * 16384 + t0 + 8 * tc8) = *(const uint4*)(xb + ch * 72 + 8 * tc8);
    }
    *(uint4*)(VDT + ((size_t)b * 256 + ch) * TK + key0 + 8 * tc8) = *(const uint4*)(vb + ch * 72 + 8 * tc8);
  }
  __syncthreads();
}

DI void ph_t2b(CP p, char* smem) {
  const u16* LIN = (const u16*)(p->ws + S_LIN);
  u16* LOUT = (u16*)(p->ws + S_LOUT);
  for (int t = blockIdx.x; t < 130 * 17; t += gridDim.x) {
    int m0 = (t / 17) * 256, j = t % 17;
    if (j < 10) {
      int g = j >> 1, n0 = (j & 1) * 128;
      const u16* A; const u16* BT; int K;
      if (g == 0) { A = LIN; BT = (const u16*)(p->ws + O_W2); K = 64; }
      else if (g == 1) { A = LIN + 64; BT = (const u16*)(p->ws + O_A2); K = 64; }
      else if (g == 2) { A = LIN + 128; BT = (const u16*)(p->ws + O_W2) + 256 * 64; K = 64; }
      else if (g == 3) { A = LIN + 192; BT = (const u16*)(p->ws + O_A2) + 256 * 64; K = 64; }
      else { A = LIN + 256; BT = (const u16*)(p->ws + O_G2); K = 128; }
      gemm_bf16_tile<256, 2>(A, 384, BT, K, LOUT + g * 256, 1280, m0, n0, smem);
    } else if (j < 13) {
      gemm_bf16_tile<256, 2>((const u16*)(p->ws + S_CQN), 192, (const u16*)(p->ws + O_WQB), 192, (u16*)(p->ws + S_QRAW), 384, m0, (j - 10) * 128, smem);
    } else {
      gemm_bf16_tile<256, 2>((const u16*)(p->ws + S_CKVN), 128, (const u16*)(p->ws + O_WKVB), 128, (u16*)(p->ws + S_KVRAW), 512, m0, (j - 13) * 128, smem);
    }
  }
}

DI void t2c_tile(CP p, int l, int tl, char* smem) {
  const int tid = tidx();
  const int m0 = tl * 64;
  const bool lat = m0 < ML;
  int b, t0;
  if (lat) { b = m0 >> 14; t0 = m0 & 16383; } else { int mc = m0 - ML; b = mc >> 8; t0 = mc & 255; }
  const int key0 = lat ? t0 : 16384 + t0;
  const u16* QRAW = (const u16*)(p->ws + S_QRAW);
  const u16* KVRAW = (const u16*)(p->ws + S_KVRAW);
  u16* QM = (u16*)(p->ws + S_QM); u16* KM = (u16*)(p->ws + S_KM); u16* VMT = (u16*)(p->ws + S_VMT);
  u16* vb = (u16*)smem;
  if (tid < 256) {
    int tok = tid >> 2, hh = tid & 3;
    int m = m0 + tok, t = t0 + tok;
    const u16* src = QRAW + (size_t)m * 384 + 96 * hh;
    u16* dst = QM + ((size_t)(b * 4 + hh) * TK + key0 + tok) * 96;
    const float sc = 0.10206207261596577f * 1.4426950408889634f;
#pragma unroll
    for (int q = 0; q < 8; ++q) {
      float v[8];
      ld8(src + 8 * q, v);
#pragma unroll
      for (int j = 0; j < 8; ++j) v[j] *= sc;
      st8(dst + 8 * q, v);
    }
    float x[32];
    ld32(src + 64, x);
    if (lat) rope32(x, t >> 6, t & 63);
#pragma unroll
    for (int j = 0; j < 32; ++j) x[j] *= sc;
    st32(dst + 64, x);
  }
  {
    int tok = tid >> 3, hh = (tid >> 1) & 3, part = tid & 1;
    int m = m0 + tok;
    const u16* src = KVRAW + (size_t)m * 512 + 128 * hh + 64 * part;
    if (part == 0) {
      u16* dst = KM + ((size_t)(b * 4 + hh) * TK + key0 + tok) * 96;
#pragma unroll
      for (int q = 0; q < 8; ++q) *(uint4*)(dst + 8 * q) = *(const uint4*)(src + 8 * q);
    } else {
#pragma unroll
      for (int q = 0; q < 8; ++q) {
        uint4 vv = *(const uint4*)(src + 8 * q);
        const u16* vs = (const u16*)&vv;
#pragma unroll
        for (int j = 0; j < 8; ++j) vb[(64 * hh + 8 * q + j) * 72 + tok] = vs[j];
      }
    }
  }
  {
    u16* LOUT = (u16*)(p->ws + S_LOUT);
#pragma unroll 1
    for (int e = 0; e < 16; ++e) {
      int it = tid + NT * e;
      int tok = it >> 7, cg = it & 127;
      int sec = cg >> 5, c0 = (cg & 31) * 8;
      u16* ptr = LOUT + (size_t)(m0 + tok) * 1280 + sec * 256 + c0;
      float v[8], c8[8];
      ld8(ptr, v);
      if ((sec & 1) == 0) {
        ld8f(p->in[12] + (l * 2 + (sec >> 1)) * 256 + c0, c8);
#pragma unroll
        for (int j = 0; j < 8; ++j) {
          float y = -(c8[j] + v[j]);
          float sp = fmaxf(y, 0.f) + __logf(1.f + __expf(-fabsf(y)));
          v[j] = __expf(-sp - 0.5f);
        }
      } else {
        ld8f(p->in[14] + (l * 2 + (sec >> 1)) * 256 + c0, c8);
#pragma unroll
        for (int j = 0; j < 8; ++j) v[j] = sigmoidf_(c8[j] + v[j]);
      }
      st8(ptr, v);
    }
  }
  __syncthreads();
#pragma unroll 1
  for (int e = 0; e < 4; ++e) {
    int id = tid + NT * e;
    int ch = id >> 3, tc8 = id & 7;
    *(uint4*)(VMT + ((size_t)b * 256 + ch) * TK + key0 + 8 * tc8) = *(const uint4*)(vb + ch * 72 + 8 * tc8);
  }
  __syncthreads();
}

template <int DQK>
DI void attn_pass(const u16* __restrict__ Qp, const u16* __restrict__ Kp, const u16* __restrict__ VTp, int kt0, int nkt,
                  char* lds, f32x16 (&o)[2], float& lsum) {
  constexpr int KS = DQK / 16;
  constexpr int KROW = DQK * 2 + 16;
  constexpr int KCH = DQK / 8;
  constexpr int NKC = 64 * KCH;
  constexpr int STG = 64 * KROW + 64 * 144;
  const int tid = tidx(), lane = tid & 63, wave = tid >> 6, r = lane & 31, h = lane >> 5;
  bf16x8 qf[KS];
#pragma unroll
  for (int s = 0; s < KS; ++s) qf[s] = *(const bf16x8*)(Qp + (size_t)(32 * wave + r) * DQK + 16 * s + 8 * h);
#pragma unroll
  for (int dt = 0; dt < 2; ++dt)
#pragma unroll
    for (int i = 0; i < 16; ++i) o[dt][i] = 0.f;
  float base = 0.f, base_next = 0.f, alpha_p = 1.f;
  f32x16 nb16;
#pragma unroll
  for (int i = 0; i < 16; ++i) nb16[i] = 0.f;
  f2v ls2 = {0.f, 0.f};
  const int kq0 = tid, kq1 = tid + NT;
  const bool has1 = kq1 < NKC, has0 = kq0 < NKC;
  const int kr0 = kq0 / KCH, kc0 = kq0 % KCH, kr1 = kq1 / KCH, kc1 = kq1 % KCH;
  const int vr = tid >> 3, vc = tid & 7;
  const int so0 = kr0 * KROW + kc0 * 16, so1 = kr1 * KROW + kc1 * 16, sov = 64 * KROW + vr * 144 + (vc >> 1) * 32 + (vc & 1) * 8;
  const u16* kp0 = Kp + (size_t)kr0 * DQK + kc0 * 8;
  const u16* kp1 = Kp + (size_t)kr1 * DQK + kc1 * 8;
  const u16* vp0 = VTp + (size_t)vr * TK + vc * 8;
  uint4 rk0 = make_uint4(0, 0, 0, 0), rk1 = make_uint4(0, 0, 0, 0), rv;
  uint4 rk0b = make_uint4(0, 0, 0, 0), rk1b = make_uint4(0, 0, 0, 0), rvb = make_uint4(0, 0, 0, 0);
#define ATT_LOAD_X(tile_, A0, A1, AV)                                             \
  {                                                                               \
    const int key0__ = (tile_) * 64;                                              \
    if (has0) A0 = *(const uint4*)(kp0 + (size_t)key0__ * DQK);                   \
    if (has1) A1 = *(const uint4*)(kp1 + (size_t)key0__ * DQK);                   \
    AV = *(const uint4*)(vp0 + key0__);                                           \
  }
#define ATT_STORE_X(stg_, A0, A1, AV)                                             \
  {                                                                               \
    char* sn__ = lds + (stg_) * STG;                                              \
    if (has0) *(uint4*)(sn__ + so0) = A0;                                         \
    if (has1) *(uint4*)(sn__ + so1) = A1;                                         \
    *(uint2*)(sn__ + sov) = make_uint2(AV.x, AV.y);                               \
    *(uint2*)(sn__ + sov + 16) = make_uint2(AV.z, AV.w);                          \
  }
#define ATT_LOAD(tile_) ATT_LOAD_X(tile_, rk0, rk1, rv)
#define ATT_STORE(stg_) ATT_STORE_X(stg_, rk0, rk1, rv)
#define ATT_LOAD_B(tile_) ATT_LOAD_X(tile_, rk0b, rk1b, rvb)
#define ATT_STORE_B(stg_) ATT_STORE_X(stg_, rk0b, rk1b, rvb)
#define ATT_QK(dst_, stg_)                                                        \
  {                                                                               \
    const char* sK__ = lds + (stg_) * STG;                                        \
    _Pragma("unroll") for (int mt = 0; mt < 2; ++mt) {                            \
      _Pragma("unroll") for (int s = 0; s < KS; ++s) {                            \
        bf16x8 a__ = *(const bf16x8*)(sK__ + (32 * mt + r) * KROW + 32 * s + 16 * h); \
        if (s == 0) dst_[mt] = MFMA32(a__, qf[s], nb16);                          \
        else dst_[mt] = MFMA32(a__, qf[s], dst_[mt]);                             \
      }                                                                           \
    }                                                                             \
  }
#define ATT_SOFTMAX_PV(sacc, stg_, J_)                                            \
  {                                                                               \
    const char* sV__ = lds + (stg_) * STG + 64 * KROW;                            \
    if ((J_) == 2) {                                                              \
      const f2v al2 = {alpha_p, alpha_p};                                         \
      ls2 = ls2 * al2;                                                            \
      _Pragma("unroll") for (int dt = 0; dt < 2; ++dt)                            \
        _Pragma("unroll") for (int i = 0; i < 16; ++i) o[dt][i] *= alpha_p;       \
    }                                                                             \
    if ((J_) == 0) {                                                              \
      float mloc = sacc[0][0];                                                    \
      _Pragma("unroll") for (int i = 1; i < 16; ++i) mloc = fmaxf(mloc, sacc[0][i]); \
      _Pragma("unroll") for (int i = 0; i < 16; ++i) mloc = fmaxf(mloc, sacc[1][i]); \
      mloc = fmaxf(mloc, __shfl_xor(mloc, 32));                                   \
      const float dlt = fmaxf(mloc, 0.f);                                         \
      alpha_p = __builtin_amdgcn_exp2f(-dlt);                                     \
      base_next = base + dlt;                                                     \
    }                                                                             \
    _Pragma("unroll") for (int mt = 0; mt < 2; ++mt)                              \
      _Pragma("unroll") for (int i = 0; i < 16; i += 2) {                         \
        f2v e = {__builtin_amdgcn_exp2f(sacc[mt][i]), __builtin_amdgcn_exp2f(sacc[mt][i + 1])}; \
        sacc[mt][i] = e.x; sacc[mt][i + 1] = e.y;                                 \
        ls2 += e;                                                                 \
      }                                                                           \
    _Pragma("unroll") for (int mt = 0; mt < 2; ++mt)                              \
      _Pragma("unroll") for (int s2 = 0; s2 < 2; ++s2) {                          \
        uint4 pw;                                                                 \
        pw.x = pk2(sacc[mt][8 * s2 + 0], sacc[mt][8 * s2 + 1]);                   \
        pw.y = pk2(sacc[mt][8 * s2 + 2], sacc[mt][8 * s2 + 3]);                   \
        pw.z = pk2(sacc[mt][8 * s2 + 4], sacc[mt][8 * s2 + 5]);                   \
        pw.w = pk2(sacc[mt][8 * s2 + 6], sacc[mt][8 * s2 + 7]);                   \
        bf16x8 pb = __builtin_bit_cast(bf16x8, pw);                               \
        _Pragma("unroll") for (int dt = 0; dt < 2; ++dt) {                        \
          const char* vp = sV__ + (32 * dt + r) * 144 + (2 * mt + s2) * 32 + 16 * h; \
          bf16x8 va = *(const bf16x8*)vp;                                         \
          o[dt] = MFMA32(va, pb, o[dt]);                                          \
        }                                                                         \
      }                                                                           \
    if ((J_) == 0) {                                                              \
      base = base_next;                                                           \
      _Pragma("unroll") for (int i = 0; i < 16; ++i) nb16[i] = -base_next;        \
    }                                                                             \
  }
  __syncthreads();
  ATT_LOAD(kt0)
  ATT_STORE(0)
  ATT_LOAD(kt0 + 1)
  ATT_STORE(1)
  __syncthreads();
  f32x16 sc[2], sn[2];
  int st_cur = 0, st_nxt = 1, st_sto = 2;
  const int lastt = nkt - 1;
  ATT_QK(sc, 0)
#pragma unroll 1
  for (int t = 0; t < nkt; t += 2) {
    const int jph = t & 3;
    { const int tl = (t + 2 < lastt) ? t + 2 : lastt; ATT_LOAD(kt0 + tl) }
    ATT_QK(sn, st_nxt)
    ATT_SOFTMAX_PV(sc, st_cur, jph)
    ATT_STORE(st_sto)
    __syncthreads();
    { const int tl = (t + 3 < lastt) ? t + 3 : lastt; ATT_LOAD(kt0 + tl) }
    ATT_QK(sc, st_sto)
    ATT_SOFTMAX_PV(sn, st_nxt, 1)
    ATT_STORE(st_cur)
    __syncthreads();
    const int tmp__ = st_cur; st_cur = st_sto; st_sto = st_nxt; st_nxt = tmp__;
  }
  lsum = ls2.x + ls2.y;
  lsum += __shfl_xor(lsum, 32);
#undef ATT_LOAD
#undef ATT_LOAD_B
#undef ATT_STORE_B
#undef ATT_LOAD_X
#undef ATT_STORE_X
#undef ATT_STORE
#undef ATT_QK
#undef ATT_SOFTMAX_PV
}

template <int DQK>
DI void attn_pass2(const u16* __restrict__ Qp, const u16* __restrict__ Kp, const u16* __restrict__ VTp, int kt0, int nkt, int nq,
                   char* lds, f32x16 (&o)[2][2], float (&lsum)[2]) {
  constexpr int KS = DQK / 16;
  constexpr int KROW = DQK * 2 + 16;
  constexpr int KCH = DQK / 8;
  constexpr int NKC = 64 * KCH;
  constexpr int STG = 64 * KROW + 64 * 144;
  const int tid = tidx(), lane = tid & 63, wave = tid >> 6, r = lane & 31, h = lane >> 5;
  const bool act = wave * 64 < nq;
  bf16x8 qf[2][KS];
#pragma unroll
  for (int u = 0; u < 2; ++u)
#pragma unroll
    for (int s = 0; s < KS; ++s) qf[u][s] = *(const bf16x8*)(Qp + (size_t)(act ? (64 * wave + 32 * u + r) : r) * DQK + 16 * s + 8 * h);
#pragma unroll
  for (int u = 0; u < 2; ++u)
#pragma unroll
    for (int dt = 0; dt < 2; ++dt)
#pragma unroll
      for (int i = 0; i < 16; ++i) o[u][dt][i] = 0.f;
  float base[2] = {0.f, 0.f};
  f2v ls2[2] = {{0.f, 0.f}, {0.f, 0.f}};
  const int kq0 = tid, kq1 = tid + NT;
  const bool has1 = (NKC > NT) && (kq1 < NKC), has0 = (NKC >= NT) || (kq0 < NKC);
  const int kr0 = kq0 / KCH, kc0 = kq0 % KCH, kr1 = kq1 / KCH, kc1 = kq1 % KCH;
  const int vr = tid >> 3, vc = tid & 7;
  const int so0 = kr0 * KROW + kc0 * 16, so1 = kr1 * KROW + kc1 * 16, sov = 64 * KROW + vr * 144 + (vc >> 1) * 32 + (vc & 1) * 8;
  const u16* kp0 = Kp + (size_t)kr0 * DQK + kc0 * 8;
  const u16* kp1 = Kp + (size_t)kr1 * DQK + kc1 * 8;
  const u16* vp0 = VTp + (size_t)vr * TK + vc * 8;
  uint4 rk0 = make_uint4(0, 0, 0, 0), rk1 = make_uint4(0, 0, 0, 0), rv;
#define A2_LOAD(tile_) { const int key0__ = (tile_) * 64; if (has0) rk0 = *(const uint4*)(kp0 + (size_t)key0__ * DQK); \
    if (has1) rk1 = *(const uint4*)(kp1 + (size_t)key0__ * DQK); rv = *(const uint4*)(vp0 + key0__); }
#define A2_STORE(stg_) { char* sn__ = lds + (stg_) * STG; if (has0) *(uint4*)(sn__ + so0) = rk0; if (has1) *(uint4*)(sn__ + so1) = rk1; \
    *(uint2*)(sn__ + sov) = make_uint2(rv.x, rv.y); *(uint2*)(sn__ + sov + 16) = make_uint2(rv.z, rv.w); }
  __syncthreads();
  A2_LOAD(kt0)
  A2_STORE(0)
  A2_LOAD(kt0 + 1)
  A2_STORE(1)
  __syncthreads();
  int st_cur = 0, st_nxt = 1, st_sto = 2;
  const int lastt = nkt - 1;
#pragma unroll 1
  for (int t = 0; t < nkt; ++t) {
    { const int tl = (t + 2 < lastt) ? t + 2 : lastt; A2_LOAD(kt0 + tl) }
    if (act) {
      const char* sK = lds + st_cur * STG;
      const char* sV = sK + 64 * KROW;
      f32x16 sc[2][2];
#pragma unroll
      for (int mt = 0; mt < 2; ++mt)
#pragma unroll
        for (int s = 0; s < KS; ++s) {
          const bf16x8 a = *(const bf16x8*)(sK + (32 * mt + r) * KROW + 32 * s + 16 * h);
#pragma unroll
          for (int u = 0; u < 2; ++u) {
            if (s == 0) { const f32x16 z = {0.f,0.f,0.f,0.f,0.f,0.f,0.f,0.f,0.f,0.f,0.f,0.f,0.f,0.f,0.f,0.f}; sc[u][mt] = MFMA32(a, qf[u][s], z); }
            else sc[u][mt] = MFMA32(a, qf[u][s], sc[u][mt]);
          }
        }
      bf16x8 pb[2][2][2];
      if ((t & 3) == 0) {
#pragma unroll
        for (int u = 0; u < 2; ++u) {
          float mloc = sc[u][0][0];
#pragma unroll
          for (int i = 1; i < 16; ++i) mloc = fmaxf(mloc, sc[u][0][i]);
#pragma unroll
          for (int i = 0; i < 16; ++i) mloc = fmaxf(mloc, sc[u][1][i]);
          mloc = fmaxf(mloc, __shfl_xor(mloc, 32));
          const float dlt = fmaxf(mloc - base[u] - 32.f, 0.f);
          if (__builtin_amdgcn_ballot_w64(dlt > 32.f) != 0ull) {
            const float al = __builtin_amdgcn_exp2f(-dlt);
            const f2v al2 = {al, al};
            ls2[u] = ls2[u] * al2;
#pragma unroll
            for (int dt = 0; dt < 2; ++dt)
#pragma unroll
              for (int i = 0; i < 16; ++i) o[u][dt][i] *= al;
            base[u] += dlt;
          }
        }
      }
      if (__builtin_amdgcn_ballot_w64(base[0] != 0.f || base[1] != 0.f) != 0ull) {
#pragma unroll
        for (int u = 0; u < 2; ++u)
#pragma unroll
          for (int mt = 0; mt < 2; ++mt)
#pragma unroll
            for (int i = 0; i < 16; ++i) sc[u][mt][i] -= base[u];
      }
#pragma unroll
      for (int u = 0; u < 2; ++u) {
#pragma unroll
        for (int mt = 0; mt < 2; ++mt)
#pragma unroll
          for (int i = 0; i < 16; i += 2) {
            f2v e = {__builtin_amdgcn_exp2f(sc[u][mt][i]), __builtin_amdgcn_exp2f(sc[u][mt][i + 1])};
            sc[u][mt][i] = e.x; sc[u][mt][i + 1] = e.y;
            ls2[u] += e;
          }
#pragma unroll
        for (int mt = 0; mt < 2; ++mt)
#pragma unroll
          for (int s2 = 0; s2 < 2; ++s2) {
            uint4 pw;
            pw.x = pk2(sc[u][mt][8 * s2 + 0], sc[u][mt][8 * s2 + 1]);
            pw.y = pk2(sc[u][mt][8 * s2 + 2], sc[u][mt][8 * s2 + 3]);
            pw.z = pk2(sc[u][mt][8 * s2 + 4], sc[u][mt][8 * s2 + 5]);
            pw.w = pk2(sc[u][mt][8 * s2 + 6], sc[u][mt][8 * s2 + 7]);
            pb[u][mt][s2] = __builtin_bit_cast(bf16x8, pw);
          }
      }
#pragma unroll
      for (int mt = 0; mt < 2; ++mt)
#pragma unroll
        for (int s2 = 0; s2 < 2; ++s2)
#pragma unroll
          for (int dt = 0; dt < 2; ++dt) {
            const bf16x8 va = *(const bf16x8*)(sV + (32 * dt + r) * 144 + (2 * mt + s2) * 32 + 16 * h);
            o[0][dt] = MFMA32(va, pb[0][mt][s2], o[0][dt]);
            o[1][dt] = MFMA32(va, pb[1][mt][s2], o[1][dt]);
          }
    }
    A2_STORE(st_sto)
    __syncthreads();
    const int tmp = st_cur; st_cur = st_nxt; st_nxt = st_sto; st_sto = tmp;
  }
#undef A2_LOAD
#undef A2_STORE
#pragma unroll
  for (int u = 0; u < 2; ++u) {
    float l = ls2[u].x + ls2[u].y;
    l += __shfl_xor(l, 32);
    lsum[u] = l;
  }
}

DI void mla_item(CP p, int b, int hh, int qt, char* smem) {
  const u16* QM = (const u16*)(p->ws + S_QM);
  const u16* KM = (const u16*)(p->ws + S_KM);
  const u16* VMT = (const u16*)(p->ws + S_VMT);
  u16* OALL = (u16*)(p->ws + S_OALL);
  const bool ctx = qt == 32;
  const int q0 = ctx ? 16384 : qt * 512;
  const int nq = ctx ? 256 : 512;
  const size_t hb = (size_t)(b * 4 + hh);
  f32x16 o[2][2]; float l[2];
  attn_pass2<96>(QM + (hb * TK + q0) * 96, KM + hb * TK * 96, VMT + hb * 64 * TK, ctx ? 256 : 0, ctx ? 4 : 260, nq, smem, o, l);
  const int lane = tidx() & 63, wave = tidx() >> 6, r = lane & 31, h = lane >> 5;
  if (wave * 64 < nq) {
#pragma unroll
    for (int u = 0; u < 2; ++u) {
      const int q = 64 * wave + 32 * u + r;
      const int m = ctx ? (ML + b * 256 + q) : (b * 16384 + q0 + q);
      const float il = 1.f / l[u];
#pragma unroll
      for (int dt = 0; dt < 2; ++dt)
#pragma unroll
        for (int g = 0; g < 4; ++g) {
          uint2 w;
          w.x = pk2(o[u][dt][4 * g] * il, o[u][dt][4 * g + 1] * il);
          w.y = pk2(o[u][dt][4 * g + 2] * il, o[u][dt][4 * g + 3] * il);
          *(uint2*)(OALL + (size_t)m * 1024 + 512 + 64 * hh + 32 * dt + 8 * g + 4 * h) = w;
        }
    }
  }
}
DI void diff_item(CP p, int l_, int b, int hd, int qt, char* smem) {
  const u16* QD = (const u16*)(p->ws + O_QD);
  const u16* KD = (const u16*)(p->ws + O_KD);
  const u16* VDT = (const u16*)(p->ws + O_VDT);
  u16* OALL = (u16*)(p->ws + S_OALL);
  const bool ctx = qt == 32;
  const int q0 = ctx ? 16384 : qt * 512;
  const int nq = ctx ? 256 : 512;
  const int kt0 = ctx ? 256 : 0, nkt = ctx ? 4 : 260;
  const u16* VT = VDT + (size_t)(b * 4 + hd) * 64 * TK;
  const int lane = tidx() & 63, wave = tidx() >> 6, r = lane & 31, h = lane >> 5;
  const bool act = wave * 64 < nq;
  {
    f32x16 o1[2][2]; float l1[2];
    const size_t hb = (size_t)(b * 8 + 2 * hd);
    attn_pass2<32>(QD + (hb * TK + q0) * 32, KD + hb * TK * 32, VT, kt0, nkt, nq, smem, o1, l1);
    if (act) {
#pragma unroll
      for (int u = 0; u < 2; ++u) {
        const float i1 = 1.f / l1[u];
        const int q = 64 * wave + 32 * u + r;
        const int m = ctx ? (ML + b * 256 + q) : (b * 16384 + q0 + q);
#pragma unroll
        for (int dt = 0; dt < 2; ++dt)
#pragma unroll
          for (int g = 0; g < 4; ++g) {
            uint2 w;
            w.x = pk2(o1[u][dt][4 * g] * i1, o1[u][dt][4 * g + 1] * i1);
            w.y = pk2(o1[u][dt][4 * g + 2] * i1, o1[u][dt][4 * g + 3] * i1);
            *(uint2*)(OALL + (size_t)m * 1024 + 768 + 64 * hd + 32 * dt + 8 * g + 4 * h) = w;
          }
      }
    }
  }
  f32x16 o2[2][2]; float l2[2];
  {
    const size_t hb = (size_t)(b * 8 + 2 * hd + 1);
    attn_pass2<32>(QD + (hb * TK + q0) * 32, KD + hb * TK * 32, VT, kt0, nkt, nq, smem, o2, l2);
  }
  float s1 = 0.f, s2 = 0.f;
  for (int j = 0; j < 32; ++j) {
    s1 += p->in[36][l_ * 32 + j] * p->in[37][l_ * 32 + j];
    s2 += p->in[38][l_ * 32 + j] * p->in[39][l_ * 32 + j];
  }
  const float li = lam_init_of(l_);
  const float lam = expf(s1) - expf(s2) + li;
  const float* sub = p->in[40] + l_ * 64;
  if (act) {
#pragma unroll
    for (int u = 0; u < 2; ++u) {
      const float i2 = lam / l2[u];
      const int q = 64 * wave + 32 * u + r;
      const int m = ctx ? (ML + b * 256 + q) : (b * 16384 + q0 + q);
      u16* dst = OALL + (size_t)m * 1024 + 768 + 64 * hd + 4 * h;
      float ss = 0.f;
#pragma unroll
      for (int dt = 0; dt < 2; ++dt)
#pragma unroll
        for (int g = 0; g < 4; ++g) {
          const uint2 pw = *(const uint2*)(dst + 32 * dt + 8 * g);
          const float a0 = __uint_as_float(pw.x << 16), a1 = __uint_as_float(pw.x & 0xffff0000u);
          const float a2 = __uint_as_float(pw.y << 16), a3 = __uint_as_float(pw.y & 0xffff0000u);
          const float v0 = a0 - o2[u][dt][4 * g] * i2, v1 = a1 - o2[u][dt][4 * g + 1] * i2;
          const float v2 = a2 - o2[u][dt][4 * g + 2] * i2, v3 = a3 - o2[u][dt][4 * g + 3] * i2;
          o2[u][dt][4 * g] = v0; o2[u][dt][4 * g + 1] = v1; o2[u][dt][4 * g + 2] = v2; o2[u][dt][4 * g + 3] = v3;
          ss += v0 * v0 + v1 * v1 + v2 * v2 + v3 * v3;
        }
      ss += __shfl_xor(ss, 32);
      const float rs = rsqrtf(ss * (1.f / 64.f) + 1e-5f) * (1.f - li);
#pragma unroll
      for (int dt = 0; dt < 2; ++dt)
#pragma unroll
        for (int g = 0; g < 4; ++g) {
          const int dv = 32 * dt + 8 * g + 4 * h;
          const float4 sg = *(const float4*)(sub + dv);
          uint2 w;
          w.x = pk2(o2[u][dt][4 * g] * rs * sg.x, o2[u][dt][4 * g + 1] * rs * sg.y);
          w.y = pk2(o2[u][dt][4 * g + 2] * rs * sg.z, o2[u][dt][4 * g + 3] * rs * sg.w);
          *(uint2*)(dst + 32 * dt + 8 * g) = w;
        }
    }
  }
}

DI void hyena_item(CP p, int l, int c, char* smem) {
  const int tid = tidx(), lane = tid & 63, wave = tid >> 6, r = lane & 31, h = lane >> 5;
  u16* zl = (u16*)smem;
  char* cp = smem + 2 * 128 * 136 * 2;
  float* red = (float*)(cp + 2 * 2 * 8 * 544);
  const u16* ZT = (const u16*)(p->ws + O_ZT) + (size_t)c * 2 * 16384;
  const u16* X0T = (const u16*)(p->ws + S_X0T) + (size_t)c * 2 * 16384;
  u16* OHT = (u16*)(p->ws + S_OHT) + (size_t)c * 2 * 16384;
  const u16* rkg = (const u16*)(p->ws + O_RKG) + (size_t)c * RKROW;
  __syncthreads();
#pragma unroll
  for (int e = 0; e < 8; ++e) {
    int q = tid + NT * e;
    int bb = q >> 11, t8 = (q & 2047) * 8;
    *(uint4*)(zl + (bb * 128 + (t8 >> 7)) * 136 + (t8 & 127)) = *(const uint4*)(ZT + (size_t)bb * 16384 + t8);
  }
  {
    const float* part = (const float*)(p->ws + O_HPART);
    float v = part[(tid >> 1) * 512 + (tid & 1) * 256 + c];
    v = wave_sum(v);
    if (lane == 0) red[wave] = v;
  }
  const int cwin = tid >> 8, co = (tid >> 5) & 7, cq = tid & 31;
  uint4 cr;
  {
    const int bx = -128 + cwin * 16384;
    __builtin_memcpy(&cr, rkg + OFFC + bx + co + 8 * cq, 16);
  }
  *(uint4*)(cp + ((0 * 2 + cwin) * 8 + co) * 544 + 16 * cq) = cr;
  __syncthreads();
  float rn = 0.f;
#pragma unroll
  for (int q = 0; q < 8; ++q) rn += red[q];
  rn = rsqrtf(rn);
  const int mt = wave & 3, bb = wave >> 2;
  const int i_ = 32 * mt + r;
  const int o_ = (-i_) & 7;
  f32x16 acc[4];
#pragma unroll
  for (int at = 0; at < 4; ++at)
#pragma unroll
    for (int i = 0; i < 16; ++i) acc[at][i] = 0.f;
  const bf16x8 zero8 = {0, 0, 0, 0, 0, 0, 0, 0};
  uint4 cr2 = make_uint4(0, 0, 0, 0);
  {
    const int bx = -128 * 1 - 128 + cwin * 16384;
    __builtin_memcpy(&cr, rkg + OFFC + bx + co + 8 * cq, 16);
  }
#define HY_LOADC(dst_, dn_) { const int bx__ = -128 * (dn_) - 128 + cwin * 16384; __builtin_memcpy(&dst_, rkg + OFFC + bx__ + co + 8 * cq, 16); }
#define HY_STOREC(src_, dn_) { *(uint4*)(cp + ((((dn_) & 1) * 2 + cwin) * 8 + co) * 544 + 16 * cq) = src_; }
#define HY_COMPUTE(K_, dl_)                                                                    \
  {                                                                                            \
    const char* chi = cp + ((((dl_) & 1) * 2 + 0) * 8 + o_) * 544;                             \
    const char* clo = cp + ((((dl_) & 1) * 2 + 1) * 8 + o_) * 544;                             \
    _Pragma("unroll") for (int s = 0; s < 8; ++s) {                                            \
      const int j = 16 * s + 8 * h;                                                            \
      const int q = (j - i_ + 128 - o_) >> 3;                                                  \
      bf16x8 ahi = *(const bf16x8*)(chi + 16 * q);                                             \
      bf16x8 alo = *(const bf16x8*)(clo + 16 * q);                                             \
      _Pragma("unroll") for (int at = 0; at < 4; ++at) {                                       \
        const int a = 32 * at + r;                                                             \
        const int ap = (a - (dl_)) & 127;                                                      \
        bf16x8 bf = *(const bf16x8*)(zl + (bb * 128 + ap) * 136 + j);                          \
        if (at > (K_)) acc[at] = MFMA32(ahi, bf, acc[at]);                                     \
        else if (at < (K_)) acc[at] = MFMA32(alo, bf, acc[at]);                                \
        else {                                                                                 \
          bf16x8 b1 = (a >= (dl_)) ? bf : zero8;                                               \
          bf16x8 b2 = (a >= (dl_)) ? zero8 : bf;                                               \
          acc[at] = MFMA32(ahi, b1, acc[at]);                                                  \
          acc[at] = MFMA32(alo, b2, acc[at]);                                                  \
        }                                                                                      \
      }                                                                                        \
    }                                                                                          \
  }
#define HY_SEGMENT(K_)                                                                         \
  _Pragma("unroll 1") for (int dl0 = 32 * (K_); dl0 < 32 * (K_) + 32; dl0 += 2) {              \
    {                                                                                          \
      const int dl = dl0;                                                                      \
      if (dl + 2 < 128) HY_LOADC(cr2, dl + 2)                                                  \
      HY_COMPUTE(K_, dl)                                                                       \
      HY_STOREC(cr, dl + 1)                                                                    \
      __syncthreads();                                                                         \
    }                                                                                          \
    {                                                                                          \
      const int dl = dl0 + 1;                                                                  \
      if (dl + 2 < 128) HY_LOADC(cr, dl + 2)                                                   \
      HY_COMPUTE(K_, dl)                                                                       \
      if (dl + 1 < 128) HY_STOREC(cr2, dl + 1)                                                 \
      __syncthreads();                                                                         \
    }                                                                                          \
  }
  HY_SEGMENT(0)
  HY_SEGMENT(1)
  HY_SEGMENT(2)
  HY_SEGMENT(3)
#undef HY_SEGMENT
#undef HY_COMPUTE
#undef HY_LOADC
#undef HY_STOREC
  const float bias = p->in[31][l * 256 + c];
#pragma unroll
  for (int at = 0; at < 4; ++at) {
    const int a = 32 * at + r;
#pragma unroll
    for (int g = 0; g < 4; ++g) {
      const int il = 32 * mt + 8 * g + 4 * h;
      const int t = 128 * a + il;
      uint2 zz = *(const uint2*)(zl + (bb * 128 + a) * 136 + il);
      uint2 xx = *(const uint2*)(X0T + (size_t)bb * 16384 + t);
      float z0 = __uint_as_float(zz.x << 16), z1 = __uint_as_float(zz.x & 0xffff0000u);
      float z2 = __uint_as_float(zz.y << 16), z3 = __uint_as_float(zz.y & 0xffff0000u);
      float x0 = __uint_as_float(xx.x << 16), x1 = __uint_as_float(xx.x & 0xffff0000u);
      float x2 = __uint_as_float(xx.y << 16), x3 = __uint_as_float(xx.y & 0xffff0000u);
      uint2 w;
      w.x = pk2(x0 * (acc[at][4 * g] * rn + z0 * bias), x1 * (acc[at][4 * g + 1] * rn + z1 * bias));
      w.y = pk2(x2 * (acc[at][4 * g + 2] * rn + z2 * bias), x3 * (acc[at][4 * g + 3] * rn + z3 * bias));
      *(uint2*)(OHT + (size_t)bb * 16384 + t) = w;
    }
  }
  __syncthreads();
}

DI void scan_item(CP p, int l, int si, char* smem) {
  const int tid = tidx(), lane = tid & 63, wave = tid >> 6;
  const int quarter = si & 3, dir = (si >> 2) & 1, hh = (si >> 3) & 3, b = si >> 5;
  const u16* Rb = (const u16*)(p->ws + S_R); const u16* KRAW = (const u16*)(p->ws + S_KRAW);
  const u16* Vb = (const u16*)(p->ws + S_V); const u16* KK = (const u16*)(p->ws + S_KK);
  const u16* LOUT = (const u16*)(p->ws + S_LOUT);
  u16* Yo = (u16*)(p->ws + (dir ? S_YB : S_YF));
  constexpr int BUF = 42 * 1024;
#define SCAN_ROW(s_) (((s_) < 256) ? (ML + b * 256 + (dir ? 255 - (s_) : (s_))) : (b * 16384 + (dir ? 16383 - ((s_) - 256) : ((s_) - 256))))
  __syncthreads();
  if (wave >= 4) {
    const int lt = tid - 256;
    const int lst = lt >> 3, lcg = lt & 7;
    const bool ldv = lt < 64;
    const int vst = lt >> 1, vcg = lt & 1;
    float kav[8];
    ld8f(p->in[18] + l * 256 + 64 * hh + 8 * lcg, kav);
    uint4 q0, q1, q2, q3, q4, q5 = make_uint4(0, 0, 0, 0);
#define SCAN_ISSUE(ch_)                                                                                  \
  {                                                                                                      \
    const int s__ = 32 * (ch_) + lst;                                                                    \
    const int m__ = SCAN_ROW(s__);                                                                       \
    const size_t o__ = (size_t)m__ * 256 + 64 * hh + 8 * lcg;                                            \
    q0 = *(const uint4*)(Rb + o__); q1 = *(const uint4*)(KRAW + o__); q2 = *(const uint4*)(KK + o__);    \
    q3 = *(const uint4*)(LOUT + (size_t)m__ * 1280 + dir * 512 + 64 * hh + 8 * lcg);                     \
    q4 = *(const uint4*)(LOUT + (size_t)m__ * 1280 + dir * 512 + 256 + 64 * hh + 8 * lcg);               \
    if (ldv) {                                                                                           \
      const int s2__ = 32 * (ch_) + vst;                                                                 \
      const int m2__ = SCAN_ROW(s2__);                                                                   \
      q5 = *(const uint4*)(Vb + (size_t)m2__ * 256 + 64 * hh + 16 * quarter + 8 * vcg);                  \
    }                                                                                                    \
  }
#define SCAN_COMMIT(bufi_)                                                                               \
  {                                                                                                      \
    float* base__ = (float*)(smem + (bufi_) * BUF);                                                      \
    float rr[8], kr[8], kk[8], ew[8], aa[8];                                                             \
    unpack8(q0, rr); unpack8(q1, kr); unpack8(q2, kk); unpack8(q3, ew); unpack8(q4, aa);                 \
    float* d__ = base__ + lst * 64 + 8 * lcg;                                                            \
    float o0[8], o1[8], o2[8], o3[8];                                                                    \
    const float one__ = one_f();                                                                         \
    _Pragma("unroll") for (int j = 0; j < 8; ++j) {                                                      \
      o0[j] = __expf(-ew[j]);                                                                            \
      o1[j] = kr[j] * (one__ + (aa[j] - one__) * kav[j]);                                                    \
      o2[j] = -kk[j];                                                                                    \
      o3[j] = kk[j] * aa[j];                                                                             \
    }                                                                                                    \
    *(float4*)(d__) = make_float4(o0[0], o0[1], o0[2], o0[3]); *(float4*)(d__ + 4) = make_float4(o0[4], o0[5], o0[6], o0[7]); \
    *(float4*)(d__ + 2048) = make_float4(o1[0], o1[1], o1[2], o1[3]); *(float4*)(d__ + 2052) = make_float4(o1[4], o1[5], o1[6], o1[7]); \
    *(float4*)(d__ + 4096) = make_float4(o2[0], o2[1], o2[2], o2[3]); *(float4*)(d__ + 4100) = make_float4(o2[4], o2[5], o2[6], o2[7]); \
    *(float4*)(d__ + 6144) = make_float4(o3[0], o3[1], o3[2], o3[3]); *(float4*)(d__ + 6148) = make_float4(o3[4], o3[5], o3[6], o3[7]); \
    *(float4*)(d__ + 8192) = make_float4(rr[0], rr[1], rr[2], rr[3]); *(float4*)(d__ + 8196) = make_float4(rr[4], rr[5], rr[6], rr[7]); \
    if (ldv) {                                                                                           \
      float vv[8];                                                                                       \
      unpack8(q5, vv);                                                                                   \
      float* dv__ = base__ + 5 * 2048 + vst * 16 + 8 * vcg;                                              \
      *(float4*)(dv__) = make_float4(vv[0], vv[1], vv[2], vv[3]); *(float4*)(dv__ + 4) = make_float4(vv[4], vv[5], vv[6], vv[7]); \
    }                                                                                                    \
  }
    SCAN_ISSUE(0)
    SCAN_COMMIT(0)
    SCAN_ISSUE(1)
    __syncthreads();
#pragma unroll 1
    for (int ch = 0; ch < 520; ++ch) {
      if (ch + 1 < 520) SCAN_COMMIT((ch + 1) & 1)
      if (ch + 2 < 520) SCAN_ISSUE(ch + 2)
      __syncthreads();
    }
  } else {
    const int rowl = lane >> 4, jl = lane & 15;
    const int il = 4 * wave + rowl;
    f2v S01 = {0.f, 0.f}, S23 = {0.f, 0.f};
    __syncthreads();
#pragma unroll 1
    for (int ch = 0; ch < 520; ++ch) {
      const float* base = (const float*)(smem + (ch & 1) * BUF);
      const int s0 = 32 * ch;
      const int mrow0 = SCAN_ROW(s0);
      const int mstep = dir ? -1 : 1;
      u16* yp = Yo + (size_t)(mrow0 + jl * mstep) * 256 + 64 * hh + 16 * quarter + il;
      const float* sp = base + 4 * jl;
      const float* vp = base + 5 * 2048 + il;
      float4 cw = *(const float4*)(sp), ck = *(const float4*)(sp + 2048), cn = *(const float4*)(sp + 4096);
      float4 cb = *(const float4*)(sp + 6144), cr = *(const float4*)(sp + 8192);
      float cv = vp[0];
      float ykeep = 0.f;
#pragma unroll
      for (int st = 0; st < 32; ++st) {
        float4 nw = cw, nk = ck, nn = cn, nb = cb, nr = cr; float nv = cv;
        if (st + 1 < 32) {
          const float* sq = sp + (st + 1) * 64;
          nw = *(const float4*)(sq); nk = *(const float4*)(sq + 2048); nn = *(const float4*)(sq + 4096);
          nb = *(const float4*)(sq + 6144); nr = *(const float4*)(sq + 8192);
          nv = vp[(st + 1) * 16];
        }
        f2v n01 = {cn.x, cn.y}, n23 = {cn.z, cn.w};
        f2v t = S01 * n01 + S23 * n23;
        float sa = dpp_sum16(t.x + t.y);
        f2v sa2 = {sa, sa}, v2 = {cv, cv};
        f2v w01 = {cw.x, cw.y}, w23 = {cw.z, cw.w}, b01 = {cb.x, cb.y}, b23 = {cb.z, cb.w}, k01 = {ck.x, ck.y}, k23 = {ck.z, ck.w};
        S01 = S01 * w01 + sa2 * b01 + v2 * k01;
        S23 = S23 * w23 + sa2 * b23 + v2 * k23;
        f2v r01 = {cr.x, cr.y}, r23 = {cr.z, cr.w};
        f2v u = S01 * r01 + S23 * r23;
        float y = dpp_sum16(u.x + u.y);
        ykeep = ((st & 15) == jl) ? y : ykeep;
        if ((st & 15) == 15) yp[(ptrdiff_t)((st & 16) * mstep) * 256] = f2bf(ykeep);
        cw = nw; ck = nk; cn = nn; cb = nb; cr = nr; cv = nv;
      }
      __syncthreads();
    }
  }
#undef SCAN_ISSUE
#undef SCAN_COMMIT
#undef SCAN_ROW
}

constexpr int T3_SCAN = 64, T3_DIFF = 8 * 33, T3_MLA = 8 * 33, T3_HY = 256;
constexpr int T3_TOTAL = T3_SCAN + T3_DIFF + T3_MLA + T3_HY;
DI void ph_t3(CP p, int l, char* smem, int* s_item, int rep) {
  u32* cnt = (u32*)(p->ws + O_CNT) + l + 2 * rep;
  for (;;) {
    __syncthreads();
    if (tidx() == 0) *s_item = (int)atomicAdd(cnt, 1u);
    __syncthreads();
    int it = *s_item;
    if (it >= T3_TOTAL) break;
    if (it < T3_SCAN) { if (T3_ON(0)) scan_item(p, l, it, smem); }
    else if (it < T3_SCAN + T3_DIFF) {
      int j = it - T3_SCAN;
      int bh = j / 33, qt = j % 33;
      if (T3_ON(1)) diff_item(p, l, bh >> 2, bh & 3, qt, smem);
    } else if (it < T3_SCAN + T3_DIFF + T3_MLA) {
      int j = it - T3_SCAN - T3_DIFF;
      int bh = j / 33, qt = j % 33;
      if (T3_ON(2)) mla_item(p, bh >> 2, bh & 3, qt, smem);
    } else if (T3_ON(3)) hyena_item(p, l, it - T3_SCAN - T3_DIFF - T3_MLA, smem);
  }
}

DI void t4_tile(CP p, int l, int tl, char* smem) {
  const int tid = tidx();
  const int m0 = tl * 64;
  const bool lat = m0 < ML;
  int b, t0;
  if (lat) { b = m0 >> 14; t0 = m0 & 16383; } else { int mc = m0 - ML; b = mc >> 8; t0 = mc & 255; }
  const u16* Rb = (const u16*)(p->ws + S_R); const u16* KRAW = (const u16*)(p->ws + S_KRAW); const u16* Vb = (const u16*)(p->ws + S_V);
  const u16* LOUT = (const u16*)(p->ws + S_LOUT);
  const u16* YF = (const u16*)(p->ws + S_YF); const u16* YB = (const u16*)(p->ws + S_YB);
  u16* OALL = (u16*)(p->ws + S_OALL);
#pragma unroll 1
  for (int e = 0; e < 4; ++e) {
    int it = tid + NT * e;
    int tok = it >> 5, hh = (it >> 3) & 3, sub = it & 7;
    int m = m0 + tok, c0 = 64 * hh + 8 * sub;
    float yf[8], yb[8], y[8];
    ld8(YF + (size_t)m * 256 + c0, yf); ld8(YB + (size_t)m * 256 + c0, yb);
    float s = 0.f;
#pragma unroll
    for (int j = 0; j < 8; ++j) { y[j] = yf[j] + yb[j]; s += y[j]; }
    float mean = grp8_sum(s) * (1.f / 64.f);
    float vs = 0.f;
#pragma unroll
    for (int j = 0; j < 8; ++j) { float d = y[j] - mean; vs += d * d; }
    float var = grp8_sum(vs) * (1.f / 64.f);
    float rs = rsqrtf(var + 64e-5f);
    float rr[8], kr[8], vv[8], alf[8], alb[8], gg[8], ka[8], rk[8], lw[8], lb[8];
    ld8(Rb + (size_t)m * 256 + c0, rr); ld8(KRAW + (size_t)m * 256 + c0, kr); ld8(Vb + (size_t)m * 256 + c0, vv);
    ld8(LOUT + (size_t)m * 1280 + 256 + c0, alf); ld8(LOUT + (size_t)m * 1280 + 768 + c0, alb); ld8(LOUT + (size_t)m * 1280 + 1024 + c0, gg);
    ld8f(p->in[18] + l * 256 + c0, ka); ld8f(p->in[19] + l * 256 + c0, rk);
    ld8f(p->in[20] + l * 256 + c0, lw); ld8f(p->in[21] + l * 256 + c0, lb);
    float bs = 0.f;
    const float one1 = one_f();
#pragma unroll
    for (int j = 0; j < 8; ++j) {
      float af = alf[j], ab = alb[j];
      float kf = kr[j] * (one1 + (af - one1) * ka[j]), kb = kr[j] * (one1 + (ab - one1) * ka[j]);
      bs += rr[j] * rk[j] * (kf + kb);
    }
    bs = grp8_sum(bs);
    float o[8];
#pragma unroll
    for (int j = 0; j < 8; ++j) o[j] = ((y[j] - mean) * rs * lw[j] + lb[j] + bs * vv[j]) * gg[j];
    st8(OALL + (size_t)m * 1024 + c0, o);
  }
  if (lat) {
    const u16* OHT = (const u16*)(p->ws + S_OHT);
    u16* tb = (u16*)smem;
#pragma unroll 1
    for (int e = 0; e < 4; ++e) {
      int id = tid + NT * e;
      int ch = id >> 3, tc8 = id & 7;
      uint4 vv = *(const uint4*)(OHT + ((size_t)ch * 2 + b) * 16384 + t0 + 8 * tc8);
      const u16* vs = (const u16*)&vv;
#pragma unroll
      for (int j = 0; j < 8; ++j) tb[(8 * tc8 + j) * 264 + ch] = vs[j];
    }
    __syncthreads();
#pragma unroll 1
    for (int e = 0; e < 4; ++e) {
      int id = tid + NT * e;
      int tok = id >> 5, cg = id & 31;
      *(uint4*)(OALL + (size_t)(m0 + tok) * 1024 + 256 + 8 * cg) = *(const uint4*)(tb + tok * 264 + 8 * cg);
    }
    __syncthreads();
  } else {
    const float* ZC = (const float*)(p->ws + O_ZC);
    const float* X0C = (const float*)(p->ws + O_X0C);
    const float* hfc = (const float*)(p->ws + O_HFC);
    const float* part = (const float*)(p->ws + O_HPART);
    const int c = tid & 255, hf = tid >> 8;
    float nrm = 0.f;
    for (int i = 0; i < 4; ++i) nrm += part[(256 + i) * 512 + c] + part[(256 + i) * 512 + 256 + c];
    const float rn = rsqrtf(nrm);
    const float bias = p->in[31][l * 256 + c];
    float acc[32];
#pragma unroll
    for (int j = 0; j < 32; ++j) acc[j] = 0.f;
    const int tb0 = t0 + hf * 32;
#pragma unroll 1
    for (int q = 0; q < 8; ++q) {
      float kw[63], zz[32];
#pragma unroll
      for (int e = 0; e < 63; ++e) {
        int d = tb0 - 32 * q - 31 + e;
        kw[e] = (d >= 0) ? ((d < 256) ? hfc[d * 512 + c] : 0.f) : ((-d - 1 < 255) ? hfc[(-d - 1) * 512 + 256 + c] : 0.f);
      }
#pragma unroll
      for (int u = 0; u < 32; ++u) zz[u] = ZC[(b * 256 + 32 * q + u) * 256 + c];
#pragma unroll
      for (int u = 0; u < 32; ++u)
#pragma unroll
        for (int j = 0; j < 32; ++j) acc[j] += kw[31 + j - u] * zz[u];
    }
#pragma unroll
    for (int j = 0; j < 32; ++j) {
      int t = tb0 + j;
      int mc = b * 256 + t;
      float z = ZC[mc * 256 + c], x0 = X0C[mc * 256 + c];
      OALL[(size_t)(ML + mc) * 1024 + 256 + c] = f2bf(x0 * (acc[j] * rn + z * bias));
    }
  }
  {
    const int wave = tid >> 6;
    const float* MOD = (const float*)(p->ws + O_MOD);
    for (int q = 0; q < 8; ++q) {
      int m = m0 + wave * 8 + q;
      const float* modl = MOD + (size_t)l * 27648 + mod_index(m) * 9216;
      const float* xs = (m < ML) ? p->out + (size_t)m * 1024 : (const float*)(p->ws + O_XC) + (size_t)(m - ML) * 1024;
      row_op(p, m, xs, nullptr, nullptr, nullptr, nullptr, 0, 0.f, p->in[6] + (size_t)(l * 3 + 1) * 1024, modl, 1, (u16*)(p->ws + O_H));
    }
  }
}

template <int BM>
DI void t5_tile(CP p, int l, int m0, int n0, char* smem) {
  constexpr int WNT = (BM == 256) ? 2 : 1;
  const u16* H = (const u16*)(p->ws + O_H);
  const u16* OALL = (const u16*)(p->ws + S_OALL);
  u16* ACCM = (u16*)(p->ws + S_ACCM);
  const int lane = tidx() & 63, wave = tidx() >> 6, r = lane & 31;
  const int wn = (BM == 256) ? (wave & 1) : (wave & 3);
  f32x16 accs[2][WNT];
  zero_acc<WNT>(accs);
#pragma unroll 1
  for (int n = 0; n < 4; ++n) {
    f32x16 g[2][WNT], u[2][WNT];
    zero_acc<WNT>(g);
    gemm_main<BM, WNT>(H, 1024, (const u16*)(p->ws + O_WGATE) + (size_t)n * 1024 * 1024, 1024, m0, n0, smem, g);
    const float* bgp = p->in[43] + (size_t)(l * 4 + n) * 1024 + n0 + 32 * WNT * wn + r;
#pragma unroll
    for (int nt = 0; nt < WNT; ++nt) {
      const float bg = bgp[32 * nt];
#pragma unroll
      for (int mt = 0; mt < 2; ++mt)
#pragma unroll
        for (int i = 0; i < 16; ++i) g[mt][nt][i] = __builtin_amdgcn_rcpf(1.f + __expf(-(g[mt][nt][i] + bg)));
    }
    zero_acc<WNT>(u);
    gemm_main<BM, WNT>(OALL + 256 * n, 1024, (const u16*)(p->ws + O_WUP) + (size_t)n * 1024 * 256, 256, m0, n0, smem, u);
#pragma unroll
    for (int mt = 0; mt < 2; ++mt)
#pragma unroll
      for (int nt = 0; nt < WNT; ++nt)
#pragma unroll
        for (int i = 0; i < 16; ++i) accs[mt][nt][i] += g[mt][nt][i] * u[mt][nt][i];
  }
  store_bf16<BM, WNT>(accs, ACCM, 1024, m0, n0);
}
DI void ph_t5(CP p, int l, char* smem, int nm = 130) {
  const int total = nm * 8;
  const int full = (gridDim.x == 256) ? (total & ~255) : total;
  for (int it = blockIdx.x; it < full; it += gridDim.x) {
    const int t = xcd_seq(it);
    t5_tile<256>(p, l, (t >> 3) * 256, (t & 7) * 128, smem);
  }
  const int nsub = (total - full) * 2;
  for (int it = blockIdx.x; it < nsub; it += gridDim.x) {
    const int t = full + (it >> 1);
    t5_tile<128>(p, l, (t >> 3) * 256 + (it & 1) * 128, (t & 7) * 128, smem);
  }
}
DI void ph_t6(CP p, char* smem, int nm = 130) { g8_phase(p, S_ACCM, O_WO, S_YM, 1024, 4, 1024, smem, nm); }

#define XB_TMO      128
#define XB_XCNT(j)  (256  + 64 * (j))
#define XB_XSUB(j)  (1280 + 64 * (j))
#define XB_XGEN(j)  (2304 + 64 * (j))
#define XB_TOP      3328
#define XB_TOPGEN   3392
#define XCD_BAR_WORDS 3456
#define XB_SPIN_CAP (1u << 18)
#define LAS __attribute__((address_space(3)))

__device__ __forceinline__ unsigned xb_ld(unsigned* p)              { return __hip_atomic_load(p, __ATOMIC_RELAXED, __HIP_MEMORY_SCOPE_AGENT); }
__device__ __forceinline__ unsigned xb_add(unsigned* p, unsigned v) { return __hip_atomic_fetch_add(p, v, __ATOMIC_RELAXED, __HIP_MEMORY_SCOPE_AGENT); }
__device__ __forceinline__ unsigned xb_xcc_id() { return (unsigned)__builtin_amdgcn_s_getreg((3 << 11) | 20) & 0xFu; }
#define XB_SPIN(cond, bar) do { unsigned _sp = 0; while (cond) { __builtin_amdgcn_s_sleep(1); \
    if ((++_sp & 255u) == 0u) { if (xb_ld(&(bar)[XB_TMO])) break; if (_sp > XB_SPIN_CAP) { atomicAdd(&(bar)[XB_TMO], 1u); break; } } } } while (0)

struct XcdBarrier {
    unsigned* bar; unsigned x;
    volatile LAS unsigned* st;
};

__device__ __forceinline__ XcdBarrier xcd_barrier_post(unsigned* bar, volatile LAS unsigned* st) {
    XcdBarrier b; b.bar = bar; b.x = xb_xcc_id(); b.st = st;
    if (threadIdx.x == 0) (void)xb_add(&bar[XB_XCNT(b.x)], 1u);
    return b;
}
__device__ __forceinline__ void xcd_barrier_complete(unsigned* bar, unsigned x, unsigned& nloc, unsigned& nx) {
    const unsigned G = gridDim.x * gridDim.y * gridDim.z;
    unsigned sum, cnt, mine, sp = 0u;
    for (;;) {
        sum = 0u; cnt = 0u; mine = 0u;
#pragma unroll
        for (unsigned j = 0; j < 16; ++j) { const unsigned c = xb_ld(&bar[XB_XCNT(j)]); sum += c; cnt += (c > 0u) ? 1u : 0u; mine = (j == x) ? c : mine; }
        if (sum == G) break;
        __builtin_amdgcn_s_sleep(1);
        if ((++sp & 255u) == 0u) { if (xb_ld(&bar[XB_TMO])) break; if (sp > XB_SPIN_CAP) { atomicAdd(&bar[XB_TMO], 1u); break; } }
    }
    nloc = mine > 0u ? mine : 1u; nx = cnt > 0u ? cnt : 1u;
}

__device__ __forceinline__ void xcd_barrier(const XcdBarrier& b) {
    asm volatile("s_waitcnt vmcnt(0)" ::: "memory");
    __syncthreads();
    if (threadIdx.x == 0) {
        unsigned* bar = b.bar;
        __builtin_amdgcn_s_waitcnt(0);
        unsigned nloc = b.st[0], nx = b.st[1];
        if (nloc == 0u) { xcd_barrier_complete(bar, b.x, nloc, nx); b.st[0] = nloc; b.st[1] = nx; }
        const unsigned old = xb_add(&bar[XB_XSUB(b.x)], 1u);
        const unsigned gen = old / nloc;
        if (old + 1u == (gen + 1u) * nloc) {
            __builtin_amdgcn_fence(__ATOMIC_RELEASE, "agent");
            asm volatile("s_waitcnt vmcnt(0)" ::: "memory");
            const unsigned og = xb_add(&bar[XB_TOP], 1u);
            const unsigned tg = og / nx;
            if (og + 1u == (tg + 1u) * nx) xb_add(&bar[XB_TOPGEN], 1u);
            else XB_SPIN(xb_ld(&bar[XB_TOPGEN]) == tg, bar);
            __builtin_amdgcn_fence(__ATOMIC_ACQUIRE, "agent");
            xb_add(&bar[XB_XGEN(b.x)], 1u);
            asm volatile("s_waitcnt vmcnt(0)" ::: "memory");
        } else {
            XB_SPIN(xb_ld(&bar[XB_XGEN(b.x)]) == gen, bar);
            __builtin_amdgcn_fence(__ATOMIC_ACQUIRE, "agent");
            asm volatile("s_waitcnt vmcnt(0)" ::: "memory");
        }
    }
    __syncthreads();
}


__global__ void __launch_bounds__(NT) mega(Params p_) {
  __shared__ __attribute__((aligned(16))) char smem[SMEM];
  __shared__ int s_item;
  cg::grid_group grid = cg::this_grid();
  const int ph0 = p_.ph0, ph1 = p_.ph1;
  CP p = (CP)__builtin_amdgcn_kernarg_segment_ptr();
  __shared__ uint4 xb_words;
  if (ph1 - ph0 > 1) {
    if (threadIdx.x == 0) xb_words = make_uint4(0u, 0u, 0u, 0u);
    __syncthreads();
    (void)xcd_barrier_post((unsigned*)(p_.ws + O_BAR), (volatile LAS unsigned*)&xb_words);
  }
#if PROBE_MASK
  long long pr_sum = 0, pr_t0 = wall_clock64();
#endif
  for (int ph = ph0; ph < ph1; ++ph) {
    asm volatile("" : "+s"(p));
    if (ph == 0) { if (PH_ON(16)) ph_prep(p, smem); }
    else {
      const int l = (ph - 1) >> 4, k = (ph - 1) & 15;
      switch (k) {
        case 0: if (PH_ON(0)) for (int rep = 0; rep < REP_EW; ++rep) {
          const int nrow = (l == 0) ? (M / 8) : 0;
          const int total = CVT_TOTAL + 260 + nrow;
          for (int it = blockIdx.x; it < total; it += gridDim.x) {
            if (it < CVT_TOTAL) cvt_tile(p, l, it, smem);
            else if (it < CVT_TOTAL + 260) filt_item(p, l, it - CVT_TOTAL, smem);
            else row_dispatch(p, 0, 0, (it - CVT_TOTAL - 260) * 8 + (tidx() >> 6));
          }
        } break;
        case 1: if (PH_ON(1)) for (int rep = 0; rep < REP_GEMM; ++rep) ph_ffn1(p, 0, smem); break;
        case 2: if (PH_ON(2)) for (int rep = 0; rep < REP_GEMM; ++rep) ph_ffn2(p, 0, smem); break;
        case 3: if (PH_ON(3)) ph_rows(p, l, 1); break;
        case 4: if (PH_ON(4)) for (int rep = 0; rep < REP_GEMM; ++rep) ph_t1(p, smem); break;
        case 5: if (PH_ON(5)) for (int rep = 0; rep < REP_EW; ++rep) for (int t = blockIdx.x; t < 520; t += gridDim.x) t2a_tile(p, l, t, smem); break;
        case 6: if (PH_ON(6)) for (int rep = 0; rep < REP_EW2; ++rep) ph_t2b(p, smem); break;
        case 7: if (PH_ON(7)) for (int t = blockIdx.x; t < 520; t += gridDim.x) t2c_tile(p, l, t, smem); break;
        case 8: if (PH_ON(8)) for (int rep = 0; rep < REP_T3; ++rep) ph_t3(p, l, smem, &s_item, rep); break;
        case 9: if (PH_ON(9)) for (int rep = 0; rep < REP_EW2; ++rep) for (int t = blockIdx.x; t < (l == 1 ? 512 : 520); t += gridDim.x) t4_tile(p, l, t, smem); break;
        case 10: if (PH_ON(10)) for (int rep = 0; rep < REP_GEMM; ++rep) ph_t5(p, l, smem, l == 1 ? 128 : 130); break;
        case 11: if (PH_ON(11)) for (int rep = 0; rep < REP_GEMM; ++rep) ph_t6(p, smem, l == 1 ? 128 : 130); break;
        case 12: if (PH_ON(12)) ph_rows(p, l, 2, l == 1 ? ML : M); break;
        case 13: if (PH_ON(13)) for (int rep = 0; rep < REP_GEMM; ++rep) ph_ffn1(p, 1, smem, l == 1 ? 128 : 130); break;
        case 14: if (PH_ON(14)) for (int rep = 0; rep < REP_GEMM; ++rep) ph_ffn2(p, 1, smem, l == 1 ? 128 : 130); break;
        default: if (PH_ON(15)) ph_rows(p, l, 3, l == 1 ? ML : M); break;
      }
    }
    if (ph + 1 < ph1) {
      if (ph == ph0) { __threadfence(); grid.sync(); __threadfence(); }
      else {
        XcdBarrier xb;
        xb.bar = (unsigned*)(p->ws + O_BAR); xb.x = xb_xcc_id(); xb.st = (volatile LAS unsigned*)&xb_words;
        xcd_barrier(xb);
      }
    }
#if PROBE_MASK
    {
      long long t1 = wall_clock64();
      int kb = (ph == 0) ? 16 : ((ph - 1) & 15);
      if ((PROBE_MASK >> kb) & 1) pr_sum += t1 - pr_t0;
      pr_t0 = t1;
    }
#endif
  }
#if PROBE_MASK
  if (blockIdx.x == 0) {
    long long te = wall_clock64();
    while (wall_clock64() - te < pr_sum) __builtin_amdgcn_s_sleep(8);
  }
#endif
}

extern "C" void kernel_launch(void* const* d_in, const int* in_sizes, int n_in, void* d_out, int out_size, void* d_ws,
                              size_t ws_size, hipStream_t stream) {
  if (n_in < 45 || ws_size < WS_NEED) {
    fprintf(stderr, "kernel_launch: bad inputs (n_in=%d ws=%zu need=%zu)\n", n_in, ws_size, (size_t)WS_NEED);
    return;
  }
  Params p{};
  for (int i = 0; i < 45; ++i) p.in[i] = (const float*)d_in[i];
  p.out = (float*)d_out;
  p.ws = (char*)d_ws;
#if COOP
  p.ph0 = 0; p.ph1 = NPH;
  hipMemsetAsync((char*)d_ws + O_BAR, 0, 16384, stream);
  void* args[] = {&p};
  hipError_t e = hipLaunchCooperativeKernel((void*)mega, dim3(256), dim3(NT), args, 0, stream);
  if (e != hipSuccess) fprintf(stderr, "cooperative launch failed: %s\n", hipGetErrorString(e));
#else
  for (int ph = 0; ph < NPH; ++ph) {
    p.ph0 = ph; p.ph1 = ph + 1;
    hipLaunchKernelGGL(mega, dim3(256), dim3(NT), 0, stream, p);
  }
#endif
}
```

```cpp
#include <hip/hip_runtime.h>
#include <hip/hip_cooperative_groups.h>
#include <cstdio>
namespace cg = cooperative_groups;

#define DI __device__ __forceinline__
typedef unsigned short u16;
typedef unsigned int u32;
typedef short bf16x8 __attribute__((ext_vector_type(8)));
typedef short s16x4 __attribute__((ext_vector_type(4)));
typedef float f32x16 __attribute__((ext_vector_type(16)));
typedef __bf16 bf16x2_t __attribute__((ext_vector_type(2)));
typedef float f32x2_t __attribute__((ext_vector_type(2)));
typedef float f2v __attribute__((ext_vector_type(2)));

#ifndef COOP
#define COOP 1
#endif
#ifndef PHSEL
#define PHSEL -1
#endif
#ifndef T3SEL
#define T3SEL -1
#endif
#ifndef REP_T3
#define REP_T3 1
#endif
#ifndef REP_EW
#define REP_EW 1
#endif
#ifndef REP_EW2
#define REP_EW2 1
#endif
#ifndef REP_GEMM
#define REP_GEMM 1
#endif
#ifndef PROBE_MASK
#define PROBE_MASK 0
#endif
#define PH_ON(k) (PHSEL < 0 || PHSEL == (k))
#define T3_ON(k) (T3SEL < 0 || T3SEL == (k))

constexpr int D = 1024, ML = 32768, MC = 512, M = 33280, TK = 16640;
constexpr int DFF = 2816, PS = 3072;
constexpr int NT = 512;
constexpr int RKROW = 33024, OFFC = 16408;
constexpr int NPH = 33;
constexpr int SMEM = 147456;

constexpr size_t O_WFFN1 = 0;
constexpr size_t O_WFFN2 = O_WFFN1 + 2ull * 5632 * 1024 * 2;
constexpr size_t O_WIN = O_WFFN2 + 2ull * 1024 * 2816 * 2;
constexpr size_t O_WGATE = O_WIN + 3072ull * 1024 * 2;
constexpr size_t O_WUP = O_WGATE + 4ull * 1024 * 1024 * 2;
constexpr size_t O_WO = O_WUP + 4ull * 1024 * 256 * 2;
constexpr size_t O_WQB = O_WO + 1024ull * 1024 * 2;
constexpr size_t O_WKVB = O_WQB + 384 * 192 * 2;
constexpr size_t O_W2 = O_WKVB + 512 * 128 * 2;
constexpr size_t O_A2 = O_W2 + 2 * 256 * 64 * 2;
constexpr size_t O_G2 = O_A2 + 2 * 256 * 64 * 2;
constexpr size_t O_MOD = O_G2 + 256 * 128 * 2;
constexpr size_t O_CNT = O_MOD + 2ull * 3 * 9216 * 4;
constexpr size_t O_BAR = O_CNT + 256;
constexpr size_t O_XC = O_BAR + 16384;
constexpr size_t O_H = O_XC + 512ull * 1024 * 4;
constexpr size_t O_RKG = O_H + (size_t)M * 1024 * 2;
constexpr size_t O_HFC = O_RKG + 256ull * RKROW * 2;
constexpr size_t O_HPART = O_HFC + 256ull * 512 * 4;
constexpr size_t O_ZC = O_HPART + 260ull * 512 * 4;
constexpr size_t O_X0C = O_ZC + 512ull * 256 * 4;
constexpr size_t O_S = O_X0C + 512ull * 256 * 4;
constexpr size_t O_QD = O_H;
constexpr size_t O_KD = O_QD + 2ull * 8 * TK * 32 * 2;
constexpr size_t O_VDT = O_KD + 2ull * 8 * TK * 32 * 2;
constexpr size_t O_ZT = O_VDT + 2ull * 4 * 64 * TK * 2;
static_assert(O_ZT + 256ull * 2 * 16384 * 2 <= O_RKG, "H alias overflow");
constexpr size_t SZ256 = (size_t)M * 256 * 2;
constexpr size_t S_R = O_S;
constexpr size_t S_KRAW = S_R + SZ256;
constexpr size_t S_V = S_KRAW + SZ256;
constexpr size_t S_KK = S_V + SZ256;
constexpr size_t S_X0T = S_KK + SZ256;
constexpr size_t S_KM = S_X0T + 256ull * 2 * 16384 * 2;
constexpr size_t S_P = S_KM + 2ull * 4 * TK * 96 * 2;
constexpr size_t S_LIN = S_P + (size_t)M * PS * 2;
constexpr size_t S_CQN = S_LIN + (size_t)M * 384 * 2;
constexpr size_t S_CKVN = S_CQN + (size_t)M * 192 * 2;
constexpr size_t S_END = S_CKVN + (size_t)M * 128 * 2;
constexpr size_t S_LOUT = S_P;
constexpr size_t S_QRAW = S_LOUT + (size_t)M * 1280 * 2;
constexpr size_t S_KVRAW = S_QRAW + (size_t)M * 384 * 2;
constexpr size_t S_QM = S_LIN;
constexpr size_t S_VMT = S_QM + 2ull * 4 * TK * 96 * 2;
static_assert(S_VMT + 2ull * 4 * 64 * TK * 2 <= S_END, "QM/VMT overflow");
constexpr size_t S_OALL = S_QRAW;
constexpr size_t S_YF = S_OALL + (size_t)M * 1024 * 2;
constexpr size_t S_YB = S_YF + SZ256;
constexpr size_t S_OHT = S_YB + SZ256;
static_assert(S_OHT + 256ull * 2 * 16384 * 2 <= S_LIN, "P-region overflow");
constexpr size_t S_ACCM = S_LOUT;
constexpr size_t S_YM = S_R;
static_assert(S_YM + (size_t)M * 1024 * 2 <= S_P, "YM overflow");
constexpr size_t S_ACT = O_S;
constexpr size_t S_Y = S_ACT + (size_t)M * DFF * 2;
static_assert(S_Y + (size_t)M * 1024 * 2 <= S_END, "FFN overflow");
constexpr size_t WS_NEED = S_END;

struct Params {
  const float* in[45];
  float* out;
  char* ws;
  int ph0, ph1;
};
typedef const __attribute__((address_space(4))) Params* CP;

DI float one_f() { float o = 1.f; asm volatile("" : "+v"(o)); return o; }
DI int tidx() { int t = threadIdx.x; asm volatile("" : "+v"(t)); return t; }
DI u32 pk2(float a, float b) {
  f32x2_t v = {a, b};
  bf16x2_t r = __builtin_convertvector(v, bf16x2_t);
  return __builtin_bit_cast(u32, r);
}
DI u16 f2bf(float f) { return (u16)(pk2(f, 0.f) & 0xffffu); }
DI float bf2f(u16 v) { return __uint_as_float(((u32)v) << 16); }
DI void unpack8(const uint4& v, float (&f)[8]) {
  f[0] = __uint_as_float(v.x << 16); f[1] = __uint_as_float(v.x & 0xffff0000u);
  f[2] = __uint_as_float(v.y << 16); f[3] = __uint_as_float(v.y & 0xffff0000u);
  f[4] = __uint_as_float(v.z << 16); f[5] = __uint_as_float(v.z & 0xffff0000u);
  f[6] = __uint_as_float(v.w << 16); f[7] = __uint_as_float(v.w & 0xffff0000u);
}
DI void ld8(const u16* p, float (&f)[8]) { uint4 v = *(const uint4*)p; unpack8(v, f); }
DI uint4 pack8(const float (&f)[8]) {
  uint4 v; v.x = pk2(f[0], f[1]); v.y = pk2(f[2], f[3]); v.z = pk2(f[4], f[5]); v.w = pk2(f[6], f[7]); return v;
}
DI void st8(u16* p, const float (&f)[8]) { *(uint4*)p = pack8(f); }
DI void ld8f(const float* p, float (&f)[8]) {
  float4 a = *(const float4*)p, b = *(const float4*)(p + 4);
  f[0] = a.x; f[1] = a.y; f[2] = a.z; f[3] = a.w; f[4] = b.x; f[5] = b.y; f[6] = b.z; f[7] = b.w;
}
DI float sigmoidf_(float x) { return __builtin_amdgcn_rcpf(1.f + __expf(-x)); }
DI float tanhf_(float x) { return 1.f - 2.f * __builtin_amdgcn_rcpf(1.f + __expf(2.f * x)); }
DI float siluf_(float x) { return x / (1.f + expf(-x)); }
template <int CTRL> DI float dppf(float v) {
  return __builtin_bit_cast(float, __builtin_amdgcn_update_dpp(0, __builtin_bit_cast(int, v), CTRL, 0xF, 0xF, true));
}
DI float dpp_sum16(float v) {
  v += dppf<0xB1>(v);
  v += dppf<0x4E>(v);
  v += dppf<0x141>(v);
  v += dppf<0x140>(v);
  return v;
}
DI float wave_sum(float v) {
  v = dpp_sum16(v);
  v += __shfl_xor(v, 16);
  v += __shfl_xor(v, 32);
  return v;
}
DI float grp8_sum(float v) {
  v += dppf<0xB1>(v);
  v += dppf<0x4E>(v);
  v += dppf<0x141>(v);
  return v;
}
#define MFMA32(a, b, c) __builtin_amdgcn_mfma_f32_32x32x16_bf16((a), (b), (c), 0, 0, 0)
DI int crow(int i, int h) { return (i & 3) + 8 * (i >> 2) + 4 * h; }
DI int mod_index(int m) { return m < ML ? (m >> 14) : 2; }
DI float lam_init_of(int l) { return l == 0 ? 0.2f : 0.35550907f; }

DI float rope_inv(int i) { return exp2f(-(float)i * 1.6609640474436813f); }

DI void ph_prep(CP p, char* smem) {
  const int tid = tidx();
  if (blockIdx.x == 0 && tid < 64) ((u32*)(p->ws + O_CNT))[tid] = 0u;
  float* sv = (float*)smem;
  float* red = sv + 3072;
  for (int i = tid; i < 3072; i += NT) {
    int v = i >> 10, k = i & 1023;
    float c = (v < 2) ? p->in[1][v * 1024 + k] : p->in[3][k];
    sv[i] = siluf_(c);
  }
  __syncthreads();
  float* MOD = (float*)(p->ws + O_MOD);
  for (int it = blockIdx.x; it < 288; it += gridDim.x) {
    int l = it / 144, cb = (it % 144) * 64;
    int col = cb + (tid & 63), ks = tid >> 6;
    const float* w = p->in[4] + (size_t)l * 1024 * 9216 + col;
    float a0 = 0.f, a1 = 0.f, a2 = 0.f;
#pragma unroll 8
    for (int k = ks * 128; k < ks * 128 + 128; ++k) {
      float wv = w[(size_t)k * 9216];
      a0 += sv[k] * wv; a1 += sv[1024 + k] * wv; a2 += sv[2048 + k] * wv;
    }
    red[(0 * 8 + ks) * 64 + (tid & 63)] = a0;
    red[(1 * 8 + ks) * 64 + (tid & 63)] = a1;
    red[(2 * 8 + ks) * 64 + (tid & 63)] = a2;
    __syncthreads();
    if (tid < 192) {
      int v = tid >> 6, c = tid & 63;
      float s = 0.f;
#pragma unroll
      for (int q = 0; q < 8; ++q) s += red[(v * 8 + q) * 64 + c];
      MOD[(size_t)l * 27648 + v * 9216 + cb + c] = s + p->in[5][l * 9216 + cb + c];
    }
    __syncthreads();
  }
}

struct CvtJob { const float* src; u16* dst; int K, Nsrc, Ndst, mode; };
DI CvtJob cvt_job(CP p, int l, int j) {
  CvtJob c; c.mode = 0;
  char* ws = p->ws;
  if (j < 2) { c.src = p->in[8] + (size_t)(l * 2 + j) * 1024 * 5632; c.dst = (u16*)(ws + O_WFFN1) + (size_t)j * 5632 * 1024; c.K = 1024; c.Nsrc = 5632; c.Ndst = 5632; c.mode = 1; }
  else if (j < 4) { int f = j - 2; c.src = p->in[9] + (size_t)(l * 2 + f) * 2816 * 1024; c.dst = (u16*)(ws + O_WFFN2) + (size_t)f * 1024 * 2816; c.K = 2816; c.Nsrc = 1024; c.Ndst = 1024; }
  else if (j == 4) { c.src = p->in[10] + (size_t)l * 1024 * 3040; c.dst = (u16*)(ws + O_WIN); c.K = 1024; c.Nsrc = 3040; c.Ndst = 3072; }
  else if (j < 9) { int n = j - 5; c.src = p->in[42] + (size_t)(l * 4 + n) * 1024 * 1024; c.dst = (u16*)(ws + O_WGATE) + (size_t)n * 1024 * 1024; c.K = 1024; c.Nsrc = 1024; c.Ndst = 1024; }
  else if (j < 13) { int n = j - 9; c.src = p->in[41] + (size_t)(l * 4 + n) * 256 * 1024; c.dst = (u16*)(ws + O_WUP) + (size_t)n * 1024 * 256; c.K = 256; c.Nsrc = 1024; c.Ndst = 1024; }
  else if (j == 13) { c.src = p->in[44] + (size_t)l * 1024 * 1024; c.dst = (u16*)(ws + O_WO); c.K = 1024; c.Nsrc = 1024; c.Ndst = 1024; }
  else if (j == 14) { c.src = p->in[33] + (size_t)l * 192 * 384; c.dst = (u16*)(ws + O_WQB); c.K = 192; c.Nsrc = 384; c.Ndst = 384; }
  else if (j == 15) { c.src = p->in[35] + (size_t)l * 128 * 512; c.dst = (u16*)(ws + O_WKVB); c.K = 128; c.Nsrc = 512; c.Ndst = 512; }
  else if (j < 18) { int d = j - 16; c.src = p->in[13] + (size_t)(l * 2 + d) * 64 * 256; c.dst = (u16*)(ws + O_W2) + (size_t)d * 256 * 64; c.K = 64; c.Nsrc = 256; c.Ndst = 256; }
  else if (j < 20) { int d = j - 18; c.src = p->in[15] + (size_t)(l * 2 + d) * 64 * 256; c.dst = (u16*)(ws + O_A2) + (size_t)d * 256 * 64; c.K = 64; c.Nsrc = 256; c.Ndst = 256; }
  else { c.src = p->in[16] + (size_t)l * 128 * 256; c.dst = (u16*)(ws + O_G2); c.K = 128; c.Nsrc = 256; c.Ndst = 256; }
  return c;
}
DI int cvt_tiles(int j) {
  if (j < 2) return 16 * 88;
  if (j < 4) return 44 * 16;
  if (j == 4) return 16 * 48;
  if (j < 9) return 256;
  if (j < 13) return 4 * 16;
  if (j == 13) return 256;
  if (j == 14) return 3 * 6;
  if (j == 15) return 2 * 8;
  if (j < 20) return 4;
  return 2 * 4;
}
constexpr int CVT_TOTAL = 2 * 1408 + 2 * 704 + 768 + 4 * 256 + 4 * 64 + 256 + 18 + 16 + 16 + 8;

DI void cvt_tile(CP p, int l, int tile, char* smem) {
  int j = 0;
  for (; j < 21; ++j) { int n = cvt_tiles(j); if (tile < n) break; tile -= n; }
  CvtJob c = cvt_job(p, l, j);
  const int nkt = c.K >> 6;
  const int k0 = (tile % nkt) * 64, n0 = (tile / nkt) * 64;
  float* t = (float*)smem;
  const int tid = tidx();
#pragma unroll
  for (int e = 0; e < 2; ++e) {
    int idx = tid + NT * e;
    int kk = idx >> 4, n4 = (idx & 15) * 4;
    int nd = n0 + n4;
    int col;
    if (c.mode == 1) {
      int grp = nd >> 5, ab = (nd >> 4) & 1, cc = nd & 15;
      col = ab * 2816 + 16 * grp + cc;
    } else col = nd;
    float4 v = (col < c.Nsrc) ? *(const float4*)(c.src + (size_t)(k0 + kk) * c.Nsrc + col) : make_float4(0.f, 0.f, 0.f, 0.f);
    *(float4*)(t + kk * 68 + n4) = v;
  }
  __syncthreads();
#pragma unroll
  for (int e = 0; e < 4; ++e) {
    int idx = tid + NT * e;
    int nn = idx >> 5, k2 = (idx & 31) * 2;
    u32 v = pk2(t[k2 * 68 + nn], t[(k2 + 1) * 68 + nn]);
    *(u32*)(c.dst + (size_t)(n0 + nn) * c.K + k0 + k2) = v;
  }
  __syncthreads();
}

DI void filt_item(CP p, int l, int fi, char* smem) {
  const int tid = tidx();
  const bool lat = fi < 256;
  const int n = lat ? 16384 : 256;
  const int p0 = lat ? fi * 64 : (fi - 256) * 64;
  float* zf = (float*)smem;
  float* h1 = zf + 64 * 36;
  float* h2 = h1 + 4096;
  const float* w1 = p->in[24] + l * 33 * 64;
  const float* b1 = p->in[25] + l * 64;
  const float* f1 = p->in[26] + l * 64;
  const float* w2 = p->in[27] + l * 64 * 64;
  const float* b2 = p->in[28] + l * 64;
  const float* f2 = p->in[29] + l * 64;
  const float* w3 = p->in[30] + l * 64 * 512;
  for (int it = tid; it < 64 * 33; it += NT) {
    int pos = it / 33, e = it % 33;
    int pp = p0 + pos;
    float tt = (float)pp / (float)(n - 1);
    float wpos = 6.283185307179586f * (float)pp / (float)n;
    float v;
    if (e == 0) v = tt;
    else {
      int bi = (e - 1) & 15;
      float fr = 1e-4f + (float)bi * ((15.f - 1e-4f) / 15.f);
      float ang = wpos * fr;
      v = (e <= 16) ? __cosf(ang) : -__sinf(ang);
    }
    zf[pos * 36 + e] = v;
  }
  __syncthreads();
#pragma unroll 1
  for (int e = 0; e < 8; ++e) {
    int it = tid + NT * e;
    int pos = it >> 6, k = it & 63;
    float a = b1[k];
#pragma unroll 3
    for (int q = 0; q < 33; ++q) a += zf[pos * 36 + q] * w1[q * 64 + k];
    h1[pos * 64 + k] = __sinf(f1[k] * a);
  }
  __syncthreads();
#pragma unroll 1
  for (int e = 0; e < 8; ++e) {
    int it = tid + NT * e;
    int pos = it >> 6, k = it & 63;
    float a = b2[k];
#pragma unroll 4
    for (int q = 0; q < 64; ++q) a += h1[pos * 64 + q] * w2[q * 64 + k];
    h2[k * 64 + pos] = __sinf(f2[k] * a);
  }
  __syncthreads();
  {
    const int c2 = tid, c = c2 & 255;
    const bool bwd = c2 >= 256;
    const float mind = -3.0701134573253945f, maxd = -15.350567286626973f;
    const float dl = fabsf(mind + (float)c * ((maxd - mind) / 255.f));
    float ssq = 0.f;
    u16* rk = (u16*)(p->ws + O_RKG) + (size_t)c * RKROW;
    float* hfc = (float*)(p->ws + O_HFC);
#pragma unroll 1
    for (int g = 0; g < 4; ++g) {
      float acc[16];
#pragma unroll
      for (int j = 0; j < 16; ++j) acc[j] = 0.f;
#pragma unroll 2
      for (int k = 0; k < 64; ++k) {
        const float w = w3[k * 512 + c2];
        const float* hp = h2 + k * 64 + g * 16;
        float4 v0 = *(const float4*)(hp), v1 = *(const float4*)(hp + 4), v2 = *(const float4*)(hp + 8), v3 = *(const float4*)(hp + 12);
        acc[0] += v0.x * w; acc[1] += v0.y * w; acc[2] += v0.z * w; acc[3] += v0.w * w;
        acc[4] += v1.x * w; acc[5] += v1.y * w; acc[6] += v1.z * w; acc[7] += v1.w * w;
        acc[8] += v2.x * w; acc[9] += v2.y * w; acc[10] += v2.z * w; acc[11] += v2.w * w;
        acc[12] += v3.x * w; acc[13] += v3.y * w; acc[14] += v3.z * w; acc[15] += v3.w * w;
      }
#pragma unroll
      for (int j = 0; j < 16; ++j) {
        int pp = p0 + g * 16 + j;
        float tt = (float)pp / (float)(n - 1);
        float val = acc[j] * expf(-tt * dl);
        bool used = !(bwd && pp == n - 1);
        if (used) ssq += val * val;
        if (lat) {
          if (!bwd) rk[OFFC - pp] = f2bf(val);
          else if (used) rk[OFFC + pp + 1] = f2bf(val);
        } else {
          hfc[pp * 512 + c2] = val;
        }
      }
    }
    ((float*)(p->ws + O_HPART))[fi * 512 + c2] = ssq;
  }
  if (fi == 0) {
    u16* rkg = (u16*)(p->ws + O_RKG);
    for (int it = tid; it < 256 * 257; it += NT) {
      int c = it / 257, e = it % 257;
      int idx = e < 25 ? e : 32792 + (e - 25);
      rkg[(size_t)c * RKROW + idx] = 0;
    }
  }
  __syncthreads();
}

template <int NR>
DI void row_opN(const int (&m)[NR], const float* const (&xs)[NR], float* const (&xd)[NR], const u16* Y, const float* gpost,
                const float* const (&modpost)[NR], int sub_post, float wgt, const float* gpre, const float* const (&modpre)[NR], int sub_pre, u16* H) {
  const int lane = tidx() & 63;
  float xa[NR][8], xb[NR][8], ya[NR][8], yb[NR][8];
#pragma unroll
  for (int q = 0; q < NR; ++q) {
    ld8f(xs[q] + lane * 8, xa[q]);
    ld8f(xs[q] + 512 + lane * 8, xb[q]);
    if (Y) {
      ld8(Y + (size_t)m[q] * 1024 + lane * 8, ya[q]);
      ld8(Y + (size_t)m[q] * 1024 + 512 + lane * 8, yb[q]);
    }
  }
  if (Y) {
    float ss[NR];
#pragma unroll
    for (int q = 0; q < NR; ++q) {
      ss[q] = 0.f;
#pragma unroll
      for (int j = 0; j < 8; ++j) ss[q] += ya[q][j] * ya[q][j] + yb[q][j] * yb[q][j];
    }
#pragma unroll
    for (int o = 32; o; o >>= 1)
#pragma unroll
      for (int q = 0; q < NR; ++q) ss[q] += __shfl_xor(ss[q], o);
    float gp0[8], gp1[8];
    ld8f(gpost + lane * 8, gp0); ld8f(gpost + 512 + lane * 8, gp1);
#pragma unroll
    for (int q = 0; q < NR; ++q) {
      const float rs = rsqrtf(ss[q] * (1.f / 1024.f) + 1e-6f);
      const float* gate = modpost[q] + (sub_post * 3 + 2) * 1024;
      float g[8];
      ld8f(gate + lane * 8, g);
#pragma unroll
      for (int j = 0; j < 8; ++j) xa[q][j] += wgt * g[j] * (ya[q][j] * rs * gp0[j]);
      ld8f(gate + 512 + lane * 8, g);
#pragma unroll
      for (int j = 0; j < 8; ++j) xb[q][j] += wgt * g[j] * (yb[q][j] * rs * gp1[j]);
    }
  }
#pragma unroll
  for (int q = 0; q < NR; ++q)
    if (xd[q]) {
      *(float4*)(xd[q] + lane * 8) = make_float4(xa[q][0], xa[q][1], xa[q][2], xa[q][3]);
      *(float4*)(xd[q] + lane * 8 + 4) = make_float4(xa[q][4], xa[q][5], xa[q][6], xa[q][7]);
      *(float4*)(xd[q] + 512 + lane * 8) = make_float4(xb[q][0], xb[q][1], xb[q][2], xb[q][3]);
      *(float4*)(xd[q] + 512 + lane * 8 + 4) = make_float4(xb[q][4], xb[q][5], xb[q][6], xb[q][7]);
    }
  if (gpre) {
    float ss[NR];
#pragma unroll
    for (int q = 0; q < NR; ++q) {
      ss[q] = 0.f;
#pragma unroll
      for (int j = 0; j < 8; ++j) ss[q] += xa[q][j] * xa[q][j] + xb[q][j] * xb[q][j];
    }
#pragma unroll
    for (int o = 32; o; o >>= 1)
#pragma unroll
      for (int q = 0; q < NR; ++q) ss[q] += __shfl_xor(ss[q], o);
    float g0[8], g1[8];
    ld8f(gpre + lane * 8, g0); ld8f(gpre + 512 + lane * 8, g1);
#pragma unroll
    for (int q = 0; q < NR; ++q) {
      const float rs = rsqrtf(ss[q] * (1.f / 1024.f) + 1e-6f);
      const float* shift = modpre[q] + (sub_pre * 3 + 0) * 1024;
      const float* scale = modpre[q] + (sub_pre * 3 + 1) * 1024;
      float sc[8], sh[8], hv[8];
      ld8f(scale + lane * 8, sc); ld8f(shift + lane * 8, sh);
#pragma unroll
      for (int j = 0; j < 8; ++j) hv[j] = xa[q][j] * rs * g0[j] * (1.f + sc[j]) + sh[j];
      st8(H + (size_t)m[q] * 1024 + lane * 8, hv);
      ld8f(scale + 512 + lane * 8, sc); ld8f(shift + 512 + lane * 8, sh);
#pragma unroll
      for (int j = 0; j < 8; ++j) hv[j] = xb[q][j] * rs * g1[j] * (1.f + sc[j]) + sh[j];
      st8(H + (size_t)m[q] * 1024 + 512 + lane * 8, hv);
    }
  }
}
DI void row_op(CP p, int m, const float* xs, float* xd, const u16* Y, const float* gpost, const float* modpost, int sub_post,
               float wgt, const float* gpre, const float* modpre, int sub_pre, u16* H) {
  const int mm[1] = {m};
  const float* const xss[1] = {xs};
  float* const xdd[1] = {xd};
  const float* const mp[1] = {modpost};
  const float* const mq[1] = {modpre};
  row_opN<1>(mm, xss, xdd, Y, gpost, mp, sub_post, wgt, gpre, mq, sub_pre, H);
}

DI void row_dispatch(CP p, int l, int kind, int m) {
  const float* MOD = (const float*)(p->ws + O_MOD);
  const int mi = mod_index(m);
  const float* modl = MOD + (size_t)l * 27648 + mi * 9216;
  float* xc = (float*)(p->ws + O_XC);
  float* xcur = (m < ML) ? p->out + (size_t)m * 1024 : xc + (size_t)(m - ML) * 1024;
  const float* xin = (m < ML) ? p->in[0] + (size_t)m * 1024 : p->in[2] + (size_t)(m - ML) * 1024;
  u16* H = (u16*)(p->ws + O_H);
  const float* npre = p->in[6] + (size_t)l * 3 * 1024;
  const float* npost = p->in[7] + (size_t)l * 3 * 1024;
  if (kind == 0) {
    row_op(p, m, xin, nullptr, nullptr, nullptr, nullptr, 0, 0.f, npre, modl, 0, H);
  } else if (kind == 1) {
    const float* xs = (l == 0) ? xin : xcur;
    row_op(p, m, xs, xcur, (const u16*)(p->ws + S_Y), npost, modl, 0, 0.5f, npre + 1024, modl, 1, H);
  } else if (kind == 2) {
    row_op(p, m, xcur, xcur, (const u16*)(p->ws + S_YM), npost + 1024, modl, 1, 1.0f, npre + 2048, modl, 2, H);
  } else {
    if (l == 0) {
      const float* modn = MOD + (size_t)1 * 27648 + mi * 9216;
      row_op(p, m, xcur, xcur, (const u16*)(p->ws + S_Y), npost + 2048, modl, 2, 0.5f, p->in[6] + 3 * 1024, modn, 0, H);
    } else {
      row_op(p, m, xcur, xcur, (const u16*)(p->ws + S_Y), npost + 2048, modl, 2, 0.5f, nullptr, nullptr, 0, nullptr);
    }
  }
}
DI void row_dispatch2(CP p, int l, int kind, int m0, int m1) {
  const float* MOD = (const float*)(p->ws + O_MOD);
  float* xc = (float*)(p->ws + O_XC);
  const int mm[2] = {m0, m1};
  const float* modl[2]; const float* modn[2]; float* xcur[2]; const float* xin[2];
#pragma unroll
  for (int q = 0; q < 2; ++q) {
    const int m = mm[q], mi = mod_index(m);
    modl[q] = MOD + (size_t)l * 27648 + mi * 9216;
    modn[q] = MOD + (size_t)1 * 27648 + mi * 9216;
    xcur[q] = (m < ML) ? p->out + (size_t)m * 1024 : xc + (size_t)(m - ML) * 1024;
    xin[q] = (m < ML) ? p->in[0] + (size_t)m * 1024 : p->in[2] + (size_t)(m - ML) * 1024;
  }
  u16* H = (u16*)(p->ws + O_H);
  const float* npre = p->in[6] + (size_t)l * 3 * 1024;
  const float* npost = p->in[7] + (size_t)l * 3 * 1024;
  const float* const ml[2] = {modl[0], modl[1]};
  const float* const mn[2] = {modn[0], modn[1]};
  float* const xd[2] = {xcur[0], xcur[1]};
  const float* const xsc[2] = {xcur[0], xcur[1]};
  const float* const xsi[2] = {xin[0], xin[1]};
  if (kind == 1) {
    if (l == 0) row_opN<2>(mm, xsi, xd, (const u16*)(p->ws + S_Y), npost, ml, 0, 0.5f, npre + 1024, ml, 1, H);
    else row_opN<2>(mm, xsc, xd, (const u16*)(p->ws + S_Y), npost, ml, 0, 0.5f, npre + 1024, ml, 1, H);
  } else if (kind == 2) {
    row_opN<2>(mm, xsc, xd, (const u16*)(p->ws + S_YM), npost + 1024, ml, 1, 1.0f, npre + 2048, ml, 2, H);
  } else {
    if (l == 0) row_opN<2>(mm, xsc, xd, (const u16*)(p->ws + S_Y), npost + 2048, ml, 2, 0.5f, p->in[6] + 3 * 1024, mn, 0, H);
    else row_opN<2>(mm, xsc, xd, (const u16*)(p->ws + S_Y), npost + 2048, ml, 2, 0.5f, nullptr, mn, 0, nullptr);
  }
}
DI void ph_rows(CP p, int l, int kind, int mlim = M) {
  const int wave = tidx() >> 6;
  const int stride = gridDim.x * 8;
  int m = blockIdx.x * 8 + wave;
  for (; m + stride < mlim; m += 2 * stride) row_dispatch2(p, l, kind, m, m + stride);
  if (m < mlim) row_dispatch(p, l, kind, m);
}

template <int BM, int WNT>
DI void gemm_main(const u16* __restrict__ A, int lda, const u16* __restrict__ BT, int K, int m0, int n0, char* lds,
                  f32x16 (&acc)[2][WNT]) {
  constexpr int AE = BM / 64;
  constexpr int STG = (BM + 128) * 144;
  constexpr int WN = 32 * WNT;
  const int tid = tidx(), lane = tid & 63, wave = tid >> 6, r = lane & 31, h = lane >> 5;
  const int wm = (BM == 256) ? (wave >> 1) : (wave >> 2);
  const int wn = (BM == 256) ? (wave & 1) : (wave & 3);
  const int KT = K >> 6;
  uint4 ra0, ra1, ra2 = make_uint4(0, 0, 0, 0), ra3 = make_uint4(0, 0, 0, 0), rb0, rb1;
  const u16* Ap = A + (size_t)(m0 + (tid >> 3)) * lda + (tid & 7) * 8;
  const u16* Bp = BT + (size_t)(n0 + (tid >> 3)) * K + (tid & 7) * 8;
  const size_t astr = (size_t)64 * lda, bstr = (size_t)64 * K;
  ra0 = *(const uint4*)(Ap); ra1 = *(const uint4*)(Ap + astr);
  if constexpr (AE == 4) { ra2 = *(const uint4*)(Ap + 2 * astr); ra3 = *(const uint4*)(Ap + 3 * astr); }
  rb0 = *(const uint4*)(Bp); rb1 = *(const uint4*)(Bp + bstr);
  const int sto = (tid >> 3) * 144 + (tid & 7) * 16;
  {
    char* sn = lds;
    *(uint4*)(sn + sto) = ra0; *(uint4*)(sn + sto + 64 * 144) = ra1;
    if constexpr (AE == 4) { *(uint4*)(sn + sto + 128 * 144) = ra2; *(uint4*)(sn + sto + 192 * 144) = ra3; }
    *(uint4*)(sn + BM * 144 + sto) = rb0; *(uint4*)(sn + BM * 144 + sto + 64 * 144) = rb1;
  }
  __syncthreads();
  const int aoff = (64 * wm + r) * 144 + 16 * h;
  const int boff = BM * 144 + (WN * wn + r) * 144 + 16 * h;
#pragma unroll 1
  for (int kt = 0; kt < KT; ++kt) {
    const bool more = kt + 1 < KT;
    if (more) {
      const int ko = (kt + 1) * 64;
      ra0 = *(const uint4*)(Ap + ko); ra1 = *(const uint4*)(Ap + astr + ko);
      if constexpr (AE == 4) { ra2 = *(const uint4*)(Ap + 2 * astr + ko); ra3 = *(const uint4*)(Ap + 3 * astr + ko); }
      rb0 = *(const uint4*)(Bp + ko); rb1 = *(const uint4*)(Bp + bstr + ko);
    }
    const char* sbase = lds + (kt & 1) * STG;
#pragma unroll
    for (int s = 0; s < 4; ++s) {
      bf16x8 a0 = *(const bf16x8*)(sbase + aoff + s * 32);
      bf16x8 a1 = *(const bf16x8*)(sbase + aoff + 32 * 144 + s * 32);
      bf16x8 b0 = *(const bf16x8*)(sbase + boff + s * 32);
      acc[0][0] = MFMA32(a0, b0, acc[0][0]);
      acc[1][0] = MFMA32(a1, b0, acc[1][0]);
      if constexpr (WNT == 2) {
        bf16x8 b1 = *(const bf16x8*)(sbase + boff + 32 * 144 + s * 32);
        acc[0][1] = MFMA32(a0, b1, acc[0][1]);
        acc[1][1] = MFMA32(a1, b1, acc[1][1]);
      }
    }
    if (more) {
      char* sn = lds + ((kt + 1) & 1) * STG;
      *(uint4*)(sn + sto) = ra0; *(uint4*)(sn + sto + 64 * 144) = ra1;
      if constexpr (AE == 4) { *(uint4*)(sn + sto + 128 * 144) = ra2; *(uint4*)(sn + sto + 192 * 144) = ra3; }
      *(uint4*)(sn + BM * 144 + sto) = rb0; *(uint4*)(sn + BM * 144 + sto + 64 * 144) = rb1;
    }
    __syncthreads();
  }
}
template <int WNT> DI void zero_acc(f32x16 (&acc)[2][WNT]) {
#pragma unroll
  for (int a = 0; a < 2; ++a)
#pragma unroll
    for (int b = 0; b < WNT; ++b)
#pragma unroll
      for (int i = 0; i < 16; ++i) acc[a][b][i] = 0.f;
}
DI void store_tile_pk(const f32x16& v, u16* C, int ldc, int row0, int col0, int r, int h) {
  const bool odd = r & 1;
#pragma unroll
  for (int i = 0; i < 16; i += 2) {
    float t0 = dppf<0xB1>(v[i]);
    float t1 = dppf<0xB1>(v[i + 1]);
    u32 w = odd ? pk2(t1, v[i + 1]) : pk2(v[i], t0);
    int row = row0 + (odd ? crow(i + 1, h) : crow(i, h));
    *(u32*)(C + (size_t)row * ldc + col0 + (r & ~1)) = w;
  }
}
template <int BM, int WNT>
DI void store_bf16(const f32x16 (&acc)[2][WNT], u16* C, int ldc, int m0, int n0) {
  const int lane = tidx() & 63, wave = tidx() >> 6, r = lane & 31, h = lane >> 5;
  const int wm = (BM == 256) ? (wave >> 1) : (wave >> 2);
  const int wn = (BM == 256) ? (wave & 1) : (wave & 3);
#pragma unroll
  for (int mt = 0; mt < 2; ++mt)
#pragma unroll
    for (int nt = 0; nt < WNT; ++nt)
      store_tile_pk(acc[mt][nt], C, ldc, m0 + 64 * wm + 32 * mt, n0 + 32 * WNT * wn + 32 * nt, r, h);
}
DI void gemm_main_256(const u16* __restrict__ A, int lda, const u16* __restrict__ BT, int K, int m0, int n0, char* lds,
                      f32x16 (&acc)[4][2]) {
  constexpr int STG = 512 * 144;
  const int tid = tidx(), lane = tid & 63, wave = tid >> 6, r = lane & 31, h = lane >> 5;
  const int wm = wave >> 2, wn = wave & 3;
  const int KT = K >> 6;
  const u16* Ap = A + (size_t)(m0 + (tid >> 3)) * lda + (tid & 7) * 8;
  const u16* Bp = BT + (size_t)(n0 + (tid >> 3)) * K + (tid & 7) * 8;
  const size_t astr = (size_t)64 * lda, bstr = (size_t)64 * K;
  uint4 ra0, ra1, ra2, ra3, rb0, rb1, rb2, rb3;
  ra0 = *(const uint4*)(Ap); ra1 = *(const uint4*)(Ap + astr); ra2 = *(const uint4*)(Ap + 2 * astr); ra3 = *(const uint4*)(Ap + 3 * astr);
  rb0 = *(const uint4*)(Bp); rb1 = *(const uint4*)(Bp + bstr); rb2 = *(const uint4*)(Bp + 2 * bstr); rb3 = *(const uint4*)(Bp + 3 * bstr);
  const int sto = (tid >> 3) * 144 + (tid & 7) * 16;
  {
    char* sn = lds;
    *(uint4*)(sn + sto) = ra0; *(uint4*)(sn + sto + 64 * 144) = ra1; *(uint4*)(sn + sto + 128 * 144) = ra2; *(uint4*)(sn + sto + 192 * 144) = ra3;
    sn += 256 * 144;
    *(uint4*)(sn + sto) = rb0; *(uint4*)(sn + sto + 64 * 144) = rb1; *(uint4*)(sn + sto + 128 * 144) = rb2; *(uint4*)(sn + sto + 192 * 144) = rb3;
  }
  __syncthreads();
  const int aoff = (128 * wm + r) * 144 + 16 * h;
  const int boff = 256 * 144 + (64 * wn + r) * 144 + 16 * h;
#pragma unroll 1
  for (int kt = 0; kt < KT; ++kt) {
    const bool more = kt + 1 < KT;
    if (more) {
      const int ko = (kt + 1) * 64;
      ra0 = *(const uint4*)(Ap + ko); ra1 = *(const uint4*)(Ap + astr + ko); ra2 = *(const uint4*)(Ap + 2 * astr + ko); ra3 = *(const uint4*)(Ap + 3 * astr + ko);
      rb0 = *(const uint4*)(Bp + ko); rb1 = *(const uint4*)(Bp + bstr + ko); rb2 = *(const uint4*)(Bp + 2 * bstr + ko); rb3 = *(const uint4*)(Bp + 3 * bstr + ko);
    }
    const char* sbase = lds + (kt & 1) * STG;
#pragma unroll
    for (int s = 0; s < 4; ++s) {
      bf16x8 b0 = *(const bf16x8*)(sbase + boff + s * 32);
      bf16x8 b1 = *(const bf16x8*)(sbase + boff + 32 * 144 + s * 32);
#pragma unroll
      for (int mt = 0; mt < 4; ++mt) {
        bf16x8 a = *(const bf16x8*)(sbase + aoff + mt * 32 * 144 + s * 32);
        acc[mt][0] = MFMA32(a, b0, acc[mt][0]);
        acc[mt][1] = MFMA32(a, b1, acc[mt][1]);
      }
    }
    if (more) {
      char* sn = lds + ((kt + 1) & 1) * STG;
      *(uint4*)(sn + sto) = ra0; *(uint4*)(sn + sto + 64 * 144) = ra1; *(uint4*)(sn + sto + 128 * 144) = ra2; *(uint4*)(sn + sto + 192 * 144) = ra3;
      sn += 256 * 144;
      *(uint4*)(sn + sto) = rb0; *(uint4*)(sn + sto + 64 * 144) = rb1; *(uint4*)(sn + sto + 128 * 144) = rb2; *(uint4*)(sn + sto + 192 * 144) = rb3;
    }
    __syncthreads();
  }
}
template <int BM, int WNT>
DI void gemm_bf16_tile(const u16* A, int lda, const u16* BT, int K, u16* C, int ldc, int m0, int n0, char* lds) {
  f32x16 acc[2][WNT];
  zero_acc<WNT>(acc);
  gemm_main<BM, WNT>(A, lda, BT, K, m0, n0, lds, acc);
  store_bf16<BM, WNT>(acc, C, ldc, m0, n0);
}

typedef float f32x4v __attribute__((ext_vector_type(4)));
#define LAS3 __attribute__((address_space(3)))
DI int g8_lds_byte(int r, int c) {
  int st = (r >> 4) * 2 + (c >> 5), rr = r & 15, cc = c & 31, ob = rr * 64 + cc * 2;
  return st * 1024 + (ob ^ (((ob >> 9) & 1) << 5));
}
DI void g8_stage_rc(int b, int& R, int& C) {
  int st = b / 1024, sb = b % 1024, swz = sb ^ (((sb >> 9) & 1) << 5);
  R = (st >> 1) * 16 + swz / 64; C = (st & 1) * 32 + (swz % 64) / 2;
}
DI void gemm8p(const u16* __restrict__ A, const u16* __restrict__ Bt, int K, int brow, int bcol, char* shmc,
               f32x4v (&acc)[2][2][4][2]) {
  constexpr int BK = 64, HALF = 128, HT = HALF * BK;
  u16* shm = (u16*)shmc;
  const int tid = tidx();
#define G8_SA(b, h) (shm + ((b) * 2 + (h)) * HT)
#define G8_SB(b, h) (shm + (4 + (b) * 2 + (h)) * HT)
  int g8_off0, g8_off1;
  { int _r, _c; g8_stage_rc(tid * 16, _r, _c); g8_off0 = _r * K + _c; g8_stage_rc(tid * 16 + 8192, _r, _c); g8_off1 = _r * K + _c; }
#define G8_STAGE(P, BASE, br, kt) do { const u16* _gb = (BASE) + ((long)(br) * K + (long)(kt) * BK); \
      __builtin_amdgcn_global_load_lds((const unsigned*)(_gb + g8_off0), (LAS3 unsigned*)((char*)(P) + tid * 16), 16, 0, 0); \
      __builtin_amdgcn_global_load_lds((const unsigned*)(_gb + g8_off1), (LAS3 unsigned*)((char*)(P) + tid * 16 + 8192), 16, 0, 0); } while (0)
#define G8_LDA(dst, b, h) _Pragma("unroll") for (int m = 0; m < 4; ++m) _Pragma("unroll") for (int k = 0; k < 2; ++k) \
    dst[m][k] = *reinterpret_cast<const bf16x8*>((char*)G8_SA(b, h) + g8_lds_byte(wr * 64 + m * 16 + fr, k * 32 + fq * 8))
#define G8_LDB(dst, b, h) _Pragma("unroll") for (int n = 0; n < 2; ++n) _Pragma("unroll") for (int k = 0; k < 2; ++k) \
    dst[n][k] = *reinterpret_cast<const bf16x8*>((char*)G8_SB(b, h) + g8_lds_byte(wc * 32 + n * 16 + fr, k * 32 + fq * 8))
#define G8_MMA(ai, bj, At_, Bt_) do { __builtin_amdgcn_s_setprio(1); \
    _Pragma("unroll") for (int m = 0; m < 4; ++m) _Pragma("unroll") for (int n = 0; n < 2; ++n) _Pragma("unroll") for (int k = 0; k < 2; ++k) \
      acc[ai][bj][m][n] = __builtin_amdgcn_mfma_f32_16x16x32_bf16(At_[m][k], Bt_[n][k], acc[ai][bj][m][n], 0, 0, 0); \
    __builtin_amdgcn_s_setprio(0); } while (0)
#define G8_WAIT_V(n) asm volatile("s_waitcnt vmcnt(" #n ")" ::: "memory")
#define G8_WAIT_L(n) asm volatile("s_waitcnt lgkmcnt(" #n ")" ::: "memory")
#define G8_BAR __builtin_amdgcn_s_barrier()
#define G8_SCHED __builtin_amdgcn_sched_barrier(0)
  const int wid = tid >> 6, lane = tid & 63, wr = wid >> 2, wc = wid & 3, fr = lane & 15, fq = lane >> 4;
  bf16x8 At[4][2], B0[2][2], B1[2][2];
  const int nt = K / BK;
  G8_STAGE(G8_SB(0, 0), Bt, bcol, 0); G8_STAGE(G8_SA(0, 0), A, brow, 0);
  G8_STAGE(G8_SB(0, 1), Bt, bcol + HALF, 0); G8_STAGE(G8_SA(0, 1), A, brow + HALF, 0);
  if (wr == 1) G8_BAR;
  G8_WAIT_V(4); G8_BAR;
  G8_STAGE(G8_SB(1, 0), Bt, bcol, 1); G8_STAGE(G8_SA(1, 0), A, brow, 1); G8_STAGE(G8_SB(1, 1), Bt, bcol + HALF, 1);
  G8_WAIT_V(6); G8_BAR;
#pragma unroll 1
  for (int t = 0; t < nt - 2; t += 2) {
    G8_LDB(B0, 0, 0); G8_SCHED; G8_LDA(At, 0, 0); G8_STAGE(G8_SA(1, 1), A, brow + HALF, t + 1);
    G8_WAIT_L(8); G8_BAR; G8_WAIT_L(0); G8_MMA(0, 0, At, B0); G8_BAR; G8_SCHED;
    G8_LDB(B1, 0, 1); G8_STAGE(G8_SB(0, 0), Bt, bcol, t + 2);
    G8_BAR; G8_WAIT_L(0); G8_MMA(0, 1, At, B1); G8_BAR;
    G8_LDA(At, 0, 1); G8_STAGE(G8_SA(0, 0), A, brow, t + 2);
    G8_BAR; G8_WAIT_L(0); G8_MMA(1, 0, At, B0); G8_BAR; G8_SCHED;
    G8_STAGE(G8_SB(0, 1), Bt, bcol + HALF, t + 2);
    G8_WAIT_V(6); G8_BAR; G8_MMA(1, 1, At, B1); G8_BAR;
    G8_LDB(B0, 1, 0); G8_SCHED; G8_LDA(At, 1, 0); G8_STAGE(G8_SA(0, 1), A, brow + HALF, t + 2);
    G8_WAIT_L(8); G8_BAR; G8_WAIT_L(0); G8_MMA(0, 0, At, B0); G8_BAR; G8_SCHED;
    G8_LDB(B1, 1, 1); G8_STAGE(G8_SB(1, 0), Bt, bcol, t + 3);
    G8_BAR; G8_WAIT_L(0); G8_MMA(0, 1, At, B1); G8_BAR;
    G8_LDA(At, 1, 1); G8_STAGE(G8_SA(1, 0), A, brow, t + 3);
    G8_BAR; G8_WAIT_L(0); G8_MMA(1, 0, At, B0); G8_BAR; G8_SCHED;
    G8_STAGE(G8_SB(1, 1), Bt, bcol + HALF, t + 3);
    G8_WAIT_V(6); G8_BAR; G8_MMA(1, 1, At, B1); G8_BAR;
  }
  { G8_LDB(B0, 0, 0); G8_LDA(At, 0, 0); G8_STAGE(G8_SA(1, 1), A, brow + HALF, nt - 1);
    G8_BAR; G8_WAIT_L(0); G8_MMA(0, 0, At, B0); G8_BAR;
    G8_LDB(B1, 0, 1); G8_BAR; G8_WAIT_L(0); G8_MMA(0, 1, At, B1); G8_BAR;
    G8_LDA(At, 0, 1); G8_WAIT_V(4); G8_BAR; G8_WAIT_L(0); G8_MMA(1, 0, At, B0); G8_MMA(1, 1, At, B1); G8_BAR; }
  { G8_LDB(B0, 1, 0); G8_LDA(At, 1, 0); G8_WAIT_V(2); G8_BAR; G8_WAIT_L(0); G8_MMA(0, 0, At, B0); G8_BAR;
    G8_LDB(B1, 1, 1); G8_WAIT_V(0); G8_BAR; G8_WAIT_L(0); G8_MMA(0, 1, At, B1); G8_BAR;
    G8_LDA(At, 1, 1); G8_BAR; G8_WAIT_L(0); G8_MMA(1, 0, At, B0); G8_MMA(1, 1, At, B1); G8_BAR; }
  if (wr == 0) G8_BAR;
}
DI void g8_store(const f32x4v& v, u16* C, int ldc, int row0, int col0, int fr, int fq) {
  const bool odd = fr & 1;
#pragma unroll
  for (int j = 0; j < 4; j += 2) {
    float t0 = dppf<0xB1>(v[j]);
    float t1 = dppf<0xB1>(v[j + 1]);
    u32 w = odd ? pk2(t1, v[j + 1]) : pk2(v[j], t0);
    int row = row0 + fq * 4 + j + (odd ? 1 : 0);
    *(u32*)(C + (size_t)row * ldc + col0 + (fr & ~1)) = w;
  }
}

DI int xcd_seq(int it) {
  if (gridDim.x != 256) return it;
  const int b = it & 255;
  return (it & ~255) + (b & 7) * 32 + (b >> 3);
}
DI void patch_mn(int q, int NM, int NN, int& mt, int& nt) {
  const int per = 4 * NN;
  const int g = q / per, rem = q - g * per;
  const int mrem = NM - 4 * g;
  const int mg = mrem < 4 ? mrem : 4;
  nt = rem / mg;
  mt = 4 * g + (rem - nt * mg);
}
DI void ph_ffn1(CP p, int f, char* smem, int nm = 130) {
  for (int it = blockIdx.x; it < 3072; it += gridDim.x) {
    CP q = p;
    asm volatile("" : "+s"(q));
    const u16* H = (const u16*)(q->ws + O_H);
    const u16* W = (const u16*)(q->ws + O_WFFN1) + (size_t)f * 5632 * 1024;
    const int t = xcd_seq(it);
    if (t >= nm * 22) continue;
    int mt_, nt_;
    patch_mn(t, nm, 22, mt_, nt_);
    const int brow = mt_ * 256, bcol = nt_ * 256;
    f32x4v acc[2][2][4][2];
#pragma unroll
    for (int a_ = 0; a_ < 2; ++a_)
#pragma unroll
      for (int b_ = 0; b_ < 2; ++b_)
#pragma unroll
        for (int m = 0; m < 4; ++m)
#pragma unroll
          for (int n = 0; n < 2; ++n) acc[a_][b_][m][n] = (f32x4v){0.f, 0.f, 0.f, 0.f};
    gemm8p(H, W, 1024, brow, bcol, smem, acc);
    asm volatile("" : "+s"(q));
    u16* ACT = (u16*)(q->ws + S_ACT);
    const int tid = tidx(), wid = tid >> 6, lane = tid & 63, wr = wid >> 2, wc = wid & 3, fr = lane & 15, fq = lane >> 4;
#pragma unroll
    for (int ai = 0; ai < 2; ++ai)
#pragma unroll
      for (int bj = 0; bj < 2; ++bj)
#pragma unroll
        for (int m = 0; m < 4; ++m) {
          f32x4v v;
#pragma unroll
          for (int j = 0; j < 4; ++j) {
            float a = acc[ai][bj][m][0][j], b = acc[ai][bj][m][1][j];
            v[j] = a * b * __builtin_amdgcn_rcpf(1.f + __expf(-a));
          }
          g8_store(v, ACT, DFF, brow + ai * 128 + wr * 64 + m * 16, (bcol + bj * 128 + wc * 32) / 2, fr, fq);
        }
  }
}
DI void g8_phase(CP p, size_t offA, size_t offB, size_t offC, int K, int NN, int ldc, char* smem, int nm = 130) {
  const int total = nm * NN;
  const int full = (gridDim.x == 256) ? (total & ~255) : total;
  for (int it = blockIdx.x; it < full; it += gridDim.x) {
    const int t = xcd_seq(it);
    int mt_, nt_;
    patch_mn(t, nm, NN, mt_, nt_);
    const int brow = mt_ * 256, bcol = nt_ * 256;
    CP q = p;
    asm volatile("" : "+s"(q));
    const u16* A = (const u16*)(q->ws + offA);
    const u16* Bt = (const u16*)(q->ws + offB);
    f32x4v acc[2][2][4][2];
#pragma unroll
    for (int a_ = 0; a_ < 2; ++a_)
#pragma unroll
      for (int b_ = 0; b_ < 2; ++b_)
#pragma unroll
        for (int m = 0; m < 4; ++m)
#pragma unroll
          for (int n = 0; n < 2; ++n) acc[a_][b_][m][n] = (f32x4v){0.f, 0.f, 0.f, 0.f};
    gemm8p(A, Bt, K, brow, bcol, smem, acc);
    asm volatile("" : "+s"(q));
    u16* C = (u16*)(q->ws + offC);
    const int tid = tidx(), wid = tid >> 6, lane = tid & 63, wr = wid >> 2, wc = wid & 3, fr = lane & 15, fq = lane >> 4;
#pragma unroll
    for (int ai = 0; ai < 2; ++ai)
#pragma unroll
      for (int bj = 0; bj < 2; ++bj)
#pragma unroll
        for (int m = 0; m < 4; ++m)
#pragma unroll
          for (int n = 0; n < 2; ++n)
            g8_store(acc[ai][bj][m][n], C, ldc, brow + ai * 128 + wr * 64 + m * 16, bcol + bj * 128 + wc * 32 + n * 16, fr, fq);
  }
  const int nsub = (total - full) * 4;
  for (int it = blockIdx.x; it < nsub; it += gridDim.x) {
    const int t = full + (it >> 2), sub = it & 3;
    int mt_, nt_;
    patch_mn(t, nm, NN, mt_, nt_);
    const int m0 = mt_ * 256 + (sub >> 1) * 128, n0 = nt_ * 256 + (sub & 1) * 128;
    gemm_bf16_tile<128, 1>((const u16*)(p->ws + offA), K, (const u16*)(p->ws + offB), K, (u16*)(p->ws + offC), ldc, m0, n0, smem);
  }
}
DI void ph_ffn2(CP p, int f, char* smem, int nm = 130) {
  g8_phase(p, S_ACT, O_WFFN2 + (size_t)f * 1024 * 2816 * 2, S_Y, DFF, 4, 1024, smem, nm);
}
DI void ph_t1(CP p, char* smem) { g8_phase(p, O_H, O_WIN, S_P, 1024, 12, PS, smem); }

DI void rope32(float (&x)[32], int row, int col) {
#pragma unroll
  for (int i = 0; i < 8; ++i) {
    float inv = rope_inv(i);
    float sr, cr, sc, cc;
    sr = __sinf((float)row * inv); cr = __cosf((float)row * inv);
    sc = __sinf((float)col * inv); cc = __cosf((float)col * inv);
    float a = x[i], b = x[i + 8];
    x[i] = a * cr - b * sr; x[i + 8] = b * cr + a * sr;
    float c = x[16 + i], d = x[24 + i];
    x[16 + i] = c * cc - d * sc; x[24 + i] = d * cc + c * sc;
  }
}
DI void ld32(const u16* p, float (&x)[32]) {
#pragma unroll
  for (int q = 0; q < 4; ++q) {
    uint4 v = *(const uint4*)(p + 8 * q);
    x[8 * q + 0] = __uint_as_float(v.x << 16); x[8 * q + 1] = __uint_as_float(v.x & 0xffff0000u);
    x[8 * q + 2] = __uint_as_float(v.y << 16); x[8 * q + 3] = __uint_as_float(v.y & 0xffff0000u);
    x[8 * q + 4] = __uint_as_float(v.z << 16); x[8 * q + 5] = __uint_as_float(v.z & 0xffff0000u);
    x[8 * q + 6] = __uint_as_float(v.w << 16); x[8 * q + 7] = __uint_as_float(v.w & 0xffff0000u);
  }
}
DI void st32(u16* p, const float (&x)[32]) {
#pragma unroll
  for (int q = 0; q < 4; ++q) {
    uint4 v;
    v.x = pk2(x[8 * q], x[8 * q + 1]); v.y = pk2(x[8 * q + 2], x[8 * q + 3]);
    v.z = pk2(x[8 * q + 4], x[8 * q + 5]); v.w = pk2(x[8 * q + 6], x[8 * q + 7]);
    *(uint4*)(p + 8 * q) = v;
  }
}

DI void t2a_tile(CP p, int l, int tl, char* smem) {
  const int tid = tidx();
  const int m0 = tl * 64;
  const bool lat = m0 < ML;
  int b, t0, n;
  if (lat) { b = m0 >> 14; t0 = m0 & 16383; n = 16384; } else { int mc = m0 - ML; b = mc >> 8; t0 = mc & 255; n = 256; }
  const int key0 = lat ? t0 : 16384 + t0;
  const u16* P = (const u16*)(p->ws + S_P);
  u16* Rb = (u16*)(p->ws + S_R); u16* KRAW = (u16*)(p->ws + S_KRAW); u16* Vb = (u16*)(p->ws + S_V); u16* KK = (u16*)(p->ws + S_KK);
  u16* LIN = (u16*)(p->ws + S_LIN); u16* CQN = (u16*)(p->ws + S_CQN); u16* CKVN = (u16*)(p->ws + S_CKVN);
  u16* KM = (u16*)(p->ws + S_KM); u16* QD = (u16*)(p->ws + O_QD); u16* KD = (u16*)(p->ws + O_KD); u16* VDT = (u16*)(p->ws + O_VDT);
  u16* ZT = (u16*)(p->ws + O_ZT); u16* X0T = (u16*)(p->ws + S_X0T);
  float* ZC = (float*)(p->ws + O_ZC); float* X0C = (float*)(p->ws + O_X0C);
  u16* zb = (u16*)smem;
  u16* xb = zb + 256 * 72;
  u16* vb = xb + 256 * 72;
  const float* mu = p->in[11] + l * 1152;
  const float* k_k = p->in[17] + l * 256;
#pragma unroll 1
  for (int e = 0; e < 18; ++e) {
    int it = tid + NT * e;
    int tok = it / 144, cg = it % 144;
    int t = t0 + tok, m = m0 + tok, c0 = cg * 8;
    const u16* pc = P + (size_t)m * PS + c0;
    float xc_[8], xp[8], xn[8], u[8], muv[8];
    ld8(pc, xc_);
    if (t > 0) ld8(pc - PS, xp); else {
#pragma unroll
      for (int j = 0; j < 8; ++j) xp[j] = 0.f;
    }
    if (t < n - 1) ld8(pc + PS, xn); else {
#pragma unroll
      for (int j = 0; j < 8; ++j) xn[j] = 0.f;
    }
    ld8f(mu + c0, muv);
#pragma unroll
    for (int j = 0; j < 8; ++j) u[j] = 0.5f * muv[j] * (xp[j] + xn[j]) + (1.f - muv[j]) * xc_[j];
    if (cg < 32) st8(Rb + (size_t)m * 256 + c0, u);
    else if (cg < 64) {
      int c = c0 - 256;
      st8(KRAW + (size_t)m * 256 + c, u);
      float kkv[8], kc[8];
      ld8f(k_k + c, kc);
      float ss = 0.f;
#pragma unroll
      for (int j = 0; j < 8; ++j) { kkv[j] = u[j] * kc[j]; ss += kkv[j] * kkv[j]; }
      ss = grp8_sum(ss);
      float inv = 1.f / fmaxf(sqrtf(ss), 1e-12f);
#pragma unroll
      for (int j = 0; j < 8; ++j) kkv[j] *= inv;
      st8(KK + (size_t)m * 256 + c, kkv);
    } else if (cg < 96) st8(Vb + (size_t)m * 256 + c0 - 512, u);
    else {
      int dst;
      if (cg < 112) { dst = 256 + c0 - 768;
#pragma unroll
        for (int j = 0; j < 8; ++j) u[j] = sigmoidf_(u[j]);
      } else if (cg < 120) { dst = c0 - 896;
#pragma unroll
        for (int j = 0; j < 8; ++j) u[j] = tanhf_(u[j]);
      } else if (cg < 128) { dst = 128 + c0 - 960;
#pragma unroll
        for (int j = 0; j < 8; ++j) u[j] = tanhf_(u[j]);
      } else if (cg < 136) dst = 64 + c0 - 1024;
      else dst = 192 + c0 - 1088;
      st8(LIN + (size_t)m * 384 + dst, u);
    }
  }
  const float* cw = p->in[22] + l * 3 * 768;
  const float* cb = p->in[23] + l * 768;
#pragma unroll 1
  for (int e = 0; e < 4; ++e) {
    int it = tid + NT * e;
    int tok = it >> 5, cg = it & 31;
    int t = t0 + tok, m = m0 + tok, c0 = cg * 8;
    float uu[3][8];
#pragma unroll
    for (int s = 0; s < 3; ++s) {
      int col = s * 256 + c0;
      const u16* pc = P + (size_t)m * PS + 1152 + col;
      float xc_[8], xp[8], xn[8], w0[8], w1[8], w2[8], bb[8];
      ld8(pc, xc_);
      if (t > 0) ld8(pc - PS, xp); else {
#pragma unroll
        for (int j = 0; j < 8; ++j) xp[j] = 0.f;
      }
      if (t < n - 1) ld8(pc + PS, xn); else {
#pragma unroll
        for (int j = 0; j < 8; ++j) xn[j] = 0.f;
      }
      ld8f(cw + col, w0); ld8f(cw + 768 + col, w1); ld8f(cw + 1536 + col, w2); ld8f(cb + col, bb);
#pragma unroll
      for (int j = 0; j < 8; ++j) uu[s][j] = xp[j] * w0[j] + xc_[j] * w1[j] + xn[j] * w2[j] + bb[j];
    }
    if (lat) {
#pragma unroll
      for (int j = 0; j < 8; ++j) {
        zb[(c0 + j) * 72 + tok] = f2bf(uu[2][j] * uu[1][j]);
        xb[(c0 + j) * 72 + tok] = f2bf(uu[0][j]);
      }
    } else {
      int mc = m - ML;
#pragma unroll
      for (int j = 0; j < 8; ++j) { ZC[mc * 256 + c0 + j] = uu[2][j] * uu[1][j]; X0C[mc * 256 + c0 + j] = uu[0][j]; }
    }
    uint4 vv = *(const uint4*)(P + (size_t)m * PS + 2784 + c0);
    const u16* vs = (const u16*)&vv;
#pragma unroll
    for (int j = 0; j < 8; ++j) vb[(c0 + j) * 72 + tok] = vs[j];
  }
  {
    int tok = tid >> 3, sub = tid & 7;
    int m = m0 + tok;
    const u16* pr = P + (size_t)m * PS;
    {
      float v[24];
#pragma unroll
      for (int q = 0; q < 3; ++q) ld8(pr + 1920 + 24 * sub + 8 * q, *(float(*)[8])&v[8 * q]);
      float ss = 0.f;
#pragma unroll
      for (int j = 0; j < 24; ++j) ss += v[j] * v[j];
      ss = grp8_sum(ss);
      float rs = rsqrtf(ss * (1.f / 192.f) + 1e-6f);
      const float* g = p->in[32] + l * 192 + 24 * sub;
#pragma unroll
      for (int q = 0; q < 3; ++q) {
        float o[8];
#pragma unroll
        for (int j = 0; j < 8; ++j) o[j] = v[8 * q + j] * rs * g[8 * q + j];
        st8(CQN + (size_t)m * 192 + 24 * sub + 8 * q, o);
      }
    }
    {
      float v[16];
#pragma unroll
      for (int q = 0; q < 2; ++q) ld8(pr + 2112 + 16 * sub + 8 * q, *(float(*)[8])&v[8 * q]);
      float ss = 0.f;
#pragma unroll
      for (int j = 0; j < 16; ++j) ss += v[j] * v[j];
      ss = grp8_sum(ss);
      float rs = rsqrtf(ss * (1.f / 128.f) + 1e-6f);
      const float* g = p->in[34] + l * 128 + 16 * sub;
#pragma unroll
      for (int q = 0; q < 2; ++q) {
        float o[8];
#pragma unroll
        for (int j = 0; j < 8; ++j) o[j] = v[8 * q + j] * rs * g[8 * q + j];
        st8(CKVN + (size_t)m * 128 + 16 * sub + 8 * q, o);
      }
    }
  }
  if (tid < 64) {
    int tok = tid, m = m0 + tok, t = t0 + tok;
    float x[32];
    ld32(P + (size_t)m * PS + 2240, x);
    if (lat) rope32(x, t >> 6, t & 63);
#pragma unroll
    for (int hh = 0; hh < 4; ++hh) st32(KM + ((size_t)(b * 4 + hh) * TK + key0 + tok) * 96 + 64, x);
  }
  {
    int tok = tid >> 3, h8 = tid & 7;
    int m = m0 + tok, t = t0 + tok;
    float x[32];
    ld32(P + (size_t)m * PS + 2272 + 32 * h8, x);
    if (lat) rope32(x, t >> 6, t & 63);
    const float sc = 0.17677669529663687f * 1.4426950408889634f;
#pragma unroll
    for (int j = 0; j < 32; ++j) x[j] *= sc;
    st32(QD + ((size_t)(b * 8 + h8) * TK + key0 + tok) * 32, x);
    ld32(P + (size_t)m * PS + 2528 + 32 * h8, x);
    if (lat) rope32(x, t >> 6, t & 63);
    st32(KD + ((size_t)(b * 8 + h8) * TK + key0 + tok) * 32, x);
  }
  __syncthreads();
#pragma unroll 1
  for (int e = 0; e < 4; ++e) {
    int id = tid + NT * e;
    int ch = id >> 3, tc8 = id & 7;
    if (lat) {
      *(uint4*)(ZT + ((size_t)ch * 2 + b) * 16384 + t0 + 8 * tc8) = *(const uint4*)(zb + ch * 72 + 8 * tc8);
      *(uint4*)(X0T + ((size_t)ch * 2 + b) * 16384 + t0 + 8 * tc8) = *(const uint4*)(xb + ch * 72 + 8 * tc8);
    }
    *(uint4*)(VDT + ((size_t)b * 256 + ch) * TK + key0 + 8 * tc8) = *(const uint4*)(vb + ch * 72 + 8 * tc8);
  }
  __syncthreads();
}

DI void ph_t2b(CP p, char* smem) {
  const u16* LIN = (const u16*)(p->ws + S_LIN);
  u16* LOUT = (u16*)(p->ws + S_LOUT);
  for (int t = blockIdx.x; t < 130 * 17; t += gridDim.x) {
    int m0 = (t / 17) * 256, j = t % 17;
    if (j < 10) {
      int g = j >> 1, n0 = (j & 1) * 128;
      const u16* A; const u16* BT; int K;
      if (g == 0) { A = LIN; BT = (const u16*)(p->ws + O_W2); K = 64; }
      else if (g == 1) { A = LIN + 64; BT = (const u16*)(p->ws + O_A2); K = 64; }
      else if (g == 2) { A = LIN + 128; BT = (const u16*)(p->ws + O_W2) + 256 * 64; K = 64; }
      else if (g == 3) { A = LIN + 192; BT = (const u16*)(p->ws + O_A2) + 256 * 64; K = 64; }
      else { A = LIN + 256; BT = (const u16*)(p->ws + O_G2); K = 128; }
      gemm_bf16_tile<256, 2>(A, 384, BT, K, LOUT + g * 256, 1280, m0, n0, smem);
    } else if (j < 13) {
      gemm_bf16_tile<256, 2>((const u16*)(p->ws + S_CQN), 192, (const u16*)(p->ws + O_WQB), 192, (u16*)(p->ws + S_QRAW), 384, m0, (j - 10) * 128, smem);
    } else {
      gemm_bf16_tile<256, 2>((const u16*)(p->ws + S_CKVN), 128, (const u16*)(p->ws + O_WKVB), 128, (u16*)(p->ws + S_KVRAW), 512, m0, (j - 13) * 128, smem);
    }
  }
}

DI void t2c_tile(CP p, int l, int tl, char* smem) {
  const int tid = tidx();
  const int m0 = tl * 64;
  const bool lat = m0 < ML;
  int b, t0;
  if (lat) { b = m0 >> 14; t0 = m0 & 16383; } else { int mc = m0 - ML; b = mc >> 8; t0 = mc & 255; }
  const int key0 = lat ? t0 : 16384 + t0;
  const u16* QRAW = (const u16*)(p->ws + S_QRAW);
  const u16* KVRAW = (const u16*)(p->ws + S_KVRAW);
  u16* QM = (u16*)(p->ws + S_QM); u16* KM = (u16*)(p->ws + S_KM); u16* VMT = (u16*)(p->ws + S_VMT);
  u16* vb = (u16*)smem;
  if (tid < 256) {
    int tok = tid >> 2, hh = tid & 3;
    int m = m0 + tok, t = t0 + tok;
    const u16* src = QRAW + (size_t)m * 384 + 96 * hh;
    u16* dst = QM + ((size_t)(b * 4 + hh) * TK + key0 + tok) * 96;
    const float sc = 0.10206207261596577f * 1.4426950408889634f;
#pragma unroll
    for (int q = 0; q < 8; ++q) {
      float v[8];
      ld8(src + 8 * q, v);
#pragma unroll
      for (int j = 0; j < 8; ++j) v[j] *= sc;
      st8(dst + 8 * q, v);
    }
    float x[32];
    ld32(src + 64, x);
    if (lat) rope32(x, t >> 6, t & 63);
#pragma unroll
    for (int j = 0; j < 32; ++j) x[j] *= sc;
    st32(dst + 64, x);
  }
  {
    int tok = tid >> 3, hh = (tid >> 1) & 3, part = tid & 1;
    int m = m0 + tok;
    const u16* src = KVRAW + (size_t)m * 512 + 128 * hh + 64 * part;
    if (part == 0) {
      u16* dst = KM + ((size_t)(b * 4 + hh) * TK + key0 + tok) * 96;
#pragma unroll
      for (int q = 0; q < 8; ++q) *(uint4*)(dst + 8 * q) = *(const uint4*)(src + 8 * q);
    } else {
#pragma unroll
      for (int q = 0; q < 8; ++q) {
        uint4 vv = *(const uint4*)(src + 8 * q);
        const u16* vs = (const u16*)&vv;
#pragma unroll
        for (int j = 0; j < 8; ++j) vb[(64 * hh + 8 * q + j) * 72 + tok] = vs[j];
      }
    }
  }
  {
    u16* LOUT = (u16*)(p->ws + S_LOUT);
#pragma unroll 1
    for (int e = 0; e < 16; ++e) {
      int it = tid + NT * e;
      int tok = it >> 7, cg = it & 127;
      int sec = cg >> 5, c0 = (cg & 31) * 8;
      u16* ptr = LOUT + (size_t)(m0 + tok) * 1280 + sec * 256 + c0;
      float v[8], c8[8];
      ld8(ptr, v);
      if ((sec & 1) == 0) {
        ld8f(p->in[12] + (l * 2 + (sec >> 1)) * 256 + c0, c8);
#pragma unroll
        for (int j = 0; j < 8; ++j) {
          float y = -(c8[j] + v[j]);
          float sp = fmaxf(y, 0.f) + __logf(1.f + __expf(-fabsf(y)));
          v[j] = __expf(-sp - 0.5f);
        }
      } else {
        ld8f(p->in[14] + (l * 2 + (sec >> 1)) * 256 + c0, c8);
#pragma unroll
        for (int j = 0; j < 8; ++j) v[j] = sigmoidf_(c8[j] + v[j]);
      }
      st8(ptr, v);
    }
  }
  __syncthreads();
#pragma unroll 1
  for (int e = 0; e < 4; ++e) {
    int id = tid + NT * e;
    int ch = id >> 3, tc8 = id & 7;
    *(uint4*)(VMT + ((size_t)b * 256 + ch) * TK + key0 + 8 * tc8) = *(const uint4*)(vb + ch * 72 + 8 * tc8);
  }
  __syncthreads();
}

template <int DQK>
DI void attn_pass(const u16* __restrict__ Qp, const u16* __restrict__ Kp, const u16* __restrict__ VTp, int kt0, int nkt,
                  char* lds, f32x16 (&o)[2], float& lsum) {
  constexpr int KS = DQK / 16;
  constexpr int KROW = DQK * 2 + 16;
  constexpr int KCH = DQK / 8;
  constexpr int NKC = 64 * KCH;
  constexpr int STG = 64 * KROW + 64 * 144;
  const int tid = tidx(), lane = tid & 63, wave = tid >> 6, r = lane & 31, h = lane >> 5;
  bf16x8 qf[KS];
#pragma unroll
  for (int s = 0; s < KS; ++s) qf[s] = *(const bf16x8*)(Qp + (size_t)(32 * wave + r) * DQK + 16 * s + 8 * h);
#pragma unroll
  for (int dt = 0; dt < 2; ++dt)
#pragma unroll
    for (int i = 0; i < 16; ++i) o[dt][i] = 0.f;
  float base = 0.f, base_next = 0.f, alpha_p = 1.f;
  f32x16 nb16;
#pragma unroll
  for (int i = 0; i < 16; ++i) nb16[i] = 0.f;
  f2v ls2 = {0.f, 0.f};
  const int kq0 = tid, kq1 = tid + NT;
  const bool has1 = kq1 < NKC, has0 = kq0 < NKC;
  const int kr0 = kq0 / KCH, kc0 = kq0 % KCH, kr1 = kq1 / KCH, kc1 = kq1 % KCH;
  const int vr = tid >> 3, vc = tid & 7;
  const int so0 = kr0 * KROW + kc0 * 16, so1 = kr1 * KROW + kc1 * 16, sov = 64 * KROW + vr * 144 + (vc >> 1) * 32 + (vc & 1) * 8;
  const u16* kp0 = Kp + (size_t)kr0 * DQK + kc0 * 8;
  const u16* kp1 = Kp + (size_t)kr1 * DQK + kc1 * 8;
  const u16* vp0 = VTp + (size_t)vr * TK + vc * 8;
  uint4 rk0 = make_uint4(0, 0, 0, 0), rk1 = make_uint4(0, 0, 0, 0), rv;
  uint4 rk0b = make_uint4(0, 0, 0, 0), rk1b = make_uint4(0, 0, 0, 0), rvb = make_uint4(0, 0, 0, 0);
#define ATT_LOAD_X(tile_, A0, A1, AV)                                             \
  {                                                                               \
    const int key0__ = (tile_) * 64;                                              \
    if (has0) A0 = *(const uint4*)(kp0 + (size_t)key0__ * DQK);                   \
    if (has1) A1 = *(const uint4*)(kp1 + (size_t)key0__ * DQK);                   \
    AV = *(const uint4*)(vp0 + key0__);                                           \
  }
#define ATT_STORE_X(stg_, A0, A1, AV)                                             \
  {                                                                               \
    char* sn__ = lds + (stg_) * STG;                                              \
    if (has0) *(uint4*)(sn__ + so0) = A0;                                         \
    if (has1) *(uint4*)(sn__ + so1) = A1;                                         \
    *(uint2*)(sn__ + sov) = make_uint2(AV.x, AV.y);                               \
    *(uint2*)(sn__ + sov + 16) = make_uint2(AV.z, AV.w);                          \
  }
#define ATT_LOAD(tile_) ATT_LOAD_X(tile_, rk0, rk1, rv)
#define ATT_STORE(stg_) ATT_STORE_X(stg_, rk0, rk1, rv)
#define ATT_LOAD_B(tile_) ATT_LOAD_X(tile_, rk0b, rk1b, rvb)
#define ATT_STORE_B(stg_) ATT_STORE_X(stg_, rk0b, rk1b, rvb)
#define ATT_QK(dst_, stg_)                                                        \
  {                                                                               \
    const char* sK__ = lds + (stg_) * STG;                                        \
    _Pragma("unroll") for (int mt = 0; mt < 2; ++mt) {                            \
      _Pragma("unroll") for (int s = 0; s < KS; ++s) {                            \
        bf16x8 a__ = *(const bf16x8*)(sK__ + (32 * mt + r) * KROW + 32 * s + 16 * h); \
        if (s == 0) dst_[mt] = MFMA32(a__, qf[s], nb16);                          \
        else dst_[mt] = MFMA32(a__, qf[s], dst_[mt]);                             \
      }                                                                           \
    }                                                                             \
  }
#define ATT_SOFTMAX_PV(sacc, stg_, J_)                                            \
  {                                                                               \
    const char* sV__ = lds + (stg_) * STG + 64 * KROW;                            \
    if ((J_) == 2) {                                                              \
      const f2v al2 = {alpha_p, alpha_p};                                         \
      ls2 = ls2 * al2;                                                            \
      _Pragma("unroll") for (int dt = 0; dt < 2; ++dt)                            \
        _Pragma("unroll") for (int i = 0; i < 16; ++i) o[dt][i] *= alpha_p;       \
    }                                                                             \
    if ((J_) == 0) {                                                              \
      float mloc = sacc[0][0];                                                    \
      _Pragma("unroll") for (int i = 1; i < 16; ++i) mloc = fmaxf(mloc, sacc[0][i]); \
      _Pragma("unroll") for (int i = 0; i < 16; ++i) mloc = fmaxf(mloc, sacc[1][i]); \
      mloc = fmaxf(mloc, __shfl_xor(mloc, 32));                                   \
      const float dlt = fmaxf(mloc, 0.f);                                         \
      alpha_p = __builtin_amdgcn_exp2f(-dlt);                                     \
      base_next = base + dlt;                                                     \
    }                                                                             \
    _Pragma("unroll") for (int mt = 0; mt < 2; ++mt)                              \
      _Pragma("unroll") for (int i = 0; i < 16; i += 2) {                         \
        f2v e = {__builtin_amdgcn_exp2f(sacc[mt][i]), __builtin_amdgcn_exp2f(sacc[mt][i + 1])}; \
        sacc[mt][i] = e.x; sacc[mt][i + 1] = e.y;                                 \
        ls2 += e;                                                                 \
      }                                                                           \
    _Pragma("unroll") for (int mt = 0; mt < 2; ++mt)                              \
      _Pragma("unroll") for (int s2 = 0; s2 < 2; ++s2) {                          \
        uint4 pw;                                                                 \
        pw.x = pk2(sacc[mt][8 * s2 + 0], sacc[mt][8 * s2 + 1]);                   \
        pw.y = pk2(sacc[mt][8 * s2 + 2], sacc[mt][8 * s2 + 3]);                   \
        pw.z = pk2(sacc[mt][8 * s2 + 4], sacc[mt][8 * s2 + 5]);                   \
        pw.w = pk2(sacc[mt][8 * s2 + 6], sacc[mt][8 * s2 + 7]);                   \
        bf16x8 pb = __builtin_bit_cast(bf16x8, pw);                               \
        _Pragma("unroll") for (int dt = 0; dt < 2; ++dt) {                        \
          const char* vp = sV__ + (32 * dt + r) * 144 + (2 * mt + s2) * 32 + 16 * h; \
          bf16x8 va = *(const bf16x8*)vp;                                         \
          o[dt] = MFMA32(va, pb, o[dt]);                                          \
        }                                                                         \
      }                                                                           \
    if ((J_) == 0) {                                                              \
      base = base_next;                                                           \
      _Pragma("unroll") for (int i = 0; i < 16; ++i) nb16[i] = -base_next;        \
    }                                                                             \
  }
  __syncthreads();
  ATT_LOAD(kt0)
  ATT_STORE(0)
  ATT_LOAD(kt0 + 1)
  ATT_STORE(1)
  __syncthreads();
  f32x16 sc[2], sn[2];
  int st_cur = 0, st_nxt = 1, st_sto = 2;
  const int lastt = nkt - 1;
  ATT_QK(sc, 0)
#pragma unroll 1
  for (int t = 0; t < nkt; t += 2) {
    const int jph = t & 3;
    { const int tl = (t + 2 < lastt) ? t + 2 : lastt; ATT_LOAD(kt0 + tl) }
    ATT_QK(sn, st_nxt)
    ATT_SOFTMAX_PV(sc, st_cur, jph)
    ATT_STORE(st_sto)
    __syncthreads();
    { const int tl = (t + 3 < lastt) ? t + 3 : lastt; ATT_LOAD(kt0 + tl) }
    ATT_QK(sc, st_sto)
    ATT_SOFTMAX_PV(sn, st_nxt, 1)
    ATT_STORE(st_cur)
    __syncthreads();
    const int tmp__ = st_cur; st_cur = st_sto; st_sto = st_nxt; st_nxt = tmp__;
  }
  lsum = ls2.x + ls2.y;
  lsum += __shfl_xor(lsum, 32);
#undef ATT_LOAD
#undef ATT_LOAD_B
#undef ATT_STORE_B
#undef ATT_LOAD_X
#undef ATT_STORE_X
#undef ATT_STORE
#undef ATT_QK
#undef ATT_SOFTMAX_PV
}

template <int DQK>
DI void attn_pass2(const u16* __restrict__ Qp, const u16* __restrict__ Kp, const u16* __restrict__ VTp, int kt0, int nkt, int nq,
                   char* lds, f32x16 (&o)[2][2], float (&lsum)[2]) {
  constexpr int KS = DQK / 16;
  constexpr int KROW = DQK * 2 + 16;
  constexpr int KCH = DQK / 8;
  constexpr int NKC = 64 * KCH;
  constexpr int STG = 64 * KROW + 64 * 144;
  const int tid = tidx(), lane = tid & 63, wave = tid >> 6, r = lane & 31, h = lane >> 5;
  const bool act = wave * 64 < nq;
  bf16x8 qf[2][KS];
#pragma unroll
  for (int u = 0; u < 2; ++u)
#pragma unroll
    for (int s = 0; s < KS; ++s) qf[u][s] = *(const bf16x8*)(Qp + (size_t)(act ? (64 * wave + 32 * u + r) : r) * DQK + 16 * s + 8 * h);
#pragma unroll
  for (int u = 0; u < 2; ++u)
#pragma unroll
    for (int dt = 0; dt < 2; ++dt)
#pragma unroll
      for (int i = 0; i < 16; ++i) o[u][dt][i] = 0.f;
  float base[2] = {0.f, 0.f};
  f2v ls2[2] = {{0.f, 0.f}, {0.f, 0.f}};
  const int kq0 = tid, kq1 = tid + NT;
  const bool has1 = (NKC > NT) && (kq1 < NKC), has0 = (NKC >= NT) || (kq0 < NKC);
  const int kr0 = kq0 / KCH, kc0 = kq0 % KCH, kr1 = kq1 / KCH, kc1 = kq1 % KCH;
  const int vr = tid >> 3, vc = tid & 7;
  const int so0 = kr0 * KROW + kc0 * 16, so1 = kr1 * KROW + kc1 * 16, sov = 64 * KROW + vr * 144 + (vc >> 1) * 32 + (vc & 1) * 8;
  const u16* kp0 = Kp + (size_t)kr0 * DQK + kc0 * 8;
  const u16* kp1 = Kp + (size_t)kr1 * DQK + kc1 * 8;
  const u16* vp0 = VTp + (size_t)vr * TK + vc * 8;
  uint4 rk0 = make_uint4(0, 0, 0, 0), rk1 = make_uint4(0, 0, 0, 0), rv;
#define A2_LOAD(tile_) { const int key0__ = (tile_) * 64; if (has0) rk0 = *(const uint4*)(kp0 + (size_t)key0__ * DQK); \
    if (has1) rk1 = *(const uint4*)(kp1 + (size_t)key0__ * DQK); rv = *(const uint4*)(vp0 + key0__); }
#define A2_STORE(stg_) { char* sn__ = lds + (stg_) * STG; if (has0) *(uint4*)(sn__ + so0) = rk0; if (has1) *(uint4*)(sn__ + so1) = rk1; \
    *(uint2*)(sn__ + sov) = make_uint2(rv.x, rv.y); *(uint2*)(sn__ + sov + 16) = make_uint2(rv.z, rv.w); }
  __syncthreads();
  A2_LOAD(kt0)
  A2_STORE(0)
  A2_LOAD(kt0 + 1)
  A2_STORE(1)
  __syncthreads();
  int st_cur = 0, st_nxt = 1, st_sto = 2;
  const int lastt = nkt - 1;
#pragma unroll 1
  for (int t = 0; t < nkt; ++t) {
    { const int tl = (t + 2 < lastt) ? t + 2 : lastt; A2_LOAD(kt0 + tl) }
    if (act) {
      const char* sK = lds + st_cur * STG;
      const char* sV = sK + 64 * KROW;
      f32x16 sc[2][2];
#pragma unroll
      for (int mt = 0; mt < 2; ++mt)
#pragma unroll
        for (int s = 0; s < KS; ++s) {
          const bf16x8 a = *(const bf16x8*)(sK + (32 * mt + r) * KROW + 32 * s + 16 * h);
#pragma unroll
          for (int u = 0; u < 2; ++u) {
            if (s == 0) { const f32x16 z = {0.f,0.f,0.f,0.f,0.f,0.f,0.f,0.f,0.f,0.f,0.f,0.f,0.f,0.f,0.f,0.f}; sc[u][mt] = MFMA32(a, qf[u][s], z); }
            else sc[u][mt] = MFMA32(a, qf[u][s], sc[u][mt]);
          }
        }
      bf16x8 pb[2][2][2];
      if ((t & 3) == 0) {
#pragma unroll
        for (int u = 0; u < 2; ++u) {
          float mloc = sc[u][0][0];
#pragma unroll
          for (int i = 1; i < 16; ++i) mloc = fmaxf(mloc, sc[u][0][i]);
#pragma unroll
          for (int i = 0; i < 16; ++i) mloc = fmaxf(mloc, sc[u][1][i]);
          mloc = fmaxf(mloc, __shfl_xor(mloc, 32));
          const float dlt = fmaxf(mloc - base[u] - 32.f, 0.f);
          if (__builtin_amdgcn_ballot_w64(dlt > 32.f) != 0ull) {
            const float al = __builtin_amdgcn_exp2f(-dlt);
            const f2v al2 = {al, al};
            ls2[u] = ls2[u] * al2;
#pragma unroll
            for (int dt = 0; dt < 2; ++dt)
#pragma unroll
              for (int i = 0; i < 16; ++i) o[u][dt][i] *= al;
            base[u] += dlt;
          }
        }
      }
      if (__builtin_amdgcn_ballot_w64(base[0] != 0.f || base[1] != 0.f) != 0ull) {
#pragma unroll
        for (int u = 0; u < 2; ++u)
#pragma unroll
          for (int mt = 0; mt < 2; ++mt)
#pragma unroll
            for (int i = 0; i < 16; ++i) sc[u][mt][i] -= base[u];
      }
#pragma unroll
      for (int u = 0; u < 2; ++u) {
#pragma unroll
        for (int mt = 0; mt < 2; ++mt)
#pragma unroll
          for (int i = 0; i < 16; i += 2) {
            f2v e = {__builtin_amdgcn_exp2f(sc[u][mt][i]), __builtin_amdgcn_exp2f(sc[u][mt][i + 1])};
            sc[u][mt][i] = e.x; sc[u][mt][i + 1] = e.y;
            ls2[u] += e;
          }
#pragma unroll
        for (int mt = 0; mt < 2; ++mt)
#pragma unroll
          for (int s2 = 0; s2 < 2; ++s2) {
            uint4 pw;
            pw.x = pk2(sc[u][mt][8 * s2 + 0], sc[u][mt][8 * s2 + 1]);
            pw.y = pk2(sc[u][mt][8 * s2 + 2], sc[u][mt][8 * s2 + 3]);
            pw.z = pk2(sc[u][mt][8 * s2 + 4], sc[u][mt][8 * s2 + 5]);
            pw.w = pk2(sc[u][mt][8 * s2 + 6], sc[u][mt][8 * s2 + 7]);
            pb[u][mt][s2] = __builtin_bit_cast(bf16x8, pw);
          }
      }
#pragma unroll
      for (int mt = 0; mt < 2; ++mt)
#pragma unroll
        for (int s2 = 0; s2 < 2; ++s2)
#pragma unroll
          for (int dt = 0; dt < 2; ++dt) {
            const bf16x8 va = *(const bf16x8*)(sV + (32 * dt + r) * 144 + (2 * mt + s2) * 32 + 16 * h);
            o[0][dt] = MFMA32(va, pb[0][mt][s2], o[0][dt]);
            o[1][dt] = MFMA32(va, pb[1][mt][s2], o[1][dt]);
          }
    }
    A2_STORE(st_sto)
    __syncthreads();
    const int tmp = st_cur; st_cur = st_nxt; st_nxt = st_sto; st_sto = tmp;
  }
#undef A2_LOAD
#undef A2_STORE
#pragma unroll
  for (int u = 0; u < 2; ++u) {
    float l = ls2[u].x + ls2[u].y;
    l += __shfl_xor(l, 32);
    lsum[u] = l;
  }
}

DI void mla_item(CP p, int b, int hh, int qt, char* smem) {
  const u16* QM = (const u16*)(p->ws + S_QM);
  const u16* KM = (const u16*)(p->ws + S_KM);
  const u16* VMT = (const u16*)(p->ws + S_VMT);
  u16* OALL = (u16*)(p->ws + S_OALL);
  const bool ctx = qt == 32;
  const int q0 = ctx ? 16384 : qt * 512;
  const int nq = ctx ? 256 : 512;
  const size_t hb = (size_t)(b * 4 + hh);
  f32x16 o[2][2]; float l[2];
  attn_pass2<96>(QM + (hb * TK + q0) * 96, KM + hb * TK * 96, VMT + hb * 64 * TK, ctx ? 256 : 0, ctx ? 4 : 260, nq, smem, o, l);
  const int lane = tidx() & 63, wave = tidx() >> 6, r = lane & 31, h = lane >> 5;
  if (wave * 64 < nq) {
#pragma unroll
    for (int u = 0; u < 2; ++u) {
      const int q = 64 * wave + 32 * u + r;
      const int m = ctx ? (ML + b * 256 + q) : (b * 16384 + q0 + q);
      const float il = 1.f / l[u];
#pragma unroll
      for (int dt = 0; dt < 2; ++dt)
#pragma unroll
        for (int g = 0; g < 4; ++g) {
          uint2 w;
          w.x = pk2(o[u][dt][4 * g] * il, o[u][dt][4 * g + 1] * il);
          w.y = pk2(o[u][dt][4 * g + 2] * il, o[u][dt][4 * g + 3] * il);
          *(uint2*)(OALL + (size_t)m * 1024 + 512 + 64 * hh + 32 * dt + 8 * g + 4 * h) = w;
        }
    }
  }
}
DI void diff_item(CP p, int l_, int b, int hd, int qt, char* smem) {
  const u16* QD = (const u16*)(p->ws + O_QD);
  const u16* KD = (const u16*)(p->ws + O_KD);
  const u16* VDT = (const u16*)(p->ws + O_VDT);
  u16* OALL = (u16*)(p->ws + S_OALL);
  const bool ctx = qt == 32;
  const int q0 = ctx ? 16384 : qt * 512;
  const int nq = ctx ? 256 : 512;
  const int kt0 = ctx ? 256 : 0, nkt = ctx ? 4 : 260;
  const u16* VT = VDT + (size_t)(b * 4 + hd) * 64 * TK;
  const int lane = tidx() & 63, wave = tidx() >> 6, r = lane & 31, h = lane >> 5;
  const bool act = wave * 64 < nq;
  {
    f32x16 o1[2][2]; float l1[2];
    const size_t hb = (size_t)(b * 8 + 2 * hd);
    attn_pass2<32>(QD + (hb * TK + q0) * 32, KD + hb * TK * 32, VT, kt0, nkt, nq, smem, o1, l1);
    if (act) {
#pragma unroll
      for (int u = 0; u < 2; ++u) {
        const float i1 = 1.f / l1[u];
        const int q = 64 * wave + 32 * u + r;
        const int m = ctx ? (ML + b * 256 + q) : (b * 16384 + q0 + q);
#pragma unroll
        for (int dt = 0; dt < 2; ++dt)
#pragma unroll
          for (int g = 0; g < 4; ++g) {
            uint2 w;
            w.x = pk2(o1[u][dt][4 * g] * i1, o1[u][dt][4 * g + 1] * i1);
            w.y = pk2(o1[u][dt][4 * g + 2] * i1, o1[u][dt][4 * g + 3] * i1);
            *(uint2*)(OALL + (size_t)m * 1024 + 768 + 64 * hd + 32 * dt + 8 * g + 4 * h) = w;
          }
      }
    }
  }
  f32x16 o2[2][2]; float l2[2];
  {
    const size_t hb = (size_t)(b * 8 + 2 * hd + 1);
    attn_pass2<32>(QD + (hb * TK + q0) * 32, KD + hb * TK * 32, VT, kt0, nkt, nq, smem, o2, l2);
  }
  float s1 = 0.f, s2 = 0.f;
  for (int j = 0; j < 32; ++j) {
    s1 += p->in[36][l_ * 32 + j] * p->in[37][l_ * 32 + j];
    s2 += p->in[38][l_ * 32 + j] * p->in[39][l_ * 32 + j];
  }
  const float li = lam_init_of(l_);
  const float lam = expf(s1) - expf(s2) + li;
  const float* sub = p->in[40] + l_ * 64;
  if (act) {
#pragma unroll
    for (int u = 0; u < 2; ++u) {
      const float i2 = lam / l2[u];
      const int q = 64 * wave + 32 * u + r;
      const int m = ctx ? (ML + b * 256 + q) : (b * 16384 + q0 + q);
      u16* dst = OALL + (size_t)m * 1024 + 768 + 64 * hd + 4 * h;
      float ss = 0.f;
#pragma unroll
      for (int dt = 0; dt < 2; ++dt)
#pragma unroll
        for (int g = 0; g < 4; ++g) {
          const uint2 pw = *(const uint2*)(dst + 32 * dt + 8 * g);
          const float a0 = __uint_as_float(pw.x << 16), a1 = __uint_as_float(pw.x & 0xffff0000u);
          const float a2 = __uint_as_float(pw.y << 16), a3 = __uint_as_float(pw.y & 0xffff0000u);
          const float v0 = a0 - o2[u][dt][4 * g] * i2, v1 = a1 - o2[u][dt][4 * g + 1] * i2;
          const float v2 = a2 - o2[u][dt][4 * g + 2] * i2, v3 = a3 - o2[u][dt][4 * g + 3] * i2;
          o2[u][dt][4 * g] = v0; o2[u][dt][4 * g + 1] = v1; o2[u][dt][4 * g + 2] = v2; o2[u][dt][4 * g + 3] = v3;
          ss += v0 * v0 + v1 * v1 + v2 * v2 + v3 * v3;
        }
      ss += __shfl_xor(ss, 32);
      const float rs = rsqrtf(ss * (1.f / 64.f) + 1e-5f) * (1.f - li);
#pragma unroll
      for (int dt = 0; dt < 2; ++dt)
#pragma unroll
        for (int g = 0; g < 4; ++g) {
          const int dv = 32 * dt + 8 * g + 4 * h;
          const float4 sg = *(const float4*)(sub + dv);
          uint2 w;
          w.x = pk2(o2[u][dt][4 * g] * rs * sg.x, o2[u][dt][4 * g + 1] * rs * sg.y);
          w.y = pk2(o2[u][dt][4 * g + 2] * rs * sg.z, o2[u][dt][4 * g + 3] * rs * sg.w);
          *(uint2*)(dst + 32 * dt + 8 * g) = w;
        }
    }
  }
}

DI void hyena_item(CP p, int l, int c, char* smem) {
  const int tid = tidx(), lane = tid & 63, wave = tid >> 6, r = lane & 31, h = lane >> 5;
  u16* zl = (u16*)smem;
  char* cp = smem + 2 * 128 * 136 * 2;
  float* red = (float*)(cp + 2 * 2 * 8 * 544);
  const u16* ZT = (const u16*)(p->ws + O_ZT) + (size_t)c * 2 * 16384;
  const u16* X0T = (const u16*)(p->ws + S_X0T) + (size_t)c * 2 * 16384;
  u16* OHT = (u16*)(p->ws + S_OHT) + (size_t)c * 2 * 16384;
  const u16* rkg = (const u16*)(p->ws + O_RKG) + (size_t)c * RKROW;
  __syncthreads();
#pragma unroll
  for (int e = 0; e < 8; ++e) {
    int q = tid + NT * e;
    int bb = q >> 11, t8 = (q & 2047) * 8;
    *(uint4*)(zl + (bb * 128 + (t8 >> 7)) * 136 + (t8 & 127)) = *(const uint4*)(ZT + (size_t)bb * 16384 + t8);
  }
  {
    const float* part = (const float*)(p->ws + O_HPART);
    float v = part[(tid >> 1) * 512 + (tid & 1) * 256 + c];
    v = wave_sum(v);
    if (lane == 0) red[wave] = v;
  }
  const int cwin = tid >> 8, co = (tid >> 5) & 7, cq = tid & 31;
  uint4 cr;
  {
    const int bx = -128 + cwin * 16384;
    __builtin_memcpy(&cr, rkg + OFFC + bx + co + 8 * cq, 16);
  }
  *(uint4*)(cp + ((0 * 2 + cwin) * 8 + co) * 544 + 16 * cq) = cr;
  __syncthreads();
  float rn = 0.f;
#pragma unroll
  for (int q = 0; q < 8; ++q) rn += red[q];
  rn = rsqrtf(rn);
  const int mt = wave & 3, bb = wave >> 2;
  const int i_ = 32 * mt + r;
  const int o_ = (-i_) & 7;
  f32x16 acc[4];
#pragma unroll
  for (int at = 0; at < 4; ++at)
#pragma unroll
    for (int i = 0; i < 16; ++i) acc[at][i] = 0.f;
  const bf16x8 zero8 = {0, 0, 0, 0, 0, 0, 0, 0};
  uint4 cr2 = make_uint4(0, 0, 0, 0);
  {
    const int bx = -128 * 1 - 128 + cwin * 16384;
    __builtin_memcpy(&cr, rkg + OFFC + bx + co + 8 * cq, 16);
  }
#define HY_LOADC(dst_, dn_) { const int bx__ = -128 * (dn_) - 128 + cwin * 16384; __builtin_memcpy(&dst_, rkg + OFFC + bx__ + co + 8 * cq, 16); }
#define HY_STOREC(src_, dn_) { *(uint4*)(cp + ((((dn_) & 1) * 2 + cwin) * 8 + co) * 544 + 16 * cq) = src_; }
#define HY_COMPUTE(K_, dl_)                                                                    \
  {                                                                                            \
    const char* chi = cp + ((((dl_) & 1) * 2 + 0) * 8 + o_) * 544;                             \
    const char* clo = cp + ((((dl_) & 1) * 2 + 1) * 8 + o_) * 544;                             \
    _Pragma("unroll") for (int s = 0; s < 8; ++s) {                                            \
      const int j = 16 * s + 8 * h;                                                            \
      const int q = (j - i_ + 128 - o_) >> 3;                                                  \
      bf16x8 ahi = *(const bf16x8*)(chi + 16 * q);                                             \
      bf16x8 alo = *(const bf16x8*)(clo + 16 * q);                                             \
      _Pragma("unroll") for (int at = 0; at < 4; ++at) {                                       \
        const int a = 32 * at + r;                                                             \
        const int ap = (a - (dl_)) & 127;                                                      \
        bf16x8 bf = *(const bf16x8*)(zl + (bb * 128 + ap) * 136 + j);                          \
        if (at > (K_)) acc[at] = MFMA32(ahi, bf, acc[at]);                                     \
        else if (at < (K_)) acc[at] = MFMA32(alo, bf, acc[at]);                                \
        else {                                                                                 \
          bf16x8 b1 = (a >= (dl_)) ? bf : zero8;                                               \
          bf16x8 b2 = (a >= (dl_)) ? zero8 : bf;                                               \
          acc[at] = MFMA32(ahi, b1, acc[at]);                                                  \
          acc[at] = MFMA32(alo, b2, acc[at]);                                                  \
        }                                                                                      \
      }                                                                                        \
    }                                                                                          \
  }
#define HY_SEGMENT(K_)                                                                         \
  _Pragma("unroll 1") for (int dl0 = 32 * (K_); dl0 < 32 * (K_) + 32; dl0 += 2) {              \
    {                                                                                          \
      const int dl = dl0;                                                                      \
      if (dl + 2 < 128) HY_LOADC(cr2, dl + 2)                                                  \
      HY_COMPUTE(K_, dl)                                                                       \
      HY_STOREC(cr, dl + 1)                                                                    \
      __syncthreads();                                                                         \
    }                                                                                          \
    {                                                                                          \
      const int dl = dl0 + 1;                                                                  \
      if (dl + 2 < 128) HY_LOADC(cr, dl + 2)                                                   \
      HY_COMPUTE(K_, dl)                                                                       \
      if (dl + 1 < 128) HY_STOREC(cr2, dl + 1)                                                 \
      __syncthreads();                                                                         \
    }                                                                                          \
  }
  HY_SEGMENT(0)
  HY_SEGMENT(1)
  HY_SEGMENT(2)
  HY_SEGMENT(3)
#undef HY_SEGMENT
#undef HY_COMPUTE
#undef HY_LOADC
#undef HY_STOREC
  const float bias = p->in[31][l * 256 + c];
#pragma unroll
  for (int at = 0; at < 4; ++at) {
    const int a = 32 * at + r;
#pragma unroll
    for (int g = 0; g < 4; ++g) {
      const int il = 32 * mt + 8 * g + 4 * h;
      const int t = 128 * a + il;
      uint2 zz = *(const uint2*)(zl + (bb * 128 + a) * 136 + il);
      uint2 xx = *(const uint2*)(X0T + (size_t)bb * 16384 + t);
      float z0 = __uint_as_float(zz.x << 16), z1 = __uint_as_float(zz.x & 0xffff0000u);
      float z2 = __uint_as_float(zz.y << 16), z3 = __uint_as_float(zz.y & 0xffff0000u);
      float x0 = __uint_as_float(xx.x << 16), x1 = __uint_as_float(xx.x & 0xffff0000u);
      float x2 = __uint_as_float(xx.y << 16), x3 = __uint_as_float(xx.y & 0xffff0000u);
      uint2 w;
      w.x = pk2(x0 * (acc[at][4 * g] * rn + z0 * bias), x1 * (acc[at][4 * g + 1] * rn + z1 * bias));
      w.y = pk2(x2 * (acc[at][4 * g + 2] * rn + z2 * bias), x3 * (acc[at][4 * g + 3] * rn + z3 * bias));
      *(uint2*)(OHT + (size_t)bb * 16384 + t) = w;
    }
  }
  __syncthreads();
}

DI void scan_item(CP p, int l, int si, char* smem) {
  const int tid = tidx(), lane = tid & 63, wave = tid >> 6;
  const int quarter = si & 3, dir = (si >> 2) & 1, hh = (si >> 3) & 3, b = si >> 5;
  const u16* Rb = (const u16*)(p->ws + S_R); const u16* KRAW = (const u16*)(p->ws + S_KRAW);
  const u16* Vb = (const u16*)(p->ws + S_V); const u16* KK = (const u16*)(p->ws + S_KK);
  const u16* LOUT = (const u16*)(p->ws + S_LOUT);
  u16* Yo = (u16*)(p->ws + (dir ? S_YB : S_YF));
  constexpr int BUF = 42 * 1024;
#define SCAN_ROW(s_) (((s_) < 256) ? (ML + b * 256 + (dir ? 255 - (s_) : (s_))) : (b * 16384 + (dir ? 16383 - ((s_) - 256) : ((s_) - 256))))
  __syncthreads();
  if (wave >= 4) {
    const int lt = tid - 256;
    const int lst = lt >> 3, lcg = lt & 7;
    const bool ldv = lt < 64;
    const int vst = lt >> 1, vcg = lt & 1;
    float kav[8];
    ld8f(p->in[18] + l * 256 + 64 * hh + 8 * lcg, kav);
    uint4 q0, q1, q2, q3, q4, q5 = make_uint4(0, 0, 0, 0);
#define SCAN_ISSUE(ch_)                                                                                  \
  {                                                                                                      \
    const int s__ = 32 * (ch_) + lst;                                                                    \
    const int m__ = SCAN_ROW(s__);                                                                       \
    const size_t o__ = (size_t)m__ * 256 + 64 * hh + 8 * lcg;                                            \
    q0 = *(const uint4*)(Rb + o__); q1 = *(const uint4*)(KRAW + o__); q2 = *(const uint4*)(KK + o__);    \
    q3 = *(const uint4*)(LOUT + (size_t)m__ * 1280 + dir * 512 + 64 * hh + 8 * lcg);                     \
    q4 = *(const uint4*)(LOUT + (size_t)m__ * 1280 + dir * 512 + 256 + 64 * hh + 8 * lcg);               \
    if (ldv) {                                                                                           \
      const int s2__ = 32 * (ch_) + vst;                                                                 \
      const int m2__ = SCAN_ROW(s2__);                                                                   \
      q5 = *(const uint4*)(Vb + (size_t)m2__ * 256 + 64 * hh + 16 * quarter + 8 * vcg);                  \
    }                                                                                                    \
  }
#define SCAN_COMMIT(bufi_)                                                                               \
  {                                                                                                      \
    float* base__ = (float*)(smem + (bufi_) * BUF);                                                      \
    float rr[8], kr[8], kk[8], ew[8], aa[8];                                                             \
    unpack8(q0, rr); unpack8(q1, kr); unpack8(q2, kk); unpack8(q3, ew); unpack8(q4, aa);                 \
    float* d__ = base__ + lst * 64 + 8 * lcg;                                                            \
    float o0[8], o1[8], o2[8], o3[8];                                                                    \
    const float one__ = one_f();                                                                         \
    _Pragma("unroll") for (int j = 0; j < 8; ++j) {                                                      \
      o0[j] = __expf(-ew[j]);                                                                            \
      o1[j] = kr[j] * (one__ + (aa[j] - one__) * kav[j]);                                                    \
      o2[j] = -kk[j];                                                                                    \
      o3[j] = kk[j] * aa[j];                                                                             \
    }                                                                                                    \
    *(float4*)(d__) = make_float4(o0[0], o0[1], o0[2], o0[3]); *(float4*)(d__ + 4) = make_float4(o0[4], o0[5], o0[6], o0[7]); \
    *(float4*)(d__ + 2048) = make_float4(o1[0], o1[1], o1[2], o1[3]); *(float4*)(d__ + 2052) = make_float4(o1[4], o1[5], o1[6], o1[7]); \
    *(float4*)(d__ + 4096) = make_float4(o2[0], o2[1], o2[2], o2[3]); *(float4*)(d__ + 4100) = make_float4(o2[4], o2[5], o2[6], o2[7]); \
    *(float4*)(d__ + 6144) = make_float4(o3[0], o3[1], o3[2], o3[3]); *(float4*)(d__ + 6148) = make_float4(o3[4], o3[5], o3[6], o3[7]); \
    *(float4*)(d__ + 8192) = make_float4(rr[0], rr[1], rr[2], rr[3]); *(float4*)(d__ + 8196) = make_float4(rr[4], rr[5], rr[6], rr[7]); \
    if (ldv) {                                                                                           \
      float vv[8];                                                                                       \
      unpack8(q5, vv);                                                                                   \
      float* dv__ = base__ + 5 * 2048 + vst * 16 + 8 * vcg;                                              \
      *(float4*)(dv__) = make_float4(vv[0], vv[1], vv[2], vv[3]); *(float4*)(dv__ + 4) = make_float4(vv[4], vv[5], vv[6], vv[7]); \
    }                                                                                                    \
  }
    SCAN_ISSUE(0)
    SCAN_COMMIT(0)
    SCAN_ISSUE(1)
    __syncthreads();
#pragma unroll 1
    for (int ch = 0; ch < 520; ++ch) {
      if (ch + 1 < 520) SCAN_COMMIT((ch + 1) & 1)
      if (ch + 2 < 520) SCAN_ISSUE(ch + 2)
      __syncthreads();
    }
  } else {
    const int rowl = lane >> 4, jl = lane & 15;
    const int il = 4 * wave + rowl;
    f2v S01 = {0.f, 0.f}, S23 = {0.f, 0.f};
    __syncthreads();
#pragma unroll 1
    for (int ch = 0; ch < 520; ++ch) {
      const float* base = (const float*)(smem + (ch & 1) * BUF);
      const int s0 = 32 * ch;
      const int mrow0 = SCAN_ROW(s0);
      const int mstep = dir ? -1 : 1;
      u16* yp = Yo + (size_t)(mrow0 + jl * mstep) * 256 + 64 * hh + 16 * quarter + il;
      const float* sp = base + 4 * jl;
      const float* vp = base + 5 * 2048 + il;
      float4 cw = *(const float4*)(sp), ck = *(const float4*)(sp + 2048), cn = *(const float4*)(sp + 4096);
      float4 cb = *(const float4*)(sp + 6144), cr = *(const float4*)(sp + 8192);
      float cv = vp[0];
      float ykeep = 0.f;
#pragma unroll
      for (int st = 0; st < 32; ++st) {
        float4 nw = cw, nk = ck, nn = cn, nb = cb, nr = cr; float nv = cv;
        if (st + 1 < 32) {
          const float* sq = sp + (st + 1) * 64;
          nw = *(const float4*)(sq); nk = *(const float4*)(sq + 2048); nn = *(const float4*)(sq + 4096);
          nb = *(const float4*)(sq + 6144); nr = *(const float4*)(sq + 8192);
          nv = vp[(st + 1) * 16];
        }
        f2v n01 = {cn.x, cn.y}, n23 = {cn.z, cn.w};
        f2v t = S01 * n01 + S23 * n23;
        float sa = dpp_sum16(t.x + t.y);
        f2v sa2 = {sa, sa}, v2 = {cv, cv};
        f2v w01 = {cw.x, cw.y}, w23 = {cw.z, cw.w}, b01 = {cb.x, cb.y}, b23 = {cb.z, cb.w}, k01 = {ck.x, ck.y}, k23 = {ck.z, ck.w};
        S01 = S01 * w01 + sa2 * b01 + v2 * k01;
        S23 = S23 * w23 + sa2 * b23 + v2 * k23;
        f2v r01 = {cr.x, cr.y}, r23 = {cr.z, cr.w};
        f2v u = S01 * r01 + S23 * r23;
        float y = dpp_sum16(u.x + u.y);
        ykeep = ((st & 15) == jl) ? y : ykeep;
        if ((st & 15) == 15) yp[(ptrdiff_t)((st & 16) * mstep) * 256] = f2bf(ykeep);
        cw = nw; ck = nk; cn = nn; cb = nb; cr = nr; cv = nv;
      }
      __syncthreads();
    }
  }
#undef SCAN_ISSUE
#undef SCAN_COMMIT
#undef SCAN_ROW
}

constexpr int T3_SCAN = 64, T3_DIFF = 8 * 33, T3_MLA = 8 * 33, T3_HY = 256;
constexpr int T3_TOTAL = T3_SCAN + T3_DIFF + T3_MLA + T3_HY;
DI void ph_t3(CP p, int l, char* smem, int* s_item, int rep) {
  u32* cnt = (u32*)(p->ws + O_CNT) + l + 2 * rep;
  for (;;) {
    __syncthreads();
    if (tidx() == 0) *s_item = (int)atomicAdd(cnt, 1u);
    __syncthreads();
    int it = *s_item;
    if (it >= T3_TOTAL) break;
    if (it < T3_SCAN) { if (T3_ON(0)) scan_item(p, l, it, smem); }
    else if (it < T3_SCAN + T3_DIFF) {
      int j = it - T3_SCAN;
      int bh = j / 33, qt = j % 33;
      if (T3_ON(1)) diff_item(p, l, bh >> 2, bh & 3, qt, smem);
    } else if (it < T3_SCAN + T3_DIFF + T3_MLA) {
      int j = it - T3_SCAN - T3_DIFF;
      int bh = j / 33, qt = j % 33;
      if (T3_ON(2)) mla_item(p, bh >> 2, bh & 3, qt, smem);
    } else if (T3_ON(3)) hyena_item(p, l, it - T3_SCAN - T3_DIFF - T3_MLA, smem);
  }
}

DI void t4_tile(CP p, int l, int tl, char* smem) {
  const int tid = tidx();
  const int m0 = tl * 64;
  const bool lat = m0 < ML;
  int b, t0;
  if (lat) { b = m0 >> 14; t0 = m0 & 16383; } else { int mc = m0 - ML; b = mc >> 8; t0 = mc & 255; }
  const u16* Rb = (const u16*)(p->ws + S_R); const u16* KRAW = (const u16*)(p->ws + S_KRAW); const u16* Vb = (const u16*)(p->ws + S_V);
  const u16* LOUT = (const u16*)(p->ws + S_LOUT);
  const u16* YF = (const u16*)(p->ws + S_YF); const u16* YB = (const u16*)(p->ws + S_YB);
  u16* OALL = (u16*)(p->ws + S_OALL);
#pragma unroll 1
  for (int e = 0; e < 4; ++e) {
    int it = tid + NT * e;
    int tok = it >> 5, hh = (it >> 3) & 3, sub = it & 7;
    int m = m0 + tok, c0 = 64 * hh + 8 * sub;
    float yf[8], yb[8], y[8];
    ld8(YF + (size_t)m * 256 + c0, yf); ld8(YB + (size_t)m * 256 + c0, yb);
    float s = 0.f;
#pragma unroll
    for (int j = 0; j < 8; ++j) { y[j] = yf[j] + yb[j]; s += y[j]; }
    float mean = grp8_sum(s) * (1.f / 64.f);
    float vs = 0.f;
#pragma unroll
    for (int j = 0; j < 8; ++j) { float d = y[j] - mean; vs += d * d; }
    float var = grp8_sum(vs) * (1.f / 64.f);
    float rs = rsqrtf(var + 64e-5f);
    float rr[8], kr[8], vv[8], alf[8], alb[8], gg[8], ka[8], rk[8], lw[8], lb[8];
    ld8(Rb + (size_t)m * 256 + c0, rr); ld8(KRAW + (size_t)m * 256 + c0, kr); ld8(Vb + (size_t)m * 256 + c0, vv);
    ld8(LOUT + (size_t)m * 1280 + 256 + c0, alf); ld8(LOUT + (size_t)m * 1280 + 768 + c0, alb); ld8(LOUT + (size_t)m * 1280 + 1024 + c0, gg);
    ld8f(p->in[18] + l * 256 + c0, ka); ld8f(p->in[19] + l * 256 + c0, rk);
    ld8f(p->in[20] + l * 256 + c0, lw); ld8f(p->in[21] + l * 256 + c0, lb);
    float bs = 0.f;
    const float one1 = one_f();
#pragma unroll
    for (int j = 0; j < 8; ++j) {
      float af = alf[j], ab = alb[j];
      float kf = kr[j] * (one1 + (af - one1) * ka[j]), kb = kr[j] * (one1 + (ab - one1) * ka[j]);
      bs += rr[j] * rk[j] * (kf + kb);
    }
    bs = grp8_sum(bs);
    float o[8];
#pragma unroll
    for (int j = 0; j < 8; ++j) o[j] = ((y[j] - mean) * rs * lw[j] + lb[j] + bs * vv[j]) * gg[j];
    st8(OALL + (size_t)m * 1024 + c0, o);
  }
  if (lat) {
    const u16* OHT = (const u16*)(p->ws + S_OHT);
    u16* tb = (u16*)smem;
#pragma unroll 1
    for (int e = 0; e < 4; ++e) {
      int id = tid + NT * e;
      int ch = id >> 3, tc8 = id & 7;
      uint4 vv = *(const uint4*)(OHT + ((size_t)ch * 2 + b) * 16384 + t0 + 8 * tc8);
      const u16* vs = (const u16*)&vv;
#pragma unroll
      for (int j = 0; j < 8; ++j) tb[(8 * tc8 + j) * 264 + ch] = vs[j];
    }
    __syncthreads();
#pragma unroll 1
    for (int e = 0; e < 4; ++e) {
      int id = tid + NT * e;
      int tok = id >> 5, cg = id & 31;
      *(uint4*)(OALL + (size_t)(m0 + tok) * 1024 + 256 + 8 * cg) = *(const uint4*)(tb + tok * 264 + 8 * cg);
    }
    __syncthreads();
  } else {
    const float* ZC = (const float*)(p->ws + O_ZC);
    const float* X0C = (const float*)(p->ws + O_X0C);
    const float* hfc = (const float*)(p->ws + O_HFC);
    const float* part = (const float*)(p->ws + O_HPART);
    const int c = tid & 255, hf = tid >> 8;
    float nrm = 0.f;
    for (int i = 0; i < 4; ++i) nrm += part[(256 + i) * 512 + c] + part[(256 + i) * 512 + 256 + c];
    const float rn = rsqrtf(nrm);
    const float bias = p->in[31][l * 256 + c];
    float acc[32];
#pragma unroll
    for (int j = 0; j < 32; ++j) acc[j] = 0.f;
    const int tb0 = t0 + hf * 32;
#pragma unroll 1
    for (int q = 0; q < 8; ++q) {
      float kw[63], zz[32];
#pragma unroll
      for (int e = 0; e < 63; ++e) {
        int d = tb0 - 32 * q - 31 + e;
        kw[e] = (d >= 0) ? ((d < 256) ? hfc[d * 512 + c] : 0.f) : ((-d - 1 < 255) ? hfc[(-d - 1) * 512 + 256 + c] : 0.f);
      }
#pragma unroll
      for (int u = 0; u < 32; ++u) zz[u] = ZC[(b * 256 + 32 * q + u) * 256 + c];
#pragma unroll
      for (int u = 0; u < 32; ++u)
#pragma unroll
        for (int j = 0; j < 32; ++j) acc[j] += kw[31 + j - u] * zz[u];
    }
#pragma unroll
    for (int j = 0; j < 32; ++j) {
      int t = tb0 + j;
      int mc = b * 256 + t;
      float z = ZC[mc * 256 + c], x0 = X0C[mc * 256 + c];
      OALL[(size_t)(ML + mc) * 1024 + 256 + c] = f2bf(x0 * (acc[j] * rn + z * bias));
    }
  }
  {
    const int wave = tid >> 6;
    const float* MOD = (const float*)(p->ws + O_MOD);
    for (int q = 0; q < 8; ++q) {
      int m = m0 + wave * 8 + q;
      const float* modl = MOD + (size_t)l * 27648 + mod_index(m) * 9216;
      const float* xs = (m < ML) ? p->out + (size_t)m * 1024 : (const float*)(p->ws + O_XC) + (size_t)(m - ML) * 1024;
      row_op(p, m, xs, nullptr, nullptr, nullptr, nullptr, 0, 0.f, p->in[6] + (size_t)(l * 3 + 1) * 1024, modl, 1, (u16*)(p->ws + O_H));
    }
  }
}

template <int BM>
DI void t5_tile(CP p, int l, int m0, int n0, char* smem) {
  constexpr int WNT = (BM == 256) ? 2 : 1;
  const u16* H = (const u16*)(p->ws + O_H);
  const u16* OALL = (const u16*)(p->ws + S_OALL);
  u16* ACCM = (u16*)(p->ws + S_ACCM);
  const int lane = tidx() & 63, wave = tidx() >> 6, r = lane & 31;
  const int wn = (BM == 256) ? (wave & 1) : (wave & 3);
  f32x16 accs[2][WNT];
  zero_acc<WNT>(accs);
#pragma unroll 1
  for (int n = 0; n < 4; ++n) {
    f32x16 g[2][WNT], u[2][WNT];
    zero_acc<WNT>(g);
    gemm_main<BM, WNT>(H, 1024, (const u16*)(p->ws + O_WGATE) + (size_t)n * 1024 * 1024, 1024, m0, n0, smem, g);
    const float* bgp = p->in[43] + (size_t)(l * 4 + n) * 1024 + n0 + 32 * WNT * wn + r;
#pragma unroll
    for (int nt = 0; nt < WNT; ++nt) {
      const float bg = bgp[32 * nt];
#pragma unroll
      for (int mt = 0; mt < 2; ++mt)
#pragma unroll
        for (int i = 0; i < 16; ++i) g[mt][nt][i] = __builtin_amdgcn_rcpf(1.f + __expf(-(g[mt][nt][i] + bg)));
    }
    zero_acc<WNT>(u);
    gemm_main<BM, WNT>(OALL + 256 * n, 1024, (const u16*)(p->ws + O_WUP) + (size_t)n * 1024 * 256, 256, m0, n0, smem, u);
#pragma unroll
    for (int mt = 0; mt < 2; ++mt)
#pragma unroll
      for (int nt = 0; nt < WNT; ++nt)
#pragma unroll
        for (int i = 0; i < 16; ++i) accs[mt][nt][i] += g[mt][nt][i] * u[mt][nt][i];
  }
  store_bf16<BM, WNT>(accs, ACCM, 1024, m0, n0);
}
DI void ph_t5(CP p, int l, char* smem, int nm = 130) {
  const int total = nm * 8;
  const int full = (gridDim.x == 256) ? (total & ~255) : total;
  for (int it = blockIdx.x; it < full; it += gridDim.x) {
    const int t = xcd_seq(it);
    t5_tile<256>(p, l, (t >> 3) * 256, (t & 7) * 128, smem);
  }
  const int nsub = (total - full) * 2;
  for (int it = blockIdx.x; it < nsub; it += gridDim.x) {
    const int t = full + (it >> 1);
    t5_tile<128>(p, l, (t >> 3) * 256 + (it & 1) * 128, (t & 7) * 128, smem);
  }
}
DI void ph_t6(CP p, char* smem, int nm = 130) { g8_phase(p, S_ACCM, O_WO, S_YM, 1024, 4, 1024, smem, nm); }

#define XB_TMO      128
#define XB_XCNT(j)  (256  + 64 * (j))
#define XB_XSUB(j)  (1280 + 64 * (j))
#define XB_XGEN(j)  (2304 + 64 * (j))
#define XB_TOP      3328
#define XB_TOPGEN   3392
#define XCD_BAR_WORDS 3456
#define XB_SPIN_CAP (1u << 18)
#define LAS __attribute__((address_space(3)))

__device__ __forceinline__ unsigned xb_ld(unsigned* p)              { return __hip_atomic_load(p, __ATOMIC_RELAXED, __HIP_MEMORY_SCOPE_AGENT); }
__device__ __forceinline__ unsigned xb_add(unsigned* p, unsigned v) { return __hip_atomic_fetch_add(p, v, __ATOMIC_RELAXED, __HIP_MEMORY_SCOPE_AGENT); }
__device__ __forceinline__ unsigned xb_xcc_id() { return (unsigned)__builtin_amdgcn_s_getreg((3 << 11) | 20) & 0xFu; }
#define XB_SPIN(cond, bar) do { unsigned _sp = 0; while (cond) { __builtin_amdgcn_s_sleep(1); \
    if ((++_sp & 255u) == 0u) { if (xb_ld(&(bar)[XB_TMO])) break; if (_sp > XB_SPIN_CAP) { atomicAdd(&(bar)[XB_TMO], 1u); break; } } } } while (0)

struct XcdBarrier {
    unsigned* bar; unsigned x;
    volatile LAS unsigned* st;
};

__device__ __forceinline__ XcdBarrier xcd_barrier_post(unsigned* bar, volatile LAS unsigned* st) {
    XcdBarrier b; b.bar = bar; b.x = xb_xcc_id(); b.st = st;
    if (threadIdx.x == 0) (void)xb_add(&bar[XB_XCNT(b.x)], 1u);
    return b;
}
__device__ __forceinline__ void xcd_barrier_complete(unsigned* bar, unsigned x, unsigned& nloc, unsigned& nx) {
    const unsigned G = gridDim.x * gridDim.y * gridDim.z;
    unsigned sum, cnt, mine, sp = 0u;
    for (;;) {
        sum = 0u; cnt = 0u; mine = 0u;
#pragma unroll
        for (unsigned j = 0; j < 16; ++j) { const unsigned c = xb_ld(&bar[XB_XCNT(j)]); sum += c; cnt += (c > 0u) ? 1u : 0u; mine = (j == x) ? c : mine; }
        if (sum == G) break;
        __builtin_amdgcn_s_sleep(1);
        if ((++sp & 255u) == 0u) { if (xb_ld(&bar[XB_TMO])) break; if (sp > XB_SPIN_CAP) { atomicAdd(&bar[XB_TMO], 1u); break; } }
    }
    nloc = mine > 0u ? mine : 1u; nx = cnt > 0u ? cnt : 1u;
}

__device__ __forceinline__ void xcd_barrier(const XcdBarrier& b) {
    asm volatile("s_waitcnt vmcnt(0)" ::: "memory");
    __syncthreads();
    if (threadIdx.x == 0) {
        unsigned* bar = b.bar;
        __builtin_amdgcn_s_waitcnt(0);
        unsigned nloc = b.st[0], nx = b.st[1];
        if (nloc == 0u) { xcd_barrier_complete(bar, b.x, nloc, nx); b.st[0] = nloc; b.st[1] = nx; }
        const unsigned old = xb_add(&bar[XB_XSUB(b.x)], 1u);
        const unsigned gen = old / nloc;
        if (old + 1u == (gen + 1u) * nloc) {
            __builtin_amdgcn_fence(__ATOMIC_RELEASE, "agent");
            asm volatile("s_waitcnt vmcnt(0)" ::: "memory");
            const unsigned og = xb_add(&bar[XB_TOP], 1u);
            const unsigned tg = og / nx;
            if (og + 1u == (tg + 1u) * nx) xb_add(&bar[XB_TOPGEN], 1u);
            else XB_SPIN(xb_ld(&bar[XB_TOPGEN]) == tg, bar);
            __builtin_amdgcn_fence(__ATOMIC_ACQUIRE, "agent");
            xb_add(&bar[XB_XGEN(b.x)], 1u);
            asm volatile("s_waitcnt vmcnt(0)" ::: "memory");
        } else {
            XB_SPIN(xb_ld(&bar[XB_XGEN(b.x)]) == gen, bar);
            __builtin_amdgcn_fence(__ATOMIC_ACQUIRE, "agent");
            asm volatile("s_waitcnt vmcnt(0)" ::: "memory");
        }
    }
    __syncthreads();
}


__global__ void __launch_bounds__(NT) mega(Params p_) {
  __shared__ __attribute__((aligned(16))) char smem[SMEM];
  __shared__ int s_item;
  cg::grid_group grid = cg::this_grid();
  const int ph0 = p_.ph0, ph1 = p_.ph1;
  CP p = (CP)__builtin_amdgcn_kernarg_segment_ptr();
  __shared__ uint4 xb_words;
  if (ph1 - ph0 > 1) {
    if (threadIdx.x == 0) xb_words = make_uint4(0u, 0u, 0u, 0u);
    __syncthreads();
    (void)xcd_barrier_post((unsigned*)(p_.ws + O_BAR), (volatile LAS unsigned*)&xb_words);
  }
#if PROBE_MASK
  long long pr_sum = 0, pr_t0 = wall_clock64();
#endif
  for (int ph = ph0; ph < ph1; ++ph) {
    if (ph == 17 && ph1 - ph0 > 1) continue;
    asm volatile("" : "+s"(p));
    if (ph == 0) { if (PH_ON(16)) ph_prep(p, smem); }
    else {
      const int l = (ph - 1) >> 4, k = (ph - 1) & 15;
      switch (k) {
        case 0: if (PH_ON(0)) for (int rep = 0; rep < REP_EW; ++rep) {
          const int nrow = (l == 0) ? (M / 8) : 0;
          const int total = CVT_TOTAL + 260 + nrow;
          for (int it = blockIdx.x; it < total; it += gridDim.x) {
            if (it < CVT_TOTAL) cvt_tile(p, l, it, smem);
            else if (it < CVT_TOTAL + 260) filt_item(p, l, it - CVT_TOTAL, smem);
            else row_dispatch(p, 0, 0, (it - CVT_TOTAL - 260) * 8 + (tidx() >> 6));
          }
        } break;
        case 1: if (PH_ON(1)) for (int rep = 0; rep < REP_GEMM; ++rep) ph_ffn1(p, 0, smem); break;
        case 2: if (PH_ON(2)) for (int rep = 0; rep < REP_GEMM; ++rep) ph_ffn2(p, 0, smem); break;
        case 3: if (PH_ON(3)) ph_rows(p, l, 1); break;
        case 4: if (PH_ON(4)) for (int rep = 0; rep < REP_GEMM; ++rep) ph_t1(p, smem); break;
        case 5: if (PH_ON(5)) for (int rep = 0; rep < REP_EW; ++rep) for (int t = blockIdx.x; t < 520; t += gridDim.x) t2a_tile(p, l, t, smem); break;
        case 6: if (PH_ON(6)) for (int rep = 0; rep < REP_EW2; ++rep) ph_t2b(p, smem); break;
        case 7: if (PH_ON(7)) for (int t = blockIdx.x; t < 520; t += gridDim.x) t2c_tile(p, l, t, smem); break;
        case 8: if (PH_ON(8)) for (int rep = 0; rep < REP_T3; ++rep) ph_t3(p, l, smem, &s_item, rep); break;
        case 9: if (PH_ON(9)) for (int rep = 0; rep < REP_EW2; ++rep) for (int t = blockIdx.x; t < (l == 1 ? 512 : 520); t += gridDim.x) t4_tile(p, l, t, smem); break;
        case 10: if (PH_ON(10)) for (int rep = 0; rep < REP_GEMM; ++rep) ph_t5(p, l, smem, l == 1 ? 128 : 130); break;
        case 11: if (PH_ON(11)) for (int rep = 0; rep < REP_GEMM; ++rep) ph_t6(p, smem, l == 1 ? 128 : 130); break;
        case 12: if (PH_ON(12)) ph_rows(p, l, 2, l == 1 ? ML : M); break;
        case 13: if (PH_ON(13)) for (int rep = 0; rep < REP_GEMM; ++rep) ph_ffn1(p, 1, smem, l == 1 ? 128 : 130); break;
        case 14: if (PH_ON(14)) for (int rep = 0; rep < REP_GEMM; ++rep) ph_ffn2(p, 1, smem, l == 1 ? 128 : 130); break;
        default: if (PH_ON(15)) {
          ph_rows(p, l, 3, l == 1 ? ML : M);
          if (l == 0 && ph1 - ph0 > 1) {
            const int total = CVT_TOTAL + 260;
            for (int it = blockIdx.x; it < total; it += gridDim.x) {
              if (it < CVT_TOTAL) cvt_tile(p, 1, it, smem);
              else filt_item(p, 1, it - CVT_TOTAL, smem);
            }
          }
        } break;
      }
    }
    if (ph + 1 < ph1) {
      if (ph == ph0) { __threadfence(); grid.sync(); __threadfence(); }
      else {
        XcdBarrier xb;
        xb.bar = (unsigned*)(p->ws + O_BAR); xb.x = xb_xcc_id(); xb.st = (volatile LAS unsigned*)&xb_words;
        xcd_barrier(xb);
      }
    }
#if PROBE_MASK
    {
      long long t1 = wall_clock64();
      int kb = (ph == 0) ? 16 : ((ph - 1) & 15);
      if ((PROBE_MASK >> kb) & 1) pr_sum += t1 - pr_t0;
      pr_t0 = t1;
    }
#endif
  }
#if PROBE_MASK
  if (blockIdx.x == 0) {
    long long te = wall_clock64();
    while (wall_clock64() - te < pr_sum) __builtin_amdgcn_s_sleep(8);
  }
#endif
}

extern "C" void kernel_launch(void* const* d_in, const int* in_sizes, int n_in, void* d_out, int out_size, void* d_ws,
                              size_t ws_size, hipStream_t stream) {
  if (n_in < 45 || ws_size < WS_NEED) {
    fprintf(stderr, "kernel_launch: bad inputs (n_in=%d ws=%zu need=%zu)\n", n_in, ws_size, (size_t)WS_NEED);
    return;
  }
  Params p{};
  for (int i = 0; i < 45; ++i) p.in[i] = (const float*)d_in[i];
  p.out = (float*)d_out;
  p.ws = (char*)d_ws;
#if COOP
  p.ph0 = 0; p.ph1 = NPH;
  hipMemsetAsync((char*)d_ws + O_BAR, 0, 16384, stream);
  void* args[] = {&p};
  hipError_t e = hipLaunchCooperativeKernel((void*)mega, dim3(256), dim3(NT), args, 0, stream);
  if (e != hipSuccess) fprintf(stderr, "cooperative launch failed: %s\n", hipGetErrorString(e));
#else
  for (int ph = 0; ph < NPH; ++ph) {
    p.ph0 = ph; p.ph1 = ph + 1;
    hipLaunchKernelGGL(mega, dim3(256), dim3(NT), 0, stream, p);
  }
#endif
}
```

```cpp
#include <hip/hip_runtime.h>
#include <hip/hip_cooperative_groups.h>
#include <cstdio>
namespace cg = cooperative_groups;

#define DI __device__ __forceinline__
typedef unsigned short u16;
typedef unsigned int u32;
typedef short bf16x8 __attribute__((ext_vector_type(8)));
typedef short s16x4 __attribute__((ext_vector_type(4)));
typedef float f32x16 __attribute__((ext_vector_type(16)));
typedef __bf16 bf16x2_t __attribute__((ext_vector_type(2)));
typedef float f32x2_t __attribute__((ext_vector_type(2)));
typedef float f2v __attribute__((ext_vector_type(2)));

#ifndef COOP
#define COOP 1
#endif
#ifndef PHSEL
#define PHSEL -1
#endif
#ifndef T3SEL
#define T3SEL -1
#endif
#ifndef REP_T3
#define REP_T3 1
#endif
#ifndef REP_EW
#define REP_EW 1
#endif
#ifndef REP_EW2
#define REP_EW2 1
#endif
#ifndef REP_GEMM
#define REP_GEMM 1
#endif
#ifndef PROBE_MASK
#define PROBE_MASK 0
#endif
#define PH_ON(k) (PHSEL < 0 || PHSEL == (k))
#define T3_ON(k) (T3SEL < 0 || T3SEL == (k))

constexpr int D = 1024, ML = 32768, MC = 512, M = 33280, TK = 16640;
constexpr int DFF = 2816, PS = 3072;
constexpr int NT = 512;
constexpr int RKROW = 33024, OFFC = 16408;
constexpr int NPH = 33;
constexpr int SMEM = 147456;

constexpr size_t O_WFFN1 = 0;
constexpr size_t O_WFFN2 = O_WFFN1 + 2ull * 5632 * 1024 * 2;
constexpr size_t O_WIN = O_WFFN2 + 2ull * 1024 * 2816 * 2;
constexpr size_t O_WGATE = O_WIN + 3072ull * 1024 * 2;
constexpr size_t O_WUP = O_WGATE + 4ull * 1024 * 1024 * 2;
constexpr size_t O_WO = O_WUP + 4ull * 1024 * 256 * 2;
constexpr size_t O_WQB = O_WO + 1024ull * 1024 * 2;
constexpr size_t O_WKVB = O_WQB + 384 * 192 * 2;
constexpr size_t O_W2 = O_WKVB + 512 * 128 * 2;
constexpr size_t O_A2 = O_W2 + 2 * 256 * 64 * 2;
constexpr size_t O_G2 = O_A2 + 2 * 256 * 64 * 2;
constexpr size_t O_MOD = O_G2 + 256 * 128 * 2;
constexpr size_t O_CNT = O_MOD + 2ull * 3 * 9216 * 4;
constexpr size_t O_BAR = O_CNT + 256;
constexpr size_t O_XC = O_BAR + 16384;
constexpr size_t O_H = O_XC + 512ull * 1024 * 4;
constexpr size_t O_RKG = O_H + (size_t)M * 1024 * 2;
constexpr size_t O_HFC = O_RKG + 256ull * RKROW * 2;
constexpr size_t O_HPART = O_HFC + 256ull * 512 * 4;
constexpr size_t O_ZC = O_HPART + 260ull * 512 * 4;
constexpr size_t O_X0C = O_ZC + 512ull * 256 * 4;
constexpr size_t O_S = O_X0C + 512ull * 256 * 4;
constexpr size_t O_QD = O_H;
constexpr size_t O_KD = O_QD + 2ull * 8 * TK * 32 * 2;
constexpr size_t O_VDT = O_KD + 2ull * 8 * TK * 32 * 2;
constexpr size_t O_ZT = O_VDT + 2ull * 4 * 64 * TK * 2;
static_assert(O_ZT + 256ull * 2 * 16384 * 2 <= O_RKG, "H alias overflow");
constexpr size_t SZ256 = (size_t)M * 256 * 2;
constexpr size_t S_R = O_S;
constexpr size_t S_KRAW = S_R + SZ256;
constexpr size_t S_V = S_KRAW + SZ256;
constexpr size_t S_KK = S_V + SZ256;
constexpr size_t S_X0T = S_KK + SZ256;
constexpr size_t S_KM = S_X0T + 256ull * 2 * 16384 * 2;
constexpr size_t S_P = S_KM + 2ull * 4 * TK * 96 * 2;
constexpr size_t S_LIN = S_P + (size_t)M * PS * 2;
constexpr size_t S_CQN = S_LIN + (size_t)M * 384 * 2;
constexpr size_t S_CKVN = S_CQN + (size_t)M * 192 * 2;
constexpr size_t S_END = S_CKVN + (size_t)M * 128 * 2;
constexpr size_t S_LOUT = S_P;
constexpr size_t S_QRAW = S_LOUT + (size_t)M * 1280 * 2;
constexpr size_t S_KVRAW = S_QRAW + (size_t)M * 384 * 2;
constexpr size_t S_QM = S_LIN;
constexpr size_t S_VMT = S_QM + 2ull * 4 * TK * 96 * 2;
static_assert(S_VMT + 2ull * 4 * 64 * TK * 2 <= S_END, "QM/VMT overflow");
constexpr size_t S_OALL = S_QRAW;
constexpr size_t S_YF = S_OALL + (size_t)M * 1024 * 2;
constexpr size_t S_YB = S_YF + SZ256;
constexpr size_t S_OHT = S_YB + SZ256;
static_assert(S_OHT + 256ull * 2 * 16384 * 2 <= S_LIN, "P-region overflow");
constexpr size_t S_ACCM = S_LOUT;
constexpr size_t S_YM = S_R;
static_assert(S_YM + (size_t)M * 1024 * 2 <= S_P, "YM overflow");
constexpr size_t S_ACT = O_S;
constexpr size_t S_Y = S_ACT + (size_t)M * DFF * 2;
static_assert(S_Y + (size_t)M * 1024 * 2 <= S_END, "FFN overflow");
constexpr size_t WS_NEED = S_END;

struct Params {
  const float* in[45];
  float* out;
  char* ws;
  int ph0, ph1;
};
typedef const __attribute__((address_space(4))) Params* CP;

DI float one_f() { float o = 1.f; asm volatile("" : "+v"(o)); return o; }
DI int tidx() { int t = threadIdx.x; asm volatile("" : "+v"(t)); return t; }
DI u32 pk2(float a, float b) {
  f32x2_t v = {a, b};
  bf16x2_t r = __builtin_convertvector(v, bf16x2_t);
  return __builtin_bit_cast(u32, r);
}
DI u16 f2bf(float f) { return (u16)(pk2(f, 0.f) & 0xffffu); }
DI float bf2f(u16 v) { return __uint_as_float(((u32)v) << 16); }
DI void unpack8(const uint4& v, float (&f)[8]) {
  f[0] = __uint_as_float(v.x << 16); f[1] = __uint_as_float(v.x & 0xffff0000u);
  f[2] = __uint_as_float(v.y << 16); f[3] = __uint_as_float(v.y & 0xffff0000u);
  f[4] = __uint_as_float(v.z << 16); f[5] = __uint_as_float(v.z & 0xffff0000u);
  f[6] = __uint_as_float(v.w << 16); f[7] = __uint_as_float(v.w & 0xffff0000u);
}
DI void ld8(const u16* p, float (&f)[8]) { uint4 v = *(const uint4*)p; unpack8(v, f); }
DI uint4 pack8(const float (&f)[8]) {
  uint4 v; v.x = pk2(f[0], f[1]); v.y = pk2(f[2], f[3]); v.z = pk2(f[4], f[5]); v.w = pk2(f[6], f[7]); return v;
}
DI void st8(u16* p, const float (&f)[8]) { *(uint4*)p = pack8(f); }
DI void ld8f(const float* p, float (&f)[8]) {
  float4 a = *(const float4*)p, b = *(const float4*)(p + 4);
  f[0] = a.x; f[1] = a.y; f[2] = a.z; f[3] = a.w; f[4] = b.x; f[5] = b.y; f[6] = b.z; f[7] = b.w;
}
DI float sigmoidf_(float x) { return __builtin_amdgcn_rcpf(1.f + __expf(-x)); }
DI float tanhf_(float x) { return 1.f - 2.f * __builtin_amdgcn_rcpf(1.f + __expf(2.f * x)); }
DI float siluf_(float x) { return x / (1.f + expf(-x)); }
template <int CTRL> DI float dppf(float v) {
  return __builtin_bit_cast(float, __builtin_amdgcn_update_dpp(0, __builtin_bit_cast(int, v), CTRL, 0xF, 0xF, true));
}
DI float dpp_sum16(float v) {
  v += dppf<0xB1>(v);
  v += dppf<0x4E>(v);
  v += dppf<0x141>(v);
  v += dppf<0x140>(v);
  return v;
}
DI float wave_sum(float v) {
  v = dpp_sum16(v);
  v += __shfl_xor(v, 16);
  v += __shfl_xor(v, 32);
  return v;
}
DI float grp8_sum(float v) {
  v += dppf<0xB1>(v);
  v += dppf<0x4E>(v);
  v += dppf<0x141>(v);
  return v;
}
#define MFMA32(a, b, c) __builtin_amdgcn_mfma_f32_32x32x16_bf16((a), (b), (c), 0, 0, 0)
DI int crow(int i, int h) { return (i & 3) + 8 * (i >> 2) + 4 * h; }
DI int mod_index(int m) { return m < ML ? (m >> 14) : 2; }
DI float lam_init_of(int l) { return l == 0 ? 0.2f : 0.35550907f; }

DI float rope_inv(int i) { return exp2f(-(float)i * 1.6609640474436813f); }

DI void ph_prep(CP p, char* smem) {
  const int tid = tidx();
  if (blockIdx.x == 0 && tid < 64) ((u32*)(p->ws + O_CNT))[tid] = 0u;
  float* sv = (float*)smem;
  float* red = sv + 3072;
  for (int i = tid; i < 3072; i += NT) {
    int v = i >> 10, k = i & 1023;
    float c = (v < 2) ? p->in[1][v * 1024 + k] : p->in[3][k];
    sv[i] = siluf_(c);
  }
  __syncthreads();
  float* MOD = (float*)(p->ws + O_MOD);
  for (int it = blockIdx.x; it < 288; it += gridDim.x) {
    int l = it / 144, cb = (it % 144) * 64;
    int col = cb + (tid & 63), ks = tid >> 6;
    const float* w = p->in[4] + (size_t)l * 1024 * 9216 + col;
    float a0 = 0.f, a1 = 0.f, a2 = 0.f;
#pragma unroll 8
    for (int k = ks * 128; k < ks * 128 + 128; ++k) {
      float wv = w[(size_t)k * 9216];
      a0 += sv[k] * wv; a1 += sv[1024 + k] * wv; a2 += sv[2048 + k] * wv;
    }
    red[(0 * 8 + ks) * 64 + (tid & 63)] = a0;
    red[(1 * 8 + ks) * 64 + (tid & 63)] = a1;
    red[(2 * 8 + ks) * 64 + (tid & 63)] = a2;
    __syncthreads();
    if (tid < 192) {
      int v = tid >> 6, c = tid & 63;
      float s = 0.f;
#pragma unroll
      for (int q = 0; q < 8; ++q) s += red[(v * 8 + q) * 64 + c];
      MOD[(size_t)l * 27648 + v * 9216 + cb + c] = s + p->in[5][l * 9216 + cb + c];
    }
    __syncthreads();
  }
}

struct CvtJob { const float* src; u16* dst; int K, Nsrc, Ndst, mode; };
DI CvtJob cvt_job(CP p, int l, int j) {
  CvtJob c; c.mode = 0;
  char* ws = p->ws;
  if (j < 2) { c.src = p->in[8] + (size_t)(l * 2 + j) * 1024 * 5632; c.dst = (u16*)(ws + O_WFFN1) + (size_t)j * 5632 * 1024; c.K = 1024; c.Nsrc = 5632; c.Ndst = 5632; c.mode = 1; }
  else if (j < 4) { int f = j - 2; c.src = p->in[9] + (size_t)(l * 2 + f) * 2816 * 1024; c.dst = (u16*)(ws + O_WFFN2) + (size_t)f * 1024 * 2816; c.K = 2816; c.Nsrc = 1024; c.Ndst = 1024; }
  else if (j == 4) { c.src = p->in[10] + (size_t)l * 1024 * 3040; c.dst = (u16*)(ws + O_WIN); c.K = 1024; c.Nsrc = 3040; c.Ndst = 3072; }
  else if (j < 9) { int n = j - 5; c.src = p->in[42] + (size_t)(l * 4 + n) * 1024 * 1024; c.dst = (u16*)(ws + O_WGATE) + (size_t)n * 1024 * 1024; c.K = 1024; c.Nsrc = 1024; c.Ndst = 1024; }
  else if (j < 13) { int n = j - 9; c.src = p->in[41] + (size_t)(l * 4 + n) * 256 * 1024; c.dst = (u16*)(ws + O_WUP) + (size_t)n * 1024 * 256; c.K = 256; c.Nsrc = 1024; c.Ndst = 1024; }
  else if (j == 13) { c.src = p->in[44] + (size_t)l * 1024 * 1024; c.dst = (u16*)(ws + O_WO); c.K = 1024; c.Nsrc = 1024; c.Ndst = 1024; }
  else if (j == 14) { c.src = p->in[33] + (size_t)l * 192 * 384; c.dst = (u16*)(ws + O_WQB); c.K = 192; c.Nsrc = 384; c.Ndst = 384; }
  else if (j == 15) { c.src = p->in[35] + (size_t)l * 128 * 512; c.dst = (u16*)(ws + O_WKVB); c.K = 128; c.Nsrc = 512; c.Ndst = 512; }
  else if (j < 18) { int d = j - 16; c.src = p->in[13] + (size_t)(l * 2 + d) * 64 * 256; c.dst = (u16*)(ws + O_W2) + (size_t)d * 256 * 64; c.K = 64; c.Nsrc = 256; c.Ndst = 256; }
  else if (j < 20) { int d = j - 18; c.src = p->in[15] + (size_t)(l * 2 + d) * 64 * 256; c.dst = (u16*)(ws + O_A2) + (size_t)d * 256 * 64; c.K = 64; c.Nsrc = 256; c.Ndst = 256; }
  else { c.src = p->in[16] + (size_t)l * 128 * 256; c.dst = (u16*)(ws + O_G2); c.K = 128; c.Nsrc = 256; c.Ndst = 256; }
  return c;
}
DI int cvt_tiles(int j) {
  if (j < 2) return 16 * 88;
  if (j < 4) return 44 * 16;
  if (j == 4) return 16 * 48;
  if (j < 9) return 256;
  if (j < 13) return 4 * 16;
  if (j == 13) return 256;
  if (j == 14) return 3 * 6;
  if (j == 15) return 2 * 8;
  if (j < 20) return 4;
  return 2 * 4;
}
constexpr int CVT_TOTAL = 2 * 1408 + 2 * 704 + 768 + 4 * 256 + 4 * 64 + 256 + 18 + 16 + 16 + 8;

DI void cvt_tile(CP p, int l, int tile, char* smem) {
  int j = 0;
  for (; j < 21; ++j) { int n = cvt_tiles(j); if (tile < n) break; tile -= n; }
  CvtJob c = cvt_job(p, l, j);
  const int nkt = c.K >> 6;
  const int k0 = (tile % nkt) * 64, n0 = (tile / nkt) * 64;
  float* t = (float*)smem;
  const int tid = tidx();
#pragma unroll
  for (int e = 0; e < 2; ++e) {
    int idx = tid + NT * e;
    int kk = idx >> 4, n4 = (idx & 15) * 4;
    int nd = n0 + n4;
    int col;
    if (c.mode == 1) {
      int grp = nd >> 5, ab = (nd >> 4) & 1, cc = nd & 15;
      col = ab * 2816 + 16 * grp + cc;
    } else col = nd;
    float4 v = (col < c.Nsrc) ? *(const float4*)(c.src + (size_t)(k0 + kk) * c.Nsrc + col) : make_float4(0.f, 0.f, 0.f, 0.f);
    *(float4*)(t + kk * 68 + n4) = v;
  }
  __syncthreads();
#pragma unroll
  for (int e = 0; e < 4; ++e) {
    int idx = tid + NT * e;
    int nn = idx >> 5, k2 = (idx & 31) * 2;
    u32 v = pk2(t[k2 * 68 + nn], t[(k2 + 1) * 68 + nn]);
    *(u32*)(c.dst + (size_t)(n0 + nn) * c.K + k0 + k2) = v;
  }
  __syncthreads();
}

DI void filt_item(CP p, int l, int fi, char* smem) {
  const int tid = tidx();
  const bool lat = fi < 256;
  const int n = lat ? 16384 : 256;
  const int p0 = lat ? fi * 64 : (fi - 256) * 64;
  float* zf = (float*)smem;
  float* h1 = zf + 64 * 36;
  float* h2 = h1 + 4096;
  const float* w1 = p->in[24] + l * 33 * 64;
  const float* b1 = p->in[25] + l * 64;
  const float* f1 = p->in[26] + l * 64;
  const float* w2 = p->in[27] + l * 64 * 64;
  const float* b2 = p->in[28] + l * 64;
  const float* f2 = p->in[29] + l * 64;
  const float* w3 = p->in[30] + l * 64 * 512;
  for (int it = tid; it < 64 * 33; it += NT) {
    int pos = it / 33, e = it % 33;
    int pp = p0 + pos;
    float tt = (float)pp / (float)(n - 1);
    float wpos = 6.283185307179586f * (float)pp / (float)n;
    float v;
    if (e == 0) v = tt;
    else {
      int bi = (e - 1) & 15;
      float fr = 1e-4f + (float)bi * ((15.f - 1e-4f) / 15.f);
      float ang = wpos * fr;
      v = (e <= 16) ? __cosf(ang) : -__sinf(ang);
    }
    zf[pos * 36 + e] = v;
  }
  __syncthreads();
#pragma unroll 1
  for (int e = 0; e < 8; ++e) {
    int it = tid + NT * e;
    int pos = it >> 6, k = it & 63;
    float a = b1[k];
#pragma unroll 3
    for (int q = 0; q < 33; ++q) a += zf[pos * 36 + q] * w1[q * 64 + k];
    h1[pos * 64 + k] = __sinf(f1[k] * a);
  }
  __syncthreads();
#pragma unroll 1
  for (int e = 0; e < 8; ++e) {
    int it = tid + NT * e;
    int pos = it >> 6, k = it & 63;
    float a = b2[k];
#pragma unroll 4
    for (int q = 0; q < 64; ++q) a += h1[pos * 64 + q] * w2[q * 64 + k];
    h2[k * 64 + pos] = __sinf(f2[k] * a);
  }
  __syncthreads();
  {
    const int c2 = tid, c = c2 & 255;
    const bool bwd = c2 >= 256;
    const float mind = -3.0701134573253945f, maxd = -15.350567286626973f;
    const float dl = fabsf(mind + (float)c * ((maxd - mind) / 255.f));
    float ssq = 0.f;
    u16* rk = (u16*)(p->ws + O_RKG) + (size_t)c * RKROW;
    float* hfc = (float*)(p->ws + O_HFC);
#pragma unroll 1
    for (int g = 0; g < 4; ++g) {
      float acc[16];
#pragma unroll
      for (int j = 0; j < 16; ++j) acc[j] = 0.f;
#pragma unroll 2
      for (int k = 0; k < 64; ++k) {
        const float w = w3[k * 512 + c2];
        const float* hp = h2 + k * 64 + g * 16;
        float4 v0 = *(const float4*)(hp), v1 = *(const float4*)(hp + 4), v2 = *(const float4*)(hp + 8), v3 = *(const float4*)(hp + 12);
        acc[0] += v0.x * w; acc[1] += v0.y * w; acc[2] += v0.z * w; acc[3] += v0.w * w;
        acc[4] += v1.x * w; acc[5] += v1.y * w; acc[6] += v1.z * w; acc[7] += v1.w * w;
        acc[8] += v2.x * w; acc[9] += v2.y * w; acc[10] += v2.z * w; acc[11] += v2.w * w;
        acc[12] += v3.x * w; acc[13] += v3.y * w; acc[14] += v3.z * w; acc[15] += v3.w * w;
      }
#pragma unroll
      for (int j = 0; j < 16; ++j) {
        int pp = p0 + g * 16 + j;
        float tt = (float)pp / (float)(n - 1);
        float val = acc[j] * expf(-tt * dl);
        bool used = !(bwd && pp == n - 1);
        if (used) ssq += val * val;
        if (lat) {
          if (!bwd) rk[OFFC - pp] = f2bf(val);
          else if (used) rk[OFFC + pp + 1] = f2bf(val);
        } else {
          hfc[pp * 512 + c2] = val;
        }
      }
    }
    ((float*)(p->ws + O_HPART))[fi * 512 + c2] = ssq;
  }
  if (fi == 0) {
    u16* rkg = (u16*)(p->ws + O_RKG);
    for (int it = tid; it < 256 * 257; it += NT) {
      int c = it / 257, e = it % 257;
      int idx = e < 25 ? e : 32792 + (e - 25);
      rkg[(size_t)c * RKROW + idx] = 0;
    }
  }
  __syncthreads();
}

template <int NR>
DI void row_opN(const int (&m)[NR], const float* const (&xs)[NR], float* const (&xd)[NR], const u16* Y, const float* gpost,
                const float* const (&modpost)[NR], int sub_post, float wgt, const float* gpre, const float* const (&modpre)[NR], int sub_pre, u16* H) {
  const int lane = tidx() & 63;
  float xa[NR][8], xb[NR][8], ya[NR][8], yb[NR][8];
#pragma unroll
  for (int q = 0; q < NR; ++q) {
    ld8f(xs[q] + lane * 8, xa[q]);
    ld8f(xs[q] + 512 + lane * 8, xb[q]);
    if (Y) {
      ld8(Y + (size_t)m[q] * 1024 + lane * 8, ya[q]);
      ld8(Y + (size_t)m[q] * 1024 + 512 + lane * 8, yb[q]);
    }
  }
  if (Y) {
    float ss[NR];
#pragma unroll
    for (int q = 0; q < NR; ++q) {
      ss[q] = 0.f;
#pragma unroll
      for (int j = 0; j < 8; ++j) ss[q] += ya[q][j] * ya[q][j] + yb[q][j] * yb[q][j];
    }
#pragma unroll
    for (int o = 32; o; o >>= 1)
#pragma unroll
      for (int q = 0; q < NR; ++q) ss[q] += __shfl_xor(ss[q], o);
    float gp0[8], gp1[8];
    ld8f(gpost + lane * 8, gp0); ld8f(gpost + 512 + lane * 8, gp1);
#pragma unroll
    for (int q = 0; q < NR; ++q) {
      const float rs = rsqrtf(ss[q] * (1.f / 1024.f) + 1e-6f);
      const float* gate = modpost[q] + (sub_post * 3 + 2) * 1024;
      float g[8];
      ld8f(gate + lane * 8, g);
#pragma unroll
      for (int j = 0; j < 8; ++j) xa[q][j] += wgt * g[j] * (ya[q][j] * rs * gp0[j]);
      ld8f(gate + 512 + lane * 8, g);
#pragma unroll
      for (int j = 0; j < 8; ++j) xb[q][j] += wgt * g[j] * (yb[q][j] * rs * gp1[j]);
    }
  }
#pragma unroll
  for (int q = 0; q < NR; ++q)
    if (xd[q]) {
      *(float4*)(xd[q] + lane * 8) = make_float4(xa[q][0], xa[q][1], xa[q][2], xa[q][3]);
      *(float4*)(xd[q] + lane * 8 + 4) = make_float4(xa[q][4], xa[q][5], xa[q][6], xa[q][7]);
      *(float4*)(xd[q] + 512 + lane * 8) = make_float4(xb[q][0], xb[q][1], xb[q][2], xb[q][3]);
      *(float4*)(xd[q] + 512 + lane * 8 + 4) = make_float4(xb[q][4], xb[q][5], xb[q][6], xb[q][7]);
    }
  if (gpre) {
    float ss[NR];
#pragma unroll
    for (int q = 0; q < NR; ++q) {
      ss[q] = 0.f;
#pragma unroll
      for (int j = 0; j < 8; ++j) ss[q] += xa[q][j] * xa[q][j] + xb[q][j] * xb[q][j];
    }
#pragma unroll
    for (int o = 32; o; o >>= 1)
#pragma unroll
      for (int q = 0; q < NR; ++q) ss[q] += __shfl_xor(ss[q], o);
    float g0[8], g1[8];
    ld8f(gpre + lane * 8, g0); ld8f(gpre + 512 + lane * 8, g1);
#pragma unroll
    for (int q = 0; q < NR; ++q) {
      const float rs = rsqrtf(ss[q] * (1.f / 1024.f) + 1e-6f);
      const float* shift = modpre[q] + (sub_pre * 3 + 0) * 1024;
      const float* scale = modpre[q] + (sub_pre * 3 + 1) * 1024;
      float sc[8], sh[8], hv[8];
      ld8f(scale + lane * 8, sc); ld8f(shift + lane * 8, sh);
#pragma unroll
      for (int j = 0; j < 8; ++j) hv[j] = xa[q][j] * rs * g0[j] * (1.f + sc[j]) + sh[j];
      st8(H + (size_t)m[q] * 1024 + lane * 8, hv);
      ld8f(scale + 512 + lane * 8, sc); ld8f(shift + 512 + lane * 8, sh);
#pragma unroll
      for (int j = 0; j < 8; ++j) hv[j] = xb[q][j] * rs * g1[j] * (1.f + sc[j]) + sh[j];
      st8(H + (size_t)m[q] * 1024 + 512 + lane * 8, hv);
    }
  }
}
DI void row_op(CP p, int m, const float* xs, float* xd, const u16* Y, const float* gpost, const float* modpost, int sub_post,
               float wgt, const float* gpre, const float* modpre, int sub_pre, u16* H) {
  const int mm[1] = {m};
  const float* const xss[1] = {xs};
  float* const xdd[1] = {xd};
  const float* const mp[1] = {modpost};
  const float* const mq[1] = {modpre};
  row_opN<1>(mm, xss, xdd, Y, gpost, mp, sub_post, wgt, gpre, mq, sub_pre, H);
}

DI void row_dispatch(CP p, int l, int kind, int m) {
  const float* MOD = (const float*)(p->ws + O_MOD);
  const int mi = mod_index(m);
  const float* modl = MOD + (size_t)l * 27648 + mi * 9216;
  float* xc = (float*)(p->ws + O_XC);
  float* xcur = (m < ML) ? p->out + (size_t)m * 1024 : xc + (size_t)(m - ML) * 1024;
  const float* xin = (m < ML) ? p->in[0] + (size_t)m * 1024 : p->in[2] + (size_t)(m - ML) * 1024;
  u16* H = (u16*)(p->ws + O_H);
  const float* npre = p->in[6] + (size_t)l * 3 * 1024;
  const float* npost = p->in[7] + (size_t)l * 3 * 1024;
  if (kind == 0) {
    row_op(p, m, xin, nullptr, nullptr, nullptr, nullptr, 0, 0.f, npre, modl, 0, H);
  } else if (kind == 1) {
    const float* xs = (l == 0) ? xin : xcur;
    row_op(p, m, xs, xcur, (const u16*)(p->ws + S_Y), npost, modl, 0, 0.5f, npre + 1024, modl, 1, H);
  } else if (kind == 2) {
    row_op(p, m, xcur, xcur, (const u16*)(p->ws + S_YM), npost + 1024, modl, 1, 1.0f, npre + 2048, modl, 2, H);
  } else {
    if (l == 0) {
      const float* modn = MOD + (size_t)1 * 27648 + mi * 9216;
      row_op(p, m, xcur, xcur, (const u16*)(p->ws + S_Y), npost + 2048, modl, 2, 0.5f, p->in[6] + 3 * 1024, modn, 0, H);
    } else {
      row_op(p, m, xcur, xcur, (const u16*)(p->ws + S_Y), npost + 2048, modl, 2, 0.5f, nullptr, nullptr, 0, nullptr);
    }
  }
}
DI void row_dispatch2(CP p, int l, int kind, int m0, int m1) {
  const float* MOD = (const float*)(p->ws + O_MOD);
  float* xc = (float*)(p->ws + O_XC);
  const int mm[2] = {m0, m1};
  const float* modl[2]; const float* modn[2]; float* xcur[2]; const float* xin[2];
#pragma unroll
  for (int q = 0; q < 2; ++q) {
    const int m = mm[q], mi = mod_index(m);
    modl[q] = MOD + (size_t)l * 27648 + mi * 9216;
    modn[q] = MOD + (size_t)1 * 27648 + mi * 9216;
    xcur[q] = (m < ML) ? p->out + (size_t)m * 1024 : xc + (size_t)(m - ML) * 1024;
    xin[q] = (m < ML) ? p->in[0] + (size_t)m * 1024 : p->in[2] + (size_t)(m - ML) * 1024;
  }
  u16* H = (u16*)(p->ws + O_H);
  const float* npre = p->in[6] + (size_t)l * 3 * 1024;
  const float* npost = p->in[7] + (size_t)l * 3 * 1024;
  const float* const ml[2] = {modl[0], modl[1]};
  const float* const mn[2] = {modn[0], modn[1]};
  float* const xd[2] = {xcur[0], xcur[1]};
  const float* const xsc[2] = {xcur[0], xcur[1]};
  const float* const xsi[2] = {xin[0], xin[1]};
  if (kind == 1) {
    if (l == 0) row_opN<2>(mm, xsi, xd, (const u16*)(p->ws + S_Y), npost, ml, 0, 0.5f, npre + 1024, ml, 1, H);
    else row_opN<2>(mm, xsc, xd, (const u16*)(p->ws + S_Y), npost, ml, 0, 0.5f, npre + 1024, ml, 1, H);
  } else if (kind == 2) {
    row_opN<2>(mm, xsc, xd, (const u16*)(p->ws + S_YM), npost + 1024, ml, 1, 1.0f, npre + 2048, ml, 2, H);
  } else {
    if (l == 0) row_opN<2>(mm, xsc, xd, (const u16*)(p->ws + S_Y), npost + 2048, ml, 2, 0.5f, p->in[6] + 3 * 1024, mn, 0, H);
    else row_opN<2>(mm, xsc, xd, (const u16*)(p->ws + S_Y), npost + 2048, ml, 2, 0.5f, nullptr, mn, 0, nullptr);
  }
}
DI void ph_rows(CP p, int l, int kind, int mlim = M) {
  const int wave = tidx() >> 6;
  const int stride = gridDim.x * 8;
  int m = blockIdx.x * 8 + wave;
  for (; m + stride < mlim; m += 2 * stride) row_dispatch2(p, l, kind, m, m + stride);
  if (m < mlim) row_dispatch(p, l, kind, m);
}

template <int BM, int WNT>
DI void gemm_main(const u16* __restrict__ A, int lda, const u16* __restrict__ BT, int K, int m0, int n0, char* lds,
                  f32x16 (&acc)[2][WNT]) {
  constexpr int AE = BM / 64;
  constexpr int STG = (BM + 128) * 144;
  constexpr int WN = 32 * WNT;
  const int tid = tidx(), lane = tid & 63, wave = tid >> 6, r = lane & 31, h = lane >> 5;
  const int wm = (BM == 256) ? (wave >> 1) : (wave >> 2);
  const int wn = (BM == 256) ? (wave & 1) : (wave & 3);
  const int KT = K >> 6;
  uint4 ra0, ra1, ra2 = make_uint4(0, 0, 0, 0), ra3 = make_uint4(0, 0, 0, 0), rb0, rb1;
  const u16* Ap = A + (size_t)(m0 + (tid >> 3)) * lda + (tid & 7) * 8;
  const u16* Bp = BT + (size_t)(n0 + (tid >> 3)) * K + (tid & 7) * 8;
  const size_t astr = (size_t)64 * lda, bstr = (size_t)64 * K;
  ra0 = *(const uint4*)(Ap); ra1 = *(const uint4*)(Ap + astr);
  if constexpr (AE == 4) { ra2 = *(const uint4*)(Ap + 2 * astr); ra3 = *(const uint4*)(Ap + 3 * astr); }
  rb0 = *(const uint4*)(Bp); rb1 = *(const uint4*)(Bp + bstr);
  const int sto = (tid >> 3) * 144 + (tid & 7) * 16;
  {
    char* sn = lds;
    *(uint4*)(sn + sto) = ra0; *(uint4*)(sn + sto + 64 * 144) = ra1;
    if constexpr (AE == 4) { *(uint4*)(sn + sto + 128 * 144) = ra2; *(uint4*)(sn + sto + 192 * 144) = ra3; }
    *(uint4*)(sn + BM * 144 + sto) = rb0; *(uint4*)(sn + BM * 144 + sto + 64 * 144) = rb1;
  }
  __syncthreads();
  const int aoff = (64 * wm + r) * 144 + 16 * h;
  const int boff = BM * 144 + (WN * wn + r) * 144 + 16 * h;
#pragma unroll 1
  for (int kt = 0; kt < KT; ++kt) {
    const bool more = kt + 1 < KT;
    if (more) {
      const int ko = (kt + 1) * 64;
      ra0 = *(const uint4*)(Ap + ko); ra1 = *(const uint4*)(Ap + astr + ko);
      if constexpr (AE == 4) { ra2 = *(const uint4*)(Ap + 2 * astr + ko); ra3 = *(const uint4*)(Ap + 3 * astr + ko); }
      rb0 = *(const uint4*)(Bp + ko); rb1 = *(const uint4*)(Bp + bstr + ko);
    }
    const char* sbase = lds + (kt & 1) * STG;
#pragma unroll
    for (int s = 0; s < 4; ++s) {
      bf16x8 a0 = *(const bf16x8*)(sbase + aoff + s * 32);
      bf16x8 a1 = *(const bf16x8*)(sbase + aoff + 32 * 144 + s * 32);
      bf16x8 b0 = *(const bf16x8*)(sbase + boff + s * 32);
      acc[0][0] = MFMA32(a0, b0, acc[0][0]);
      acc[1][0] = MFMA32(a1, b0, acc[1][0]);
      if constexpr (WNT == 2) {
        bf16x8 b1 = *(const bf16x8*)(sbase + boff + 32 * 144 + s * 32);
        acc[0][1] = MFMA32(a0, b1, acc[0][1]);
        acc[1][1] = MFMA32(a1, b1, acc[1][1]);
      }
    }
    if (more) {
      char* sn = lds + ((kt + 1) & 1) * STG;
      *(uint4*)(sn + sto) = ra0; *(uint4*)(sn + sto + 64 * 144) = ra1;
      if constexpr (AE == 4) { *(uint4*)(sn + sto + 128 * 144) = ra2; *(uint4*)(sn + sto + 192 * 144) = ra3; }
      *(uint4*)(sn + BM * 144 + sto) = rb0; *(uint4*)(sn + BM * 144 + sto + 64 * 144) = rb1;
    }
    __syncthreads();
  }
}
template <int WNT> DI void zero_acc(f32x16 (&acc)[2][WNT]) {
#pragma unroll
  for (int a = 0; a < 2; ++a)
#pragma unroll
    for (int b = 0; b < WNT; ++b)
#pragma unroll
      for (int i = 0; i < 16; ++i) acc[a][b][i] = 0.f;
}
DI void store_tile_pk(const f32x16& v, u16* C, int ldc, int row0, int col0, int r, int h) {
  const bool odd = r & 1;
#pragma unroll
  for (int i = 0; i < 16; i += 2) {
    float t0 = dppf<0xB1>(v[i]);
    float t1 = dppf<0xB1>(v[i + 1]);
    u32 w = odd ? pk2(t1, v[i + 1]) : pk2(v[i], t0);
    int row = row0 + (odd ? crow(i + 1, h) : crow(i, h));
    *(u32*)(C + (size_t)row * ldc + col0 + (r & ~1)) = w;
  }
}
template <int BM, int WNT>
DI void store_bf16(const f32x16 (&acc)[2][WNT], u16* C, int ldc, int m0, int n0) {
  const int lane = tidx() & 63, wave = tidx() >> 6, r = lane & 31, h = lane >> 5;
  const int wm = (BM == 256) ? (wave >> 1) : (wave >> 2);
  const int wn = (BM == 256) ? (wave & 1) : (wave & 3);
#pragma unroll
  for (int mt = 0; mt < 2; ++mt)
#pragma unroll
    for (int nt = 0; nt < WNT; ++nt)
      store_tile_pk(acc[mt][nt], C, ldc, m0 + 64 * wm + 32 * mt, n0 + 32 * WNT * wn + 32 * nt, r, h);
}
DI void gemm_main_256(const u16* __restrict__ A, int lda, const u16* __restrict__ BT, int K, int m0, int n0, char* lds,
                      f32x16 (&acc)[4][2]) {
  constexpr int STG = 512 * 144;
  const int tid = tidx(), lane = tid & 63, wave = tid >> 6, r = lane & 31, h = lane >> 5;
  const int wm = wave >> 2, wn = wave & 3;
  const int KT = K >> 6;
  const u16* Ap = A + (size_t)(m0 + (tid >> 3)) * lda + (tid & 7) * 8;
  const u16* Bp = BT + (size_t)(n0 + (tid >> 3)) * K + (tid & 7) * 8;
  const size_t astr = (size_t)64 * lda, bstr = (size_t)64 * K;
  uint4 ra0, ra1, ra2, ra3, rb0, rb1, rb2, rb3;
  ra0 = *(const uint4*)(Ap); ra1 = *(const uint4*)(Ap + astr); ra2 = *(const uint4*)(Ap + 2 * astr); ra3 = *(const uint4*)(Ap + 3 * astr);
  rb0 = *(const uint4*)(Bp); rb1 = *(const uint4*)(Bp + bstr); rb2 = *(const uint4*)(Bp + 2 * bstr); rb3 = *(const uint4*)(Bp + 3 * bstr);
  const int sto = (tid >> 3) * 144 + (tid & 7) * 16;
  {
    char* sn = lds;
    *(uint4*)(sn + sto) = ra0; *(uint4*)(sn + sto + 64 * 144) = ra1; *(uint4*)(sn + sto + 128 * 144) = ra2; *(uint4*)(sn + sto + 192 * 144) = ra3;
    sn += 256 * 144;
    *(uint4*)(sn + sto) = rb0; *(uint4*)(sn + sto + 64 * 144) = rb1; *(uint4*)(sn + sto + 128 * 144) = rb2; *(uint4*)(sn + sto + 192 * 144) = rb3;
  }
  __syncthreads();
  const int aoff = (128 * wm + r) * 144 + 16 * h;
  const int boff = 256 * 144 + (64 * wn + r) * 144 + 16 * h;
#pragma unroll 1
  for (int kt = 0; kt < KT; ++kt) {
    const bool more = kt + 1 < KT;
    if (more) {
      const int ko = (kt + 1) * 64;
      ra0 = *(const uint4*)(Ap + ko); ra1 = *(const uint4*)(Ap + astr + ko); ra2 = *(const uint4*)(Ap + 2 * astr + ko); ra3 = *(const uint4*)(Ap + 3 * astr + ko);
      rb0 = *(const uint4*)(Bp + ko); rb1 = *(const uint4*)(Bp + bstr + ko); rb2 = *(const uint4*)(Bp + 2 * bstr + ko); rb3 = *(const uint4*)(Bp + 3 * bstr + ko);
    }
    const char* sbase = lds + (kt & 1) * STG;
#pragma unroll
    for (int s = 0; s < 4; ++s) {
      bf16x8 b0 = *(const bf16x8*)(sbase + boff + s * 32);
      bf16x8 b1 = *(const bf16x8*)(sbase + boff + 32 * 144 + s * 32);
#pragma unroll
      for (int mt = 0; mt < 4; ++mt) {
        bf16x8 a = *(const bf16x8*)(sbase + aoff + mt * 32 * 144 + s * 32);
        acc[mt][0] = MFMA32(a, b0, acc[mt][0]);
        acc[mt][1] = MFMA32(a, b1, acc[mt][1]);
      }
    }
    if (more) {
      char* sn = lds + ((kt + 1) & 1) * STG;
      *(uint4*)(sn + sto) = ra0; *(uint4*)(sn + sto + 64 * 144) = ra1; *(uint4*)(sn + sto + 128 * 144) = ra2; *(uint4*)(sn + sto + 192 * 144) = ra3;
      sn += 256 * 144;
      *(uint4*)(sn + sto) = rb0; *(uint4*)(sn + sto + 64 * 144) = rb1; *(uint4*)(sn + sto + 128 * 144) = rb2; *(uint4*)(sn + sto + 192 * 144) = rb3;
    }
    __syncthreads();
  }
}
template <int BM, int WNT>
DI void gemm_bf16_tile(const u16* A, int lda, const u16* BT, int K, u16* C, int ldc, int m0, int n0, char* lds) {
  f32x16 acc[2][WNT];
  zero_acc<WNT>(acc);
  gemm_main<BM, WNT>(A, lda, BT, K, m0, n0, lds, acc);
  store_bf16<BM, WNT>(acc, C, ldc, m0, n0);
}

typedef float f32x4v __attribute__((ext_vector_type(4)));
#define LAS3 __attribute__((address_space(3)))
DI int g8_lds_byte(int r, int c) {
  int st = (r >> 4) * 2 + (c >> 5), rr = r & 15, cc = c & 31, ob = rr * 64 + cc * 2;
  return st * 1024 + (ob ^ (((ob >> 9) & 1) << 5));
}
DI void g8_stage_rc(int b, int& R, int& C) {
  int st = b / 1024, sb = b % 1024, swz = sb ^ (((sb >> 9) & 1) << 5);
  R = (st >> 1) * 16 + swz / 64; C = (st & 1) * 32 + (swz % 64) / 2;
}
DI void gemm8p(const u16* __restrict__ A, const u16* __restrict__ Bt, int K, int brow, int bcol, char* shmc,
               f32x4v (&acc)[2][2][4][2]) {
  constexpr int BK = 64, HALF = 128, HT = HALF * BK;
  u16* shm = (u16*)shmc;
  const int tid = tidx();
#define G8_SA(b, h) (shm + ((b) * 2 + (h)) * HT)
#define G8_SB(b, h) (shm + (4 + (b) * 2 + (h)) * HT)
  int g8_off0, g8_off1;
  { int _r, _c; g8_stage_rc(tid * 16, _r, _c); g8_off0 = _r * K + _c; g8_stage_rc(tid * 16 + 8192, _r, _c); g8_off1 = _r * K + _c; }
#define G8_STAGE(P, BASE, br, kt) do { const u16* _gb = (BASE) + ((long)(br) * K + (long)(kt) * BK); \
      __builtin_amdgcn_global_load_lds((const unsigned*)(_gb + g8_off0), (LAS3 unsigned*)((char*)(P) + tid * 16), 16, 0, 0); \
      __builtin_amdgcn_global_load_lds((const unsigned*)(_gb + g8_off1), (LAS3 unsigned*)((char*)(P) + tid * 16 + 8192), 16, 0, 0); } while (0)
#define G8_LDA(dst, b, h) _Pragma("unroll") for (int m = 0; m < 4; ++m) _Pragma("unroll") for (int k = 0; k < 2; ++k) \
    dst[m][k] = *reinterpret_cast<const bf16x8*>((char*)G8_SA(b, h) + g8_lds_byte(wr * 64 + m * 16 + fr, k * 32 + fq * 8))
#define G8_LDB(dst, b, h) _Pragma("unroll") for (int n = 0; n < 2; ++n) _Pragma("unroll") for (int k = 0; k < 2; ++k) \
    dst[n][k] = *reinterpret_cast<const bf16x8*>((char*)G8_SB(b, h) + g8_lds_byte(wc * 32 + n * 16 + fr, k * 32 + fq * 8))
#define G8_MMA(ai, bj, At_, Bt_) do { __builtin_amdgcn_s_setprio(1); \
    _Pragma("unroll") for (int m = 0; m < 4; ++m) _Pragma("unroll") for (int n = 0; n < 2; ++n) _Pragma("unroll") for (int k = 0; k < 2; ++k) \
      acc[ai][bj][m][n] = __builtin_amdgcn_mfma_f32_16x16x32_bf16(At_[m][k], Bt_[n][k], acc[ai][bj][m][n], 0, 0, 0); \
    __builtin_amdgcn_s_setprio(0); } while (0)
#define G8_WAIT_V(n) asm volatile("s_waitcnt vmcnt(" #n ")" ::: "memory")
#define G8_WAIT_L(n) asm volatile("s_waitcnt lgkmcnt(" #n ")" ::: "memory")
#define G8_BAR __builtin_amdgcn_s_barrier()
#define G8_SCHED __builtin_amdgcn_sched_barrier(0)
  const int wid = tid >> 6, lane = tid & 63, wr = wid >> 2, wc = wid & 3, fr = lane & 15, fq = lane >> 4;
  bf16x8 At[4][2], B0[2][2], B1[2][2];
  const int nt = K / BK;
  G8_STAGE(G8_SB(0, 0), Bt, bcol, 0); G8_STAGE(G8_SA(0, 0), A, brow, 0);
  G8_STAGE(G8_SB(0, 1), Bt, bcol + HALF, 0); G8_STAGE(G8_SA(0, 1), A, brow + HALF, 0);
  if (wr == 1) G8_BAR;
  G8_WAIT_V(4); G8_BAR;
  G8_STAGE(G8_SB(1, 0), Bt, bcol, 1); G8_STAGE(G8_SA(1, 0), A, brow, 1); G8_STAGE(G8_SB(1, 1), Bt, bcol + HALF, 1);
  G8_WAIT_V(6); G8_BAR;
#pragma unroll 1
  for (int t = 0; t < nt - 2; t += 2) {
    G8_LDB(B0, 0, 0); G8_SCHED; G8_LDA(At, 0, 0); G8_STAGE(G8_SA(1, 1), A, brow + HALF, t + 1);
    G8_WAIT_L(8); G8_BAR; G8_WAIT_L(0); G8_MMA(0, 0, At, B0); G8_BAR; G8_SCHED;
    G8_LDB(B1, 0, 1); G8_STAGE(G8_SB(0, 0), Bt, bcol, t + 2);
    G8_BAR; G8_WAIT_L(0); G8_MMA(0, 1, At, B1); G8_BAR;
    G8_LDA(At, 0, 1); G8_STAGE(G8_SA(0, 0), A, brow, t + 2);
    G8_BAR; G8_WAIT_L(0); G8_MMA(1, 0, At, B0); G8_BAR; G8_SCHED;
    G8_STAGE(G8_SB(0, 1), Bt, bcol + HALF, t + 2);
    G8_WAIT_V(6); G8_BAR; G8_MMA(1, 1, At, B1); G8_BAR;
    G8_LDB(B0, 1, 0); G8_SCHED; G8_LDA(At, 1, 0); G8_STAGE(G8_SA(0, 1), A, brow + HALF, t + 2);
    G8_WAIT_L(8); G8_BAR; G8_WAIT_L(0); G8_MMA(0, 0, At, B0); G8_BAR; G8_SCHED;
    G8_LDB(B1, 1, 1); G8_STAGE(G8_SB(1, 0), Bt, bcol, t + 3);
    G8_BAR; G8_WAIT_L(0); G8_MMA(0, 1, At, B1); G8_BAR;
    G8_LDA(At, 1, 1); G8_STAGE(G8_SA(1, 0), A, brow, t + 3);
    G8_BAR; G8_WAIT_L(0); G8_MMA(1, 0, At, B0); G8_BAR; G8_SCHED;
    G8_STAGE(G8_SB(1, 1), Bt, bcol + HALF, t + 3);
    G8_WAIT_V(6); G8_BAR; G8_MMA(1, 1, At, B1); G8_BAR;
  }
  { G8_LDB(B0, 0, 0); G8_LDA(At, 0, 0); G8_STAGE(G8_SA(1, 1), A, brow + HALF, nt - 1);
    G8_BAR; G8_WAIT_L(0); G8_MMA(0, 0, At, B0); G8_BAR;
    G8_LDB(B1, 0, 1); G8_BAR; G8_WAIT_L(0); G8_MMA(0, 1, At, B1); G8_BAR;
    G8_LDA(At, 0, 1); G8_WAIT_V(4); G8_BAR; G8_WAIT_L(0); G8_MMA(1, 0, At, B0); G8_MMA(1, 1, At, B1); G8_BAR; }
  { G8_LDB(B0, 1, 0); G8_LDA(At, 1, 0); G8_WAIT_V(2); G8_BAR; G8_WAIT_L(0); G8_MMA(0, 0, At, B0); G8_BAR;
    G8_LDB(B1, 1, 1); G8_WAIT_V(0); G8_BAR; G8_WAIT_L(0); G8_MMA(0, 1, At, B1); G8_BAR;
    G8_LDA(At, 1, 1); G8_BAR; G8_WAIT_L(0); G8_MMA(1, 0, At, B0); G8_MMA(1, 1, At, B1); G8_BAR; }
  if (wr == 0) G8_BAR;
}
DI void g8_store(const f32x4v& v, u16* C, int ldc, int row0, int col0, int fr, int fq) {
  const bool odd = fr & 1;
#pragma unroll
  for (int j = 0; j < 4; j += 2) {
    float t0 = dppf<0xB1>(v[j]);
    float t1 = dppf<0xB1>(v[j + 1]);
    u32 w = odd ? pk2(t1, v[j + 1]) : pk2(v[j], t0);
    int row = row0 + fq * 4 + j + (odd ? 1 : 0);
    *(u32*)(C + (size_t)row * ldc + col0 + (fr & ~1)) = w;
  }
}

DI int xcd_seq(int it) {
  if (gridDim.x != 256) return it;
  const int b = it & 255;
  return (it & ~255) + (b & 7) * 32 + (b >> 3);
}
DI void patch_mn(int q, int NM, int NN, int& mt, int& nt) {
  const int per = 4 * NN;
  const int g = q / per, rem = q - g * per;
  const int mrem = NM - 4 * g;
  const int mg = mrem < 4 ? mrem : 4;
  nt = rem / mg;
  mt = 4 * g + (rem - nt * mg);
}
DI void ph_ffn1(CP p, int f, char* smem, int nm = 130) {
  for (int it = blockIdx.x; it < 3072; it += gridDim.x) {
    CP q = p;
    asm volatile("" : "+s"(q));
    const u16* H = (const u16*)(q->ws + O_H);
    const u16* W = (const u16*)(q->ws + O_WFFN1) + (size_t)f * 5632 * 1024;
    const int t = xcd_seq(it);
    if (t >= nm * 22) continue;
    int mt_, nt_;
    patch_mn(t, nm, 22, mt_, nt_);
    const int brow = mt_ * 256, bcol = nt_ * 256;
    f32x4v acc[2][2][4][2];
#pragma unroll
    for (int a_ = 0; a_ < 2; ++a_)
#pragma unroll
      for (int b_ = 0; b_ < 2; ++b_)
#pragma unroll
        for (int m = 0; m < 4; ++m)
#pragma unroll
          for (int n = 0; n < 2; ++n) acc[a_][b_][m][n] = (f32x4v){0.f, 0.f, 0.f, 0.f};
    gemm8p(H, W, 1024, brow, bcol, smem, acc);
    asm volatile("" : "+s"(q));
    u16* ACT = (u16*)(q->ws + S_ACT);
    const int tid = tidx(), wid = tid >> 6, lane = tid & 63, wr = wid >> 2, wc = wid & 3, fr = lane & 15, fq = lane >> 4;
#pragma unroll
    for (int ai = 0; ai < 2; ++ai)
#pragma unroll
      for (int bj = 0; bj < 2; ++bj)
#pragma unroll
        for (int m = 0; m < 4; ++m) {
          f32x4v v;
#pragma unroll
          for (int j = 0; j < 4; ++j) {
            float a = acc[ai][bj][m][0][j], b = acc[ai][bj][m][1][j];
            v[j] = a * b * __builtin_amdgcn_rcpf(1.f + __expf(-a));
          }
          g8_store(v, ACT, DFF, brow + ai * 128 + wr * 64 + m * 16, (bcol + bj * 128 + wc * 32) / 2, fr, fq);
        }
  }
}
DI void g8_phase(CP p, size_t offA, size_t offB, size_t offC, int K, int NN, int ldc, char* smem, int nm = 130) {
  const int total = nm * NN;
  const int full = (gridDim.x == 256) ? (total & ~255) : total;
  for (int it = blockIdx.x; it < full; it += gridDim.x) {
    const int t = xcd_seq(it);
    int mt_, nt_;
    patch_mn(t, nm, NN, mt_, nt_);
    const int brow = mt_ * 256, bcol = nt_ * 256;
    CP q = p;
    asm volatile("" : "+s"(q));
    const u16* A = (const u16*)(q->ws + offA);
    const u16* Bt = (const u16*)(q->ws + offB);
    f32x4v acc[2][2][4][2];
#pragma unroll
    for (int a_ = 0; a_ < 2; ++a_)
#pragma unroll
      for (int b_ = 0; b_ < 2; ++b_)
#pragma unroll
        for (int m = 0; m < 4; ++m)
#pragma unroll
          for (int n = 0; n < 2; ++n) acc[a_][b_][m][n] = (f32x4v){0.f, 0.f, 0.f, 0.f};
    gemm8p(A, Bt, K, brow, bcol, smem, acc);
    asm volatile("" : "+s"(q));
    u16* C = (u16*)(q->ws + offC);
    const int tid = tidx(), wid = tid >> 6, lane = tid & 63, wr = wid >> 2, wc = wid & 3, fr = lane & 15, fq = lane >> 4;
#pragma unroll
    for (int ai = 0; ai < 2; ++ai)
#pragma unroll
      for (int bj = 0; bj < 2; ++bj)
#pragma unroll
        for (int m = 0; m < 4; ++m)
#pragma unroll
          for (int n = 0; n < 2; ++n)
            g8_store(acc[ai][bj][m][n], C, ldc, brow + ai * 128 + wr * 64 + m * 16, bcol + bj * 128 + wc * 32 + n * 16, fr, fq);
  }
  const int nsub = (total - full) * 4;
  for (int it = blockIdx.x; it < nsub; it += gridDim.x) {
    const int t = full + (it >> 2), sub = it & 3;
    int mt_, nt_;
    patch_mn(t, nm, NN, mt_, nt_);
    const int m0 = mt_ * 256 + (sub >> 1) * 128, n0 = nt_ * 256 + (sub & 1) * 128;
    gemm_bf16_tile<128, 1>((const u16*)(p->ws + offA), K, (const u16*)(p->ws + offB), K, (u16*)(p->ws + offC), ldc, m0, n0, smem);
  }
}
DI void ph_ffn2(CP p, int f, char* smem, int nm = 130) {
  g8_phase(p, S_ACT, O_WFFN2 + (size_t)f * 1024 * 2816 * 2, S_Y, DFF, 4, 1024, smem, nm);
}
DI void ph_t1(CP p, char* smem) { g8_phase(p, O_H, O_WIN, S_P, 1024, 12, PS, smem); }

DI void rope32(float (&x)[32], int row, int col) {
#pragma unroll
  for (int i = 0; i < 8; ++i) {
    float inv = rope_inv(i);
    float sr, cr, sc, cc;
    sr = __sinf((float)row * inv); cr = __cosf((float)row * inv);
    sc = __sinf((float)col * inv); cc = __cosf((float)col * inv);
    float a = x[i], b = x[i + 8];
    x[i] = a * cr - b * sr; x[i + 8] = b * cr + a * sr;
    float c = x[16 + i], d = x[24 + i];
    x[16 + i] = c * cc - d * sc; x[24 + i] = d * cc + c * sc;
  }
}
DI void ld32(const u16* p, float (&x)[32]) {
#pragma unroll
  for (int q = 0; q < 4; ++q) {
    uint4 v = *(const uint4*)(p + 8 * q);
    x[8 * q + 0] = __uint_as_float(v.x << 16); x[8 * q + 1] = __uint_as_float(v.x & 0xffff0000u);
    x[8 * q + 2] = __uint_as_float(v.y << 16); x[8 * q + 3] = __uint_as_float(v.y & 0xffff0000u);
    x[8 * q + 4] = __uint_as_float(v.z << 16); x[8 * q + 5] = __uint_as_float(v.z & 0xffff0000u);
    x[8 * q + 6] = __uint_as_float(v.w << 16); x[8 * q + 7] = __uint_as_float(v.w & 0xffff0000u);
  }
}
DI void st32(u16* p, const float (&x)[32]) {
#pragma unroll
  for (int q = 0; q < 4; ++q) {
    uint4 v;
    v.x = pk2(x[8 * q], x[8 * q + 1]); v.y = pk2(x[8 * q + 2], x[8 * q + 3]);
    v.z = pk2(x[8 * q + 4], x[8 * q + 5]); v.w = pk2(x[8 * q + 6], x[8 * q + 7]);
    *(uint4*)(p + 8 * q) = v;
  }
}

DI void t2a_tile(CP p, int l, int tl, char* smem) {
  const int tid = tidx();
  const int m0 = tl * 64;
  const bool lat = m0 < ML;
  int b, t0, n;
  if (lat) { b = m0 >> 14; t0 = m0 & 16383; n = 16384; } else { int mc = m0 - ML; b = mc >> 8; t0 = mc & 255; n = 256; }
  const int key0 = lat ? t0 : 16384 + t0;
  const u16* P = (const u16*)(p->ws + S_P);
  u16* Rb = (u16*)(p->ws + S_R); u16* KRAW = (u16*)(p->ws + S_KRAW); u16* Vb = (u16*)(p->ws + S_V); u16* KK = (u16*)(p->ws + S_KK);
  u16* LIN = (u16*)(p->ws + S_LIN); u16* CQN = (u16*)(p->ws + S_CQN); u16* CKVN = (u16*)(p->ws + S_CKVN);
  u16* KM = (u16*)(p->ws + S_KM); u16* QD = (u16*)(p->ws + O_QD); u16* KD = (u16*)(p->ws + O_KD); u16* VDT = (u16*)(p->ws + O_VDT);
  u16* ZT = (u16*)(p->ws + O_ZT); u16* X0T = (u16*)(p->ws + S_X0T);
  float* ZC = (float*)(p->ws + O_ZC); float* X0C = (float*)(p->ws + O_X0C);
  u16* zb = (u16*)smem;
  u16* xb = zb + 256 * 72;
  u16* vb = xb + 256 * 72;
  const float* mu = p->in[11] + l * 1152;
  const float* k_k = p->in[17] + l * 256;
#pragma unroll 1
  for (int e = 0; e < 18; ++e) {
    int it = tid + NT * e;
    int tok = it / 144, cg = it % 144;
    int t = t0 + tok, m = m0 + tok, c0 = cg * 8;
    const u16* pc = P + (size_t)m * PS + c0;
    float xc_[8], xp[8], xn[8], u[8], muv[8];
    ld8(pc, xc_);
    if (t > 0) ld8(pc - PS, xp); else {
#pragma unroll
      for (int j = 0; j < 8; ++j) xp[j] = 0.f;
    }
    if (t < n - 1) ld8(pc + PS, xn); else {
#pragma unroll
      for (int j = 0; j < 8; ++j) xn[j] = 0.f;
    }
    ld8f(mu + c0, muv);
#pragma unroll
    for (int j = 0; j < 8; ++j) u[j] = 0.5f * muv[j] * (xp[j] + xn[j]) + (1.f - muv[j]) * xc_[j];
    if (cg < 32) st8(Rb + (size_t)m * 256 + c0, u);
    else if (cg < 64) {
      int c = c0 - 256;
      st8(KRAW + (size_t)m * 256 + c, u);
      float kkv[8], kc[8];
      ld8f(k_k + c, kc);
      float ss = 0.f;
#pragma unroll
      for (int j = 0; j < 8; ++j) { kkv[j] = u[j] * kc[j]; ss += kkv[j] * kkv[j]; }
      ss = grp8_sum(ss);
      float inv = 1.f / fmaxf(sqrtf(ss), 1e-12f);
#pragma unroll
      for (int j = 0; j < 8; ++j) kkv[j] *= inv;
      st8(KK + (size_t)m * 256 + c, kkv);
    } else if (cg < 96) st8(Vb + (size_t)m * 256 + c0 - 512, u);
    else {
      int dst;
      if (cg < 112) { dst = 256 + c0 - 768;
#pragma unroll
        for (int j = 0; j < 8; ++j) u[j] = sigmoidf_(u[j]);
      } else if (cg < 120) { dst = c0 - 896;
#pragma unroll
        for (int j = 0; j < 8; ++j) u[j] = tanhf_(u[j]);
      } else if (cg < 128) { dst = 128 + c0 - 960;
#pragma unroll
        for (int j = 0; j < 8; ++j) u[j] = tanhf_(u[j]);
      } else if (cg < 136) dst = 64 + c0 - 1024;
      else dst = 192 + c0 - 1088;
      st8(LIN + (size_t)m * 384 + dst, u);
    }
  }
  const float* cw = p->in[22] + l * 3 * 768;
  const float* cb = p->in[23] + l * 768;
#pragma unroll 1
  for (int e = 0; e < 4; ++e) {
    int it = tid + NT * e;
    int tok = it >> 5, cg = it & 31;
    int t = t0 + tok, m = m0 + tok, c0 = cg * 8;
    float uu[3][8];
#pragma unroll
    for (int s = 0; s < 3; ++s) {
      int col = s * 256 + c0;
      const u16* pc = P + (size_t)m * PS + 1152 + col;
      float xc_[8], xp[8], xn[8], w0[8], w1[8], w2[8], bb[8];
      ld8(pc, xc_);
      if (t > 0) ld8(pc - PS, xp); else {
#pragma unroll
        for (int j = 0; j < 8; ++j) xp[j] = 0.f;
      }
      if (t < n - 1) ld8(pc + PS, xn); else {
#pragma unroll
        for (int j = 0; j < 8; ++j) xn[j] = 0.f;
      }
      ld8f(cw + col, w0); ld8f(cw + 768 + col, w1); ld8f(cw + 1536 + col, w2); ld8f(cb + col, bb);
#pragma unroll
      for (int j = 0; j < 8; ++j) uu[s][j] = xp[j] * w0[j] + xc_[j] * w1[j] + xn[j] * w2[j] + bb[j];
    }
    if (lat) {
#pragma unroll
      for (int j = 0; j < 8; ++j) {
        zb[(c0 + j) * 72 + tok] = f2bf(uu[2][j] * uu[1][j]);
        xb[(c0 + j) * 72 + tok] = f2bf(uu[0][j]);
      }
    } else {
      int mc = m - ML;
#pragma unroll
      for (int j = 0; j < 8; ++j) { ZC[mc * 256 + c0 + j] = uu[2][j] * uu[1][j]; X0C[mc * 256 + c0 + j] = uu[0][j]; }
    }
    uint4 vv = *(const uint4*)(P + (size_t)m * PS + 2784 + c0);
    const u16* vs = (const u16*)&vv;
#pragma unroll
    for (int j = 0; j < 8; ++j) vb[(c0 + j) * 72 + tok] = vs[j];
  }
  {
    int tok = tid >> 3, sub = tid & 7;
    int m = m0 + tok;
    const u16* pr = P + (size_t)m * PS;
    {
      float v[24];
#pragma unroll
      for (int q = 0; q < 3; ++q) ld8(pr + 1920 + 24 * sub + 8 * q, *(float(*)[8])&v[8 * q]);
      float ss = 0.f;
#pragma unroll
      for (int j = 0; j < 24; ++j) ss += v[j] * v[j];
      ss = grp8_sum(ss);
      float rs = rsqrtf(ss * (1.f / 192.f) + 1e-6f);
      const float* g = p->in[32] + l * 192 + 24 * sub;
#pragma unroll
      for (int q = 0; q < 3; ++q) {
        float o[8];
#pragma unroll
        for (int j = 0; j < 8; ++j) o[j] = v[8 * q + j] * rs * g[8 * q + j];
        st8(CQN + (size_t)m * 192 + 24 * sub + 8 * q, o);
      }
    }
    {
      float v[16];
#pragma unroll
      for (int q = 0; q < 2; ++q) ld8(pr + 2112 + 16 * sub + 8 * q, *(float(*)[8])&v[8 * q]);
      float ss = 0.f;
#pragma unroll
      for (int j = 0; j < 16; ++j) ss += v[j] * v[j];
      ss = grp8_sum(ss);
      float rs = rsqrtf(ss * (1.f / 128.f) + 1e-6f);
      const float* g = p->in[34] + l * 128 + 16 * sub;
#pragma unroll
      for (int q = 0; q < 2; ++q) {
        float o[8];
#pragma unroll
        for (int j = 0; j < 8; ++j) o[j] = v[8 * q + j] * rs * g[8 * q + j];
        st8(CKVN + (size_t)m * 128 + 16 * sub + 8 * q, o);
      }
    }
  }
  if (tid < 64) {
    int tok = tid, m = m0 + tok, t = t0 + tok;
    float x[32];
    ld32(P + (size_t)m * PS + 2240, x);
    if (lat) rope32(x, t >> 6, t & 63);
#pragma unroll
    for (int hh = 0; hh < 4; ++hh) st32(KM + ((size_t)(b * 4 + hh) * TK + key0 + tok) * 96 + 64, x);
  }
  {
    int tok = tid >> 3, h8 = tid & 7;
    int m = m0 + tok, t = t0 + tok;
    float x[32];
    ld32(P + (size_t)m * PS + 2272 + 32 * h8, x);
    if (lat) rope32(x, t >> 6, t & 63);
    const float sc = 0.17677669529663687f * 1.4426950408889634f;
#pragma unroll
    for (int j = 0; j < 32; ++j) x[j] *= sc;
    st32(QD + ((size_t)(b * 8 + h8) * TK + key0 + tok) * 32, x);
    ld32(P + (size_t)m * PS + 2528 + 32 * h8, x);
    if (lat) rope32(x, t >> 6, t & 63);
    st32(KD + ((size_t)(b * 8 + h8) * TK + key0 + tok) * 32, x);
  }
  __syncthreads();
#pragma unroll 1
  for (int e = 0; e < 4; ++e) {
    int id = tid + NT * e;
    int ch = id >> 3, tc8 = id & 7;
    if (lat) {
      *(uint4*)(ZT + ((size_t)ch * 2 + b) * 16384 + t0 + 8 * tc8) = *(const uint4*)(zb + ch * 72 + 8 * tc8);
      *(uint4*)(X0T + ((size_t)ch * 2 + b) * 16384 + t0 + 8 * tc8) = *(const uint4*)(xb + ch * 72 + 8 * tc8);
    }
    *(uint4*)(VDT + ((size_t)b * 256 + ch) * TK + key0 + 8 * tc8) = *(const uint4*)(vb + ch * 72 + 8 * tc8);
  }
  __syncthreads();
}

DI void ph_t2b(CP p, char* smem) {
  const u16* LIN = (const u16*)(p->ws + S_LIN);
  u16* LOUT = (u16*)(p->ws + S_LOUT);
  for (int t = blockIdx.x; t < 130 * 17; t += gridDim.x) {
    int m0 = (t / 17) * 256, j = t % 17;
    if (j < 10) {
      int g = j >> 1, n0 = (j & 1) * 128;
      const u16* A; const u16* BT; int K;
      if (g == 0) { A = LIN; BT = (const u16*)(p->ws + O_W2); K = 64; }
      else if (g == 1) { A = LIN + 64; BT = (const u16*)(p->ws + O_A2); K = 64; }
      else if (g == 2) { A = LIN + 128; BT = (const u16*)(p->ws + O_W2) + 256 * 64; K = 64; }
      else if (g == 3) { A = LIN + 192; BT = (const u16*)(p->ws + O_A2) + 256 * 64; K = 64; }
      else { A = LIN + 256; BT = (const u16*)(p->ws + O_G2); K = 128; }
      gemm_bf16_tile<256, 2>(A, 384, BT, K, LOUT + g * 256, 1280, m0, n0, smem);
    } else if (j < 13) {
      gemm_bf16_tile<256, 2>((const u16*)(p->ws + S_CQN), 192, (const u16*)(p->ws + O_WQB), 192, (u16*)(p->ws + S_QRAW), 384, m0, (j - 10) * 128, smem);
    } else {
      gemm_bf16_tile<256, 2>((const u16*)(p->ws + S_CKVN), 128, (const u16*)(p->ws + O_WKVB), 128, (u16*)(p->ws + S_KVRAW), 512, m0, (j - 13) * 128, smem);
    }
  }
}

DI void t2c_tile(CP p, int l, int tl, char* smem) {
  const int tid = tidx();
  const int m0 = tl * 64;
  const bool lat = m0 < ML;
  int b, t0;
  if (lat) { b = m0 >> 14; t0 = m0 & 16383; } else { int mc = m0 - ML; b = mc >> 8; t0 = mc & 255; }
  const int key0 = lat ? t0 : 16384 + t0;
  const u16* QRAW = (const u16*)(p->ws + S_QRAW);
  const u16* KVRAW = (const u16*)(p->ws + S_KVRAW);
  u16* QM = (u16*)(p->ws + S_QM); u16* KM = (u16*)(p->ws + S_KM); u16* VMT = (u16*)(p->ws + S_VMT);
  u16* vb = (u16*)smem;
  if (tid < 256) {
    int tok = tid >> 2, hh = tid & 3;
    int m = m0 + tok, t = t0 + tok;
    const u16* src = QRAW + (size_t)m * 384 + 96 * hh;
    u16* dst = QM + ((size_t)(b * 4 + hh) * TK + key0 + tok) * 96;
    const float sc = 0.10206207261596577f * 1.4426950408889634f;
#pragma unroll
    for (int q = 0; q < 8; ++q) {
      float v[8];
      ld8(src + 8 * q, v);
#pragma unroll
      for (int j = 0; j < 8; ++j) v[j] *= sc;
      st8(dst + 8 * q, v);
    }
    float x[32];
    ld32(src + 64, x);
    if (lat) rope32(x, t >> 6, t & 63);
#pragma unroll
    for (int j = 0; j < 32; ++j) x[j] *= sc;
    st32(dst + 64, x);
  }
  {
    int tok = tid >> 3, hh = (tid >> 1) & 3, part = tid & 1;
    int m = m0 + tok;
    const u16* src = KVRAW + (size_t)m * 512 + 128 * hh + 64 * part;
    if (part == 0) {
      u16* dst = KM + ((size_t)(b * 4 + hh) * TK + key0 + tok) * 96;
#pragma unroll
      for (int q = 0; q < 8; ++q) *(uint4*)(dst + 8 * q) = *(const uint4*)(src + 8 * q);
    } else {
#pragma unroll
      for (int q = 0; q < 8; ++q) {
        uint4 vv = *(const uint4*)(src + 8 * q);
        const u16* vs = (const u16*)&vv;
#pragma unroll
        for (int j = 0; j < 8; ++j) vb[(64 * hh + 8 * q + j) * 72 + tok] = vs[j];
      }
    }
  }
  {
    u16* LOUT = (u16*)(p->ws + S_LOUT);
#pragma unroll 1
    for (int e = 0; e < 16; ++e) {
      int it = tid + NT * e;
      int tok = it >> 7, cg = it & 127;
      int sec = cg >> 5, c0 = (cg & 31) * 8;
      u16* ptr = LOUT + (size_t)(m0 + tok) * 1280 + sec * 256 + c0;
      float v[8], c8[8];
      ld8(ptr, v);
      if ((sec & 1) == 0) {
        ld8f(p->in[12] + (l * 2 + (sec >> 1)) * 256 + c0, c8);
#pragma unroll
        for (int j = 0; j < 8; ++j) {
          float y = -(c8[j] + v[j]);
          float sp = fmaxf(y, 0.f) + __logf(1.f + __expf(-fabsf(y)));
          v[j] = __expf(-sp - 0.5f);
        }
      } else {
        ld8f(p->in[14] + (l * 2 + (sec >> 1)) * 256 + c0, c8);
#pragma unroll
        for (int j = 0; j < 8; ++j) v[j] = sigmoidf_(c8[j] + v[j]);
      }
      st8(ptr, v);
    }
  }
  __syncthreads();
#pragma unroll 1
  for (int e = 0; e < 4; ++e) {
    int id = tid + NT * e;
    int ch = id >> 3, tc8 = id & 7;
    *(uint4*)(VMT + ((size_t)b * 256 + ch) * TK + key0 + 8 * tc8) = *(const uint4*)(vb + ch * 72 + 8 * tc8);
  }
  __syncthreads();
}

template <int DQK>
DI void attn_pass(const u16* __restrict__ Qp, const u16* __restrict__ Kp, const u16* __restrict__ VTp, int kt0, int nkt,
                  char* lds, f32x16 (&o)[2], float& lsum) {
  constexpr int KS = DQK / 16;
  constexpr int KROW = DQK * 2 + 16;
  constexpr int KCH = DQK / 8;
  constexpr int NKC = 64 * KCH;
  constexpr int STG = 64 * KROW + 64 * 144;
  const int tid = tidx(), lane = tid & 63, wave = tid >> 6, r = lane & 31, h = lane >> 5;
  bf16x8 qf[KS];
#pragma unroll
  for (int s = 0; s < KS; ++s) qf[s] = *(const bf16x8*)(Qp + (size_t)(32 * wave + r) * DQK + 16 * s + 8 * h);
#pragma unroll
  for (int dt = 0; dt < 2; ++dt)
#pragma unroll
    for (int i = 0; i < 16; ++i) o[dt][i] = 0.f;
  float base = 0.f, base_next = 0.f, alpha_p = 1.f;
  f32x16 nb16;
#pragma unroll
  for (int i = 0; i < 16; ++i) nb16[i] = 0.f;
  f2v ls2 = {0.f, 0.f};
  const int kq0 = tid, kq1 = tid + NT;
  const bool has1 = kq1 < NKC, has0 = kq0 < NKC;
  const int kr0 = kq0 / KCH, kc0 = kq0 % KCH, kr1 = kq1 / KCH, kc1 = kq1 % KCH;
  const int vr = tid >> 3, vc = tid & 7;
  const int so0 = kr0 * KROW + kc0 * 16, so1 = kr1 * KROW + kc1 * 16, sov = 64 * KROW + vr * 144 + (vc >> 1) * 32 + (vc & 1) * 8;
  const u16* kp0 = Kp + (size_t)kr0 * DQK + kc0 * 8;
  const u16* kp1 = Kp + (size_t)kr1 * DQK + kc1 * 8;
  const u16* vp0 = VTp + (size_t)vr * TK + vc * 8;
  uint4 rk0 = make_uint4(0, 0, 0, 0), rk1 = make_uint4(0, 0, 0, 0), rv;
  uint4 rk0b = make_uint4(0, 0, 0, 0), rk1b = make_uint4(0, 0, 0, 0), rvb = make_uint4(0, 0, 0, 0);
#define ATT_LOAD_X(tile_, A0, A1, AV)                                             \
  {                                                                               \
    const int key0__ = (tile_) * 64;                                              \
    if (has0) A0 = *(const uint4*)(kp0 + (size_t)key0__ * DQK);                   \
    if (has1) A1 = *(const uint4*)(kp1 + (size_t)key0__ * DQK);                   \
    AV = *(const uint4*)(vp0 + key0__);                                           \
  }
#define ATT_STORE_X(stg_, A0, A1, AV)                                             \
  {                                                                               \
    char* sn__ = lds + (stg_) * STG;                                              \
    if (has0) *(uint4*)(sn__ + so0) = A0;                                         \
    if (has1) *(uint4*)(sn__ + so1) = A1;                                         \
    *(uint2*)(sn__ + sov) = make_uint2(AV.x, AV.y);                               \
    *(uint2*)(sn__ + sov + 16) = make_uint2(AV.z, AV.w);                          \
  }
#define ATT_LOAD(tile_) ATT_LOAD_X(tile_, rk0, rk1, rv)
#define ATT_STORE(stg_) ATT_STORE_X(stg_, rk0, rk1, rv)
#define ATT_LOAD_B(tile_) ATT_LOAD_X(tile_, rk0b, rk1b, rvb)
#define ATT_STORE_B(stg_) ATT_STORE_X(stg_, rk0b, rk1b, rvb)
#define ATT_QK(dst_, stg_)                                                        \
  {                                                                               \
    const char* sK__ = lds + (stg_) * STG;                                        \
    _Pragma("unroll") for (int mt = 0; mt < 2; ++mt) {                            \
      _Pragma("unroll") for (int s = 0; s < KS; ++s) {                            \
        bf16x8 a__ = *(const bf16x8*)(sK__ + (32 * mt + r) * KROW + 32 * s + 16 * h); \
        if (s == 0) dst_[mt] = MFMA32(a__, qf[s], nb16);                          \
        else dst_[mt] = MFMA32(a__, qf[s], dst_[mt]);                             \
      }                                                                           \
    }                                                                             \
  }
#define ATT_SOFTMAX_PV(sacc, stg_, J_)                                            \
  {                                                                               \
    const char* sV__ = lds + (stg_) * STG + 64 * KROW;                            \
    if ((J_) == 2) {                                                              \
      const f2v al2 = {alpha_p, alpha_p};                                         \
      ls2 = ls2 * al2;                                                            \
      _Pragma("unroll") for (int dt = 0; dt < 2; ++dt)                            \
        _Pragma("unroll") for (int i = 0; i < 16; ++i) o[dt][i] *= alpha_p;       \
    }                                                                             \
    if ((J_) == 0) {                                                              \
      float mloc = sacc[0][0];                                                    \
      _Pragma("unroll") for (int i = 1; i < 16; ++i) mloc = fmaxf(mloc, sacc[0][i]); \
      _Pragma("unroll") for (int i = 0; i < 16; ++i) mloc = fmaxf(mloc, sacc[1][i]); \
      mloc = fmaxf(mloc, __shfl_xor(mloc, 32));                                   \
      const float dlt = fmaxf(mloc, 0.f);                                         \
      alpha_p = __builtin_amdgcn_exp2f(-dlt);                                     \
      base_next = base + dlt;                                                     \
    }                                                                             \
    _Pragma("unroll") for (int mt = 0; mt < 2; ++mt)                              \
      _Pragma("unroll") for (int i = 0; i < 16; i += 2) {                         \
        f2v e = {__builtin_amdgcn_exp2f(sacc[mt][i]), __builtin_amdgcn_exp2f(sacc[mt][i + 1])}; \
        sacc[mt][i] = e.x; sacc[mt][i + 1] = e.y;                                 \
        ls2 += e;                                                                 \
      }                                                                           \
    _Pragma("unroll") for (int mt = 0; mt < 2; ++mt)                              \
      _Pragma("unroll") for (int s2 = 0; s2 < 2; ++s2) {                          \
        uint4 pw;                                                                 \
        pw.x = pk2(sacc[mt][8 * s2 + 0], sacc[mt][8 * s2 + 1]);                   \
        pw.y = pk2(sacc[mt][8 * s2 + 2], sacc[mt][8 * s2 + 3]);                   \
        pw.z = pk2(sacc[mt][8 * s2 + 4], sacc[mt][8 * s2 + 5]);                   \
        pw.w = pk2(sacc[mt][8 * s2 + 6], sacc[mt][8 * s2 + 7]);                   \
        bf16x8 pb = __builtin_bit_cast(bf16x8, pw);                               \
        _Pragma("unroll") for (int dt = 0; dt < 2; ++dt) {                        \
          const char* vp = sV__ + (32 * dt + r) * 144 + (2 * mt + s2) * 32 + 16 * h; \
          bf16x8 va = *(const bf16x8*)vp;                                         \
          o[dt] = MFMA32(va, pb, o[dt]);                                          \
        }                                                                         \
      }                                                                           \
    if ((J_) == 0) {                                                              \
      base = base_next;                                                           \
      _Pragma("unroll") for (int i = 0; i < 16; ++i) nb16[i] = -base_next;        \
    }                                                                             \
  }
  __syncthreads();
  ATT_LOAD(kt0)
  ATT_STORE(0)
  ATT_LOAD(kt0 + 1)
  ATT_STORE(1)
  __syncthreads();
  f32x16 sc[2], sn[2];
  int st_cur = 0, st_nxt = 1, st_sto = 2;
  const int lastt = nkt - 1;
  ATT_QK(sc, 0)
#pragma unroll 1
  for (int t = 0; t < nkt; t += 2) {
    const int jph = t & 3;
    { const int tl = (t + 2 < lastt) ? t + 2 : lastt; ATT_LOAD(kt0 + tl) }
    ATT_QK(sn, st_nxt)
    ATT_SOFTMAX_PV(sc, st_cur, jph)
    ATT_STORE(st_sto)
    __syncthreads();
    { const int tl = (t + 3 < lastt) ? t + 3 : lastt; ATT_LOAD(kt0 + tl) }
    ATT_QK(sc, st_sto)
    ATT_SOFTMAX_PV(sn, st_nxt, 1)
    ATT_STORE(st_cur)
    __syncthreads();
    const int tmp__ = st_cur; st_cur = st_sto; st_sto = st_nxt; st_nxt = tmp__;
  }
  lsum = ls2.x + ls2.y;
  lsum += __shfl_xor(lsum, 32);
#undef ATT_LOAD
#undef ATT_LOAD_B
#undef ATT_STORE_B
#undef ATT_LOAD_X
#undef ATT_STORE_X
#undef ATT_STORE
#undef ATT_QK
#undef ATT_SOFTMAX_PV
}

template <int DQK>
DI void attn_pass2(const u16* __restrict__ Qp, const u16* __restrict__ Kp, const u16* __restrict__ VTp, int kt0, int nkt, int nq,
                   char* lds, f32x16 (&o)[2][2], float (&lsum)[2]) {
  constexpr int KS = DQK / 16;
  constexpr int KROW = DQK * 2 + 16;
  constexpr int KCH = DQK / 8;
  constexpr int NKC = 64 * KCH;
  constexpr int STG = 64 * KROW + 64 * 144;
  const int tid = tidx(), lane = tid & 63, wave = tid >> 6, r = lane & 31, h = lane >> 5;
  const bool act = wave * 64 < nq;
  bf16x8 qf[2][KS];
#pragma unroll
  for (int u = 0; u < 2; ++u)
#pragma unroll
    for (int s = 0; s < KS; ++s) qf[u][s] = *(const bf16x8*)(Qp + (size_t)(act ? (64 * wave + 32 * u + r) : r) * DQK + 16 * s + 8 * h);
#pragma unroll
  for (int u = 0; u < 2; ++u)
#pragma unroll
    for (int dt = 0; dt < 2; ++dt)
#pragma unroll
      for (int i = 0; i < 16; ++i) o[u][dt][i] = 0.f;
  float base[2] = {0.f, 0.f};
  f2v ls2[2] = {{0.f, 0.f}, {0.f, 0.f}};
  const int kq0 = tid, kq1 = tid + NT;
  const bool has1 = (NKC > NT) && (kq1 < NKC), has0 = (NKC >= NT) || (kq0 < NKC);
  const int kr0 = kq0 / KCH, kc0 = kq0 % KCH, kr1 = kq1 / KCH, kc1 = kq1 % KCH;
  const int vr = tid >> 3, vc = tid & 7;
  const int so0 = kr0 * KROW + kc0 * 16, so1 = kr1 * KROW + kc1 * 16, sov = 64 * KROW + vr * 144 + (vc >> 1) * 32 + (vc & 1) * 8;
  const u16* kp0 = Kp + (size_t)kr0 * DQK + kc0 * 8;
  const u16* kp1 = Kp + (size_t)kr1 * DQK + kc1 * 8;
  const u16* vp0 = VTp + (size_t)vr * TK + vc * 8;
  uint4 rk0 = make_uint4(0, 0, 0, 0), rk1 = make_uint4(0, 0, 0, 0), rv;
#define A2_LOAD(tile_) { const int key0__ = (tile_) * 64; if (has0) rk0 = *(const uint4*)(kp0 + (size_t)key0__ * DQK); \
    if (has1) rk1 = *(const uint4*)(kp1 + (size_t)key0__ * DQK); rv = *(const uint4*)(vp0 + key0__); }
#define A2_STORE(stg_) { char* sn__ = lds + (stg_) * STG; if (has0) *(uint4*)(sn__ + so0) = rk0; if (has1) *(uint4*)(sn__ + so1) = rk1; \
    *(uint2*)(sn__ + sov) = make_uint2(rv.x, rv.y); *(uint2*)(sn__ + sov + 16) = make_uint2(rv.z, rv.w); }
  __syncthreads();
  A2_LOAD(kt0)
  A2_STORE(0)
  A2_LOAD(kt0 + 1)
  A2_STORE(1)
  __syncthreads();
  int st_cur = 0, st_nxt = 1, st_sto = 2;
  const int lastt = nkt - 1;
#pragma unroll 1
  for (int t = 0; t < nkt; ++t) {
    { const int tl = (t + 2 < lastt) ? t + 2 : lastt; A2_LOAD(kt0 + tl) }
    if (act) {
      const char* sK = lds + st_cur * STG;
      const char* sV = sK + 64 * KROW;
      f32x16 sc[2][2];
#pragma unroll
      for (int mt = 0; mt < 2; ++mt)
#pragma unroll
        for (int s = 0; s < KS; ++s) {
          const bf16x8 a = *(const bf16x8*)(sK + (32 * mt + r) * KROW + 32 * s + 16 * h);
#pragma unroll
          for (int u = 0; u < 2; ++u) {
            if (s == 0) { const f32x16 z = {0.f,0.f,0.f,0.f,0.f,0.f,0.f,0.f,0.f,0.f,0.f,0.f,0.f,0.f,0.f,0.f}; sc[u][mt] = MFMA32(a, qf[u][s], z); }
            else sc[u][mt] = MFMA32(a, qf[u][s], sc[u][mt]);
          }
        }
      bf16x8 pb[2][2][2];
      if ((t & 3) == 0) {
#pragma unroll
        for (int u = 0; u < 2; ++u) {
          float mloc = sc[u][0][0];
#pragma unroll
          for (int i = 1; i < 16; ++i) mloc = fmaxf(mloc, sc[u][0][i]);
#pragma unroll
          for (int i = 0; i < 16; ++i) mloc = fmaxf(mloc, sc[u][1][i]);
          mloc = fmaxf(mloc, __shfl_xor(mloc, 32));
          const float dlt = fmaxf(mloc - base[u] - 32.f, 0.f);
          if (__builtin_amdgcn_ballot_w64(dlt > 32.f) != 0ull) {
            const float al = __builtin_amdgcn_exp2f(-dlt);
            const f2v al2 = {al, al};
            ls2[u] = ls2[u] * al2;
#pragma unroll
            for (int dt = 0; dt < 2; ++dt)
#pragma unroll
              for (int i = 0; i < 16; ++i) o[u][dt][i] *= al;
            base[u] += dlt;
          }
        }
      }
      if (__builtin_amdgcn_ballot_w64(base[0] != 0.f || base[1] != 0.f) != 0ull) {
#pragma unroll
        for (int u = 0; u < 2; ++u)
#pragma unroll
          for (int mt = 0; mt < 2; ++mt)
#pragma unroll
            for (int i = 0; i < 16; ++i) sc[u][mt][i] -= base[u];
      }
#pragma unroll
      for (int u = 0; u < 2; ++u) {
#pragma unroll
        for (int mt = 0; mt < 2; ++mt)
#pragma unroll
          for (int i = 0; i < 16; i += 2) {
            f2v e = {__builtin_amdgcn_exp2f(sc[u][mt][i]), __builtin_amdgcn_exp2f(sc[u][mt][i + 1])};
            sc[u][mt][i] = e.x; sc[u][mt][i + 1] = e.y;
            ls2[u] += e;
          }
#pragma unroll
        for (int mt = 0; mt < 2; ++mt)
#pragma unroll
          for (int s2 = 0; s2 < 2; ++s2) {
            uint4 pw;
            pw.x = pk2(sc[u][mt][8 * s2 + 0], sc[u][mt][8 * s2 + 1]);
            pw.y = pk2(sc[u][mt][8 * s2 + 2], sc[u][mt][8 * s2 + 3]);
            pw.z = pk2(sc[u][mt][8 * s2 + 4], sc[u][mt][8 * s2 + 5]);
            pw.w = pk2(sc[u][mt][8 * s2 + 6], sc[u][mt][8 * s2 + 7]);
            pb[u][mt][s2] = __builtin_bit_cast(bf16x8, pw);
          }
      }
#pragma unroll
      for (int mt = 0; mt < 2; ++mt)
#pragma unroll
        for (int s2 = 0; s2 < 2; ++s2)
#pragma unroll
          for (int dt = 0; dt < 2; ++dt) {
            const bf16x8 va = *(const bf16x8*)(sV + (32 * dt + r) * 144 + (2 * mt + s2) * 32 + 16 * h);
            o[0][dt] = MFMA32(va, pb[0][mt][s2], o[0][dt]);
            o[1][dt] = MFMA32(va, pb[1][mt][s2], o[1][dt]);
          }
    }
    A2_STORE(st_sto)
    __syncthreads();
    const int tmp = st_cur; st_cur = st_nxt; st_nxt = st_sto; st_sto = tmp;
  }
#undef A2_LOAD
#undef A2_STORE
#pragma unroll
  for (int u = 0; u < 2; ++u) {
    float l = ls2[u].x + ls2[u].y;
    l += __shfl_xor(l, 32);
    lsum[u] = l;
  }
}

DI void mla_item(CP p, int b, int hh, int qt, char* smem) {
  const u16* QM = (const u16*)(p->ws + S_QM);
  const u16* KM = (const u16*)(p->ws + S_KM);
  const u16* VMT = (const u16*)(p->ws + S_VMT);
  u16* OALL = (u16*)(p->ws + S_OALL);
  const bool ctx = qt == 32;
  const int q0 = ctx ? 16384 : qt * 512;
  const int nq = ctx ? 256 : 512;
  const size_t hb = (size_t)(b * 4 + hh);
  f32x16 o[2][2]; float l[2];
  attn_pass2<96>(QM + (hb * TK + q0) * 96, KM + hb * TK * 96, VMT + hb * 64 * TK, ctx ? 256 : 0, ctx ? 4 : 260, nq, smem, o, l);
  const int lane = tidx() & 63, wave = tidx() >> 6, r = lane & 31, h = lane >> 5;
  if (wave * 64 < nq) {
#pragma unroll
    for (int u = 0; u < 2; ++u) {
      const int q = 64 * wave + 32 * u + r;
      const int m = ctx ? (ML + b * 256 + q) : (b * 16384 + q0 + q);
      const float il = 1.f / l[u];
#pragma unroll
      for (int dt = 0; dt < 2; ++dt)
#pragma unroll
        for (int g = 0; g < 4; ++g) {
          uint2 w;
          w.x = pk2(o[u][dt][4 * g] * il, o[u][dt][4 * g + 1] * il);
          w.y = pk2(o[u][dt][4 * g + 2] * il, o[u][dt][4 * g + 3] * il);
          *(uint2*)(OALL + (size_t)m * 1024 + 512 + 64 * hh + 32 * dt + 8 * g + 4 * h) = w;
        }
    }
  }
}
DI void diff_item(CP p, int l_, int b, int hd, int qt, char* smem) {
  const u16* QD = (const u16*)(p->ws + O_QD);
  const u16* KD = (const u16*)(p->ws + O_KD);
  const u16* VDT = (const u16*)(p->ws + O_VDT);
  u16* OALL = (u16*)(p->ws + S_OALL);
  const bool ctx = qt == 32;
  const int q0 = ctx ? 16384 : qt * 512;
  const int nq = ctx ? 256 : 512;
  const int kt0 = ctx ? 256 : 0, nkt = ctx ? 4 : 260;
  const u16* VT = VDT + (size_t)(b * 4 + hd) * 64 * TK;
  const int lane = tidx() & 63, wave = tidx() >> 6, r = lane & 31, h = lane >> 5;
  const bool act = wave * 64 < nq;
  {
    f32x16 o1[2][2]; float l1[2];
    const size_t hb = (size_t)(b * 8 + 2 * hd);
    attn_pass2<32>(QD + (hb * TK + q0) * 32, KD + hb * TK * 32, VT, kt0, nkt, nq, smem, o1, l1);
    if (act) {
#pragma unroll
      for (int u = 0; u < 2; ++u) {
        const float i1 = 1.f / l1[u];
        const int q = 64 * wave + 32 * u + r;
        const int m = ctx ? (ML + b * 256 + q) : (b * 16384 + q0 + q);
#pragma unroll
        for (int dt = 0; dt < 2; ++dt)
#pragma unroll
          for (int g = 0; g < 4; ++g) {
            uint2 w;
            w.x = pk2(o1[u][dt][4 * g] * i1, o1[u][dt][4 * g + 1] * i1);
            w.y = pk2(o1[u][dt][4 * g + 2] * i1, o1[u][dt][4 * g + 3] * i1);
            *(uint2*)(OALL + (size_t)m * 1024 + 768 + 64 * hd + 32 * dt + 8 * g + 4 * h) = w;
          }
      }
    }
  }
  f32x16 o2[2][2]; float l2[2];
  {
    const size_t hb = (size_t)(b * 8 + 2 * hd + 1);
    attn_pass2<32>(QD + (hb * TK + q0) * 32, KD + hb * TK * 32, VT, kt0, nkt, nq, smem, o2, l2);
  }
  float s1 = 0.f, s2 = 0.f;
  for (int j = 0; j < 32; ++j) {
    s1 += p->in[36][l_ * 32 + j] * p->in[37][l_ * 32 + j];
    s2 += p->in[38][l_ * 32 + j] * p->in[39][l_ * 32 + j];
  }
  const float li = lam_init_of(l_);
  const float lam = expf(s1) - expf(s2) + li;
  const float* sub = p->in[40] + l_ * 64;
  if (act) {
#pragma unroll
    for (int u = 0; u < 2; ++u) {
      const float i2 = lam / l2[u];
      const int q = 64 * wave + 32 * u + r;
      const int m = ctx ? (ML + b * 256 + q) : (b * 16384 + q0 + q);
      u16* dst = OALL + (size_t)m * 1024 + 768 + 64 * hd + 4 * h;
      float ss = 0.f;
#pragma unroll
      for (int dt = 0; dt < 2; ++dt)
#pragma unroll
        for (int g = 0; g < 4; ++g) {
          const uint2 pw = *(const uint2*)(dst + 32 * dt + 8 * g);
          const float a0 = __uint_as_float(pw.x << 16), a1 = __uint_as_float(pw.x & 0xffff0000u);
          const float a2 = __uint_as_float(pw.y << 16), a3 = __uint_as_float(pw.y & 0xffff0000u);
          const float v0 = a0 - o2[u][dt][4 * g] * i2, v1 = a1 - o2[u][dt][4 * g + 1] * i2;
          const float v2 = a2 - o2[u][dt][4 * g + 2] * i2, v3 = a3 - o2[u][dt][4 * g + 3] * i2;
          o2[u][dt][4 * g] = v0; o2[u][dt][4 * g + 1] = v1; o2[u][dt][4 * g + 2] = v2; o2[u][dt][4 * g + 3] = v3;
          ss += v0 * v0 + v1 * v1 + v2 * v2 + v3 * v3;
        }
      ss += __shfl_xor(ss, 32);
      const float rs = rsqrtf(ss * (1.f / 64.f) + 1e-5f) * (1.f - li);
#pragma unroll
      for (int dt = 0; dt < 2; ++dt)
#pragma unroll
        for (int g = 0; g < 4; ++g) {
          const int dv = 32 * dt + 8 * g + 4 * h;
          const float4 sg = *(const float4*)(sub + dv);
          uint2 w;
          w.x = pk2(o2[u][dt][4 * g] * rs * sg.x, o2[u][dt][4 * g + 1] * rs * sg.y);
          w.y = pk2(o2[u][dt][4 * g + 2] * rs * sg.z, o2[u][dt][4 * g + 3] * rs * sg.w);
          *(uint2*)(dst + 32 * dt + 8 * g) = w;
        }
    }
  }
}

DI void hyena_item(CP p, int l, int c, char* smem) {
  const int tid = tidx(), lane = tid & 63, wave = tid >> 6, r = lane & 31, h = lane >> 5;
  u16* zl = (u16*)smem;
  char* cp = smem + 2 * 128 * 136 * 2;
  float* red = (float*)(cp + 2 * 2 * 8 * 544);
  const u16* ZT = (const u16*)(p->ws + O_ZT) + (size_t)c * 2 * 16384;
  const u16* X0T = (const u16*)(p->ws + S_X0T) + (size_t)c * 2 * 16384;
  u16* OHT = (u16*)(p->ws + S_OHT) + (size_t)c * 2 * 16384;
  const u16* rkg = (const u16*)(p->ws + O_RKG) + (size_t)c * RKROW;
  __syncthreads();
#pragma unroll
  for (int e = 0; e < 8; ++e) {
    int q = tid + NT * e;
    int bb = q >> 11, t8 = (q & 2047) * 8;
    *(uint4*)(zl + (bb * 128 + (t8 >> 7)) * 136 + (t8 & 127)) = *(const uint4*)(ZT + (size_t)bb * 16384 + t8);
  }
  {
    const float* part = (const float*)(p->ws + O_HPART);
    float v = part[(tid >> 1) * 512 + (tid & 1) * 256 + c];
    v = wave_sum(v);
    if (lane == 0) red[wave] = v;
  }
  const int cwin = tid >> 8, co = (tid >> 5) & 7, cq = tid & 31;
  uint4 cr;
  {
    const int bx = -128 + cwin * 16384;
    __builtin_memcpy(&cr, rkg + OFFC + bx + co + 8 * cq, 16);
  }
  *(uint4*)(cp + ((0 * 2 + cwin) * 8 + co) * 544 + 16 * cq) = cr;
  __syncthreads();
  float rn = 0.f;
#pragma unroll
  for (int q = 0; q < 8; ++q) rn += red[q];
  rn = rsqrtf(rn);
  const int mt = wave & 3, bb = wave >> 2;
  const int i_ = 32 * mt + r;
  const int o_ = (-i_) & 7;
  f32x16 acc[4];
#pragma unroll
  for (int at = 0; at < 4; ++at)
#pragma unroll
    for (int i = 0; i < 16; ++i) acc[at][i] = 0.f;
  const bf16x8 zero8 = {0, 0, 0, 0, 0, 0, 0, 0};
  uint4 cr2 = make_uint4(0, 0, 0, 0);
  {
    const int bx = -128 * 1 - 128 + cwin * 16384;
    __builtin_memcpy(&cr, rkg + OFFC + bx + co + 8 * cq, 16);
  }
#define HY_LOADC(dst_, dn_) { const int bx__ = -128 * (dn_) - 128 + cwin * 16384; __builtin_memcpy(&dst_, rkg + OFFC + bx__ + co + 8 * cq, 16); }
#define HY_STOREC(src_, dn_) { *(uint4*)(cp + ((((dn_) & 1) * 2 + cwin) * 8 + co) * 544 + 16 * cq) = src_; }
#define HY_COMPUTE(K_, dl_)                                                                    \
  {                                                                                            \
    const char* chi = cp + ((((dl_) & 1) * 2 + 0) * 8 + o_) * 544;                             \
    const char* clo = cp + ((((dl_) & 1) * 2 + 1) * 8 + o_) * 544;                             \
    _Pragma("unroll") for (int s = 0; s < 8; ++s) {                                            \
      const int j = 16 * s + 8 * h;                                                            \
      const int q = (j - i_ + 128 - o_) >> 3;                                                  \
      bf16x8 ahi = *(const bf16x8*)(chi + 16 * q);                                             \
      bf16x8 alo = *(const bf16x8*)(clo + 16 * q);                                             \
      _Pragma("unroll") for (int at = 0; at < 4; ++at) {                                       \
        const int a = 32 * at + r;                                                             \
        const int ap = (a - (dl_)) & 127;                                                      \
        bf16x8 bf = *(const bf16x8*)(zl + (bb * 128 + ap) * 136 + j);                          \
        if (at > (K_)) acc[at] = MFMA32(ahi, bf, acc[at]);                                     \
        else if (at < (K_)) acc[at] = MFMA32(alo, bf, acc[at]);                                \
        else {                                                                                 \
          bf16x8 b1 = (a >= (dl_)) ? bf : zero8;                                               \
          bf16x8 b2 = (a >= (dl_)) ? zero8 : bf;                                               \
          acc[at] = MFMA32(ahi, b1, acc[at]);                                                  \
          acc[at] = MFMA32(alo, b2, acc[at]);                                                  \
        }                                                                                      \
      }                                                                                        \
    }                                                                                          \
  }
#define HY_SEGMENT(K_)                                                                         \
  _Pragma("unroll 1") for (int dl0 = 32 * (K_); dl0 < 32 * (K_) + 32; dl0 += 2) {              \
    {                                                                                          \
      const int dl = dl0;                                                                      \
      if (dl + 2 < 128) HY_LOADC(cr2, dl + 2)                                                  \
      HY_COMPUTE(K_, dl)                                                                       \
      HY_STOREC(cr, dl + 1)                                                                    \
      __syncthreads();                                                                         \
    }                                                                                          \
    {                                                                                          \
      const int dl = dl0 + 1;                                                                  \
      if (dl + 2 < 128) HY_LOADC(cr, dl + 2)                                                   \
      HY_COMPUTE(K_, dl)                                                                       \
      if (dl + 1 < 128) HY_STOREC(cr2, dl + 1)                                                 \
      __syncthreads();                                                                         \
    }                                                                                          \
  }
  HY_SEGMENT(0)
  HY_SEGMENT(1)
  HY_SEGMENT(2)
  HY_SEGMENT(3)
#undef HY_SEGMENT
#undef HY_COMPUTE
#undef HY_LOADC
#undef HY_STOREC
  const float bias = p->in[31][l * 256 + c];
#pragma unroll
  for (int at = 0; at < 4; ++at) {
    const int a = 32 * at + r;
#pragma unroll
    for (int g = 0; g < 4; ++g) {
      const int il = 32 * mt + 8 * g + 4 * h;
      const int t = 128 * a + il;
      uint2 zz = *(const uint2*)(zl + (bb * 128 + a) * 136 + il);
      uint2 xx = *(const uint2*)(X0T + (size_t)bb * 16384 + t);
      float z0 = __uint_as_float(zz.x << 16), z1 = __uint_as_float(zz.x & 0xffff0000u);
      float z2 = __uint_as_float(zz.y << 16), z3 = __uint_as_float(zz.y & 0xffff0000u);
      float x0 = __uint_as_float(xx.x << 16), x1 = __uint_as_float(xx.x & 0xffff0000u);
      float x2 = __uint_as_float(xx.y << 16), x3 = __uint_as_float(xx.y & 0xffff0000u);
      uint2 w;
      w.x = pk2(x0 * (acc[at][4 * g] * rn + z0 * bias), x1 * (acc[at][4 * g + 1] * rn + z1 * bias));
      w.y = pk2(x2 * (acc[at][4 * g + 2] * rn + z2 * bias), x3 * (acc[at][4 * g + 3] * rn + z3 * bias));
      *(uint2*)(OHT + (size_t)bb * 16384 + t) = w;
    }
  }
  __syncthreads();
}

DI void scan_item(CP p, int l, int si, char* smem) {
  const int tid = tidx(), lane = tid & 63, wave = tid >> 6;
  const int quarter = si & 3, dir = (si >> 2) & 1, hh = (si >> 3) & 3, b = si >> 5;
  const u16* Rb = (const u16*)(p->ws + S_R); const u16* KRAW = (const u16*)(p->ws + S_KRAW);
  const u16* Vb = (const u16*)(p->ws + S_V); const u16* KK = (const u16*)(p->ws + S_KK);
  const u16* LOUT = (const u16*)(p->ws + S_LOUT);
  u16* Yo = (u16*)(p->ws + (dir ? S_YB : S_YF));
  constexpr int BUF = 42 * 1024;
#define SCAN_ROW(s_) (((s_) < 256) ? (ML + b * 256 + (dir ? 255 - (s_) : (s_))) : (b * 16384 + (dir ? 16383 - ((s_) - 256) : ((s_) - 256))))
  __syncthreads();
  if (wave >= 4) {
    const int lt = tid - 256;
    const int lst = lt >> 3, lcg = lt & 7;
    const bool ldv = lt < 64;
    const int vst = lt >> 1, vcg = lt & 1;
    float kav[8];
    ld8f(p->in[18] + l * 256 + 64 * hh + 8 * lcg, kav);
    uint4 q0, q1, q2, q3, q4, q5 = make_uint4(0, 0, 0, 0);
#define SCAN_ISSUE(ch_)                                                                                  \
  {                                                                                                      \
    const int s__ = 32 * (ch_) + lst;                                                                    \
    const int m__ = SCAN_ROW(s__);                                                                       \
    const size_t o__ = (size_t)m__ * 256 + 64 * hh + 8 * lcg;                                            \
    q0 = *(const uint4*)(Rb + o__); q1 = *(const uint4*)(KRAW + o__); q2 = *(const uint4*)(KK + o__);    \
    q3 = *(const uint4*)(LOUT + (size_t)m__ * 1280 + dir * 512 + 64 * hh + 8 * lcg);                     \
    q4 = *(const uint4*)(LOUT + (size_t)m__ * 1280 + dir * 512 + 256 + 64 * hh + 8 * lcg);               \
    if (ldv) {                                                                                           \
      const int s2__ = 32 * (ch_) + vst;                                                                 \
      const int m2__ = SCAN_ROW(s2__);                                                                   \
      q5 = *(const uint4*)(Vb + (size_t)m2__ * 256 + 64 * hh + 16 * quarter + 8 * vcg);                  \
    }                                                                                                    \
  }
#define SCAN_COMMIT(bufi_)                                                                               \
  {                                                                                                      \
    float* base__ = (float*)(smem + (bufi_) * BUF);                                                      \
    float rr[8], kr[8], kk[8], ew[8], aa[8];                                                             \
    unpack8(q0, rr); unpack8(q1, kr); unpack8(q2, kk); unpack8(q3, ew); unpack8(q4, aa);                 \
    float* d__ = base__ + lst * 64 + 8 * lcg;                                                            \
    float o0[8], o1[8], o2[8], o3[8];                                                                    \
    const float one__ = one_f();                                                                         \
    _Pragma("unroll") for (int j = 0; j < 8; ++j) {                                                      \
      o0[j] = __expf(-ew[j]);                                                                            \
      o1[j] = kr[j] * (one__ + (aa[j] - one__) * kav[j]);                                                    \
      o2[j] = -kk[j];                                                                                    \
      o3[j] = kk[j] * aa[j];                                                                             \
    }                                                                                                    \
    *(float4*)(d__) = make_float4(o0[0], o0[1], o0[2], o0[3]); *(float4*)(d__ + 4) = make_float4(o0[4], o0[5], o0[6], o0[7]); \
    *(float4*)(d__ + 2048) = make_float4(o1[0], o1[1], o1[2], o1[3]); *(float4*)(d__ + 2052) = make_float4(o1[4], o1[5], o1[6], o1[7]); \
    *(float4*)(d__ + 4096) = make_float4(o2[0], o2[1], o2[2], o2[3]); *(float4*)(d__ + 4100) = make_float4(o2[4], o2[5], o2[6], o2[7]); \
    *(float4*)(d__ + 6144) = make_float4(o3[0], o3[1], o3[2], o3[3]); *(float4*)(d__ + 6148) = make_float4(o3[4], o3[5], o3[6], o3[7]); \
    *(float4*)(d__ + 8192) = make_float4(rr[0], rr[1], rr[2], rr[3]); *(float4*)(d__ + 8196) = make_float4(rr[4], rr[5], rr[6], rr[7]); \
    if (ldv) {                                                                                           \
      float vv[8];                                                                                       \
      unpack8(q5, vv);                                                                                   \
      float* dv__ = base__ + 5 * 2048 + vst * 16 + 8 * vcg;                                              \
      *(float4*)(dv__) = make_float4(vv[0], vv[1], vv[2], vv[3]); *(float4*)(dv__ + 4) = make_float4(vv[4], vv[5], vv[6], vv[7]); \
    }                                                                                                    \
  }
    SCAN_ISSUE(0)
    SCAN_COMMIT(0)
    SCAN_ISSUE(1)
    __syncthreads();
#pragma unroll 1
    for (int ch = 0; ch < 520; ++ch) {
      if (ch + 1 < 520) SCAN_COMMIT((ch + 1) & 1)
      if (ch + 2 < 520) SCAN_ISSUE(ch + 2)
      __syncthreads();
    }
  } else {
    const int rowl = lane >> 4, jl = lane & 15;
    const int il = 4 * wave + rowl;
    f2v S01 = {0.f, 0.f}, S23 = {0.f, 0.f};
    __syncthreads();
#pragma unroll 1
    for (int ch = 0; ch < 520; ++ch) {
      const float* base = (const float*)(smem + (ch & 1) * BUF);
      const int s0 = 32 * ch;
      const int mrow0 = SCAN_ROW(s0);
      const int mstep = dir ? -1 : 1;
      u16* yp = Yo + (size_t)(mrow0 + jl * mstep) * 256 + 64 * hh + 16 * quarter + il;
      const float* sp = base + 4 * jl;
      const float* vp = base + 5 * 2048 + il;
      float4 cw = *(const float4*)(sp), ck = *(const float4*)(sp + 2048), cn = *(const float4*)(sp + 4096);
      float4 cb = *(const float4*)(sp + 6144), cr = *(const float4*)(sp + 8192);
      float cv = vp[0];
      float ykeep = 0.f;
#pragma unroll
      for (int st = 0; st < 32; ++st) {
        float4 nw = cw, nk = ck, nn = cn, nb = cb, nr = cr; float nv = cv;
        if (st + 1 < 32) {
          const float* sq = sp + (st + 1) * 64;
          nw = *(const float4*)(sq); nk = *(const float4*)(sq + 2048); nn = *(const float4*)(sq + 4096);
          nb = *(const float4*)(sq + 6144); nr = *(const float4*)(sq + 8192);
          nv = vp[(st + 1) * 16];
        }
        f2v n01 = {cn.x, cn.y}, n23 = {cn.z, cn.w};
        f2v t = S01 * n01 + S23 * n23;
        float sa = dpp_sum16(t.x + t.y);
        f2v sa2 = {sa, sa}, v2 = {cv, cv};
        f2v w01 = {cw.x, cw.y}, w23 = {cw.z, cw.w}, b01 = {cb.x, cb.y}, b23 = {cb.z, cb.w}, k01 = {ck.x, ck.y}, k23 = {ck.z, ck.w};
        S01 = S01 * w01 + sa2 * b01 + v2 * k01;
        S23 = S23 * w23 + sa2 * b23 + v2 * k23;
        f2v r01 = {cr.x, cr.y}, r23 = {cr.z, cr.w};
        f2v u = S01 * r01 + S23 * r23;
        float y = dpp_sum16(u.x + u.y);
        ykeep = ((st & 15) == jl) ? y : ykeep;
        if ((st & 15) == 15) yp[(ptrdiff_t)((st & 16) * mstep) * 256] = f2bf(ykeep);
        cw = nw; ck = nk; cn = nn; cb = nb; cr = nr; cv = nv;
      }
      __syncthreads();
    }
  }
#undef SCAN_ISSUE
#undef SCAN_COMMIT
#undef SCAN_ROW
}

constexpr int T3_SCAN = 64, T3_DIFF = 8 * 33, T3_MLA = 8 * 33, T3_HY = 256;
constexpr int T3_TOTAL = T3_SCAN + T3_DIFF + T3_MLA + T3_HY;
DI void ph_t3(CP p, int l, char* smem, int* s_item, int rep) {
  u32* cnt = (u32*)(p->ws + O_CNT) + l + 2 * rep;
  for (;;) {
    __syncthreads();
    if (tidx() == 0) *s_item = (int)atomicAdd(cnt, 1u);
    __syncthreads();
    int it = *s_item;
    if (it >= T3_TOTAL) break;
    if (it < T3_SCAN) { if (T3_ON(0)) scan_item(p, l, it, smem); }
    else if (it < T3_SCAN + T3_DIFF) {
      int j = it - T3_SCAN;
      int bh = j / 33, qt = j % 33;
      if (T3_ON(1)) diff_item(p, l, bh >> 2, bh & 3, qt, smem);
    } else if (it < T3_SCAN + T3_DIFF + T3_MLA) {
      int j = it - T3_SCAN - T3_DIFF;
      int bh = j / 33, qt = j % 33;
      if (T3_ON(2)) mla_item(p, bh >> 2, bh & 3, qt, smem);
    } else if (T3_ON(3)) hyena_item(p, l, it - T3_SCAN - T3_DIFF - T3_MLA, smem);
  }
}

DI void t4_tile(CP p, int l, int tl, char* smem) {
  const int tid = tidx();
  const int m0 = tl * 64;
  const bool lat = m0 < ML;
  int b, t0;
  if (lat) { b = m0 >> 14; t0 = m0 & 16383; } else { int mc = m0 - ML; b = mc >> 8; t0 = mc & 255; }
  const u16* Rb = (const u16*)(p->ws + S_R); const u16* KRAW = (const u16*)(p->ws + S_KRAW); const u16* Vb = (const u16*)(p->ws + S_V);
  const u16* LOUT = (const u16*)(p->ws + S_LOUT);
  const u16* YF = (const u16*)(p->ws + S_YF); const u16* YB = (const u16*)(p->ws + S_YB);
  u16* OALL = (u16*)(p->ws + S_OALL);
#pragma unroll 1
  for (int e = 0; e < 4; ++e) {
    int it = tid + NT * e;
    int tok = it >> 5, hh = (it >> 3) & 3, sub = it & 7;
    int m = m0 + tok, c0 = 64 * hh + 8 * sub;
    float yf[8], yb[8], y[8];
    ld8(YF + (size_t)m * 256 + c0, yf); ld8(YB + (size_t)m * 256 + c0, yb);
    float s = 0.f;
#pragma unroll
    for (int j = 0; j < 8; ++j) { y[j] = yf[j] + yb[j]; s += y[j]; }
    float mean = grp8_sum(s) * (1.f / 64.f);
    float vs = 0.f;
#pragma unroll
    for (int j = 0; j < 8; ++j) { float d = y[j] - mean; vs += d * d; }
    float var = grp8_sum(vs) * (1.f / 64.f);
    float rs = rsqrtf(var + 64e-5f);
    float rr[8], kr[8], vv[8], alf[8], alb[8], gg[8], ka[8], rk[8], lw[8], lb[8];
    ld8(Rb + (size_t)m * 256 + c0, rr); ld8(KRAW + (size_t)m * 256 + c0, kr); ld8(Vb + (size_t)m * 256 + c0, vv);
    ld8(LOUT + (size_t)m * 1280 + 256 + c0, alf); ld8(LOUT + (size_t)m * 1280 + 768 + c0, alb); ld8(LOUT + (size_t)m * 1280 + 1024 + c0, gg);
    ld8f(p->in[18] + l * 256 + c0, ka); ld8f(p->in[19] + l * 256 + c0, rk);
    ld8f(p->in[20] + l * 256 + c0, lw); ld8f(p->in[21] + l * 256 + c0, lb);
    float bs = 0.f;
    const float one1 = one_f();
#pragma unroll
    for (int j = 0; j < 8; ++j) {
      float af = alf[j], ab = alb[j];
      float kf = kr[j] * (one1 + (af - one1) * ka[j]), kb = kr[j] * (one1 + (ab - one1) * ka[j]);
      bs += rr[j] * rk[j] * (kf + kb);
    }
    bs = grp8_sum(bs);
    float o[8];
#pragma unroll
    for (int j = 0; j < 8; ++j) o[j] = ((y[j] - mean) * rs * lw[j] + lb[j] + bs * vv[j]) * gg[j];
    st8(OALL + (size_t)m * 1024 + c0, o);
  }
  if (lat) {
    const u16* OHT = (const u16*)(p->ws + S_OHT);
    u16* tb = (u16*)smem;
#pragma unroll 1
    for (int e = 0; e < 4; ++e) {
      int id = tid + NT * e;
      int ch = id >> 3, tc8 = id & 7;
      uint4 vv = *(const uint4*)(OHT + ((size_t)ch * 2 + b) * 16384 + t0 + 8 * tc8);
      const u16* vs = (const u16*)&vv;
#pragma unroll
      for (int j = 0; j < 8; ++j) tb[(8 * tc8 + j) * 264 + ch] = vs[j];
    }
    __syncthreads();
#pragma unroll 1
    for (int e = 0; e < 4; ++e) {
      int id = tid + NT * e;
      int tok = id >> 5, cg = id & 31;
      *(uint4*)(OALL + (size_t)(m0 + tok) * 1024 + 256 + 8 * cg) = *(const uint4*)(tb + tok * 264 + 8 * cg);
    }
    __syncthreads();
  } else {
    const float* ZC = (const float*)(p->ws + O_ZC);
    const float* X0C = (const float*)(p->ws + O_X0C);
    const float* hfc = (const float*)(p->ws + O_HFC);
    const float* part = (const float*)(p->ws + O_HPART);
    const int c = tid & 255, hf = tid >> 8;
    float nrm = 0.f;
    for (int i = 0; i < 4; ++i) nrm += part[(256 + i) * 512 + c] + part[(256 + i) * 512 + 256 + c];
    const float rn = rsqrtf(nrm);
    const float bias = p->in[31][l * 256 + c];
    float acc[32];
#pragma unroll
    for (int j = 0; j < 32; ++j) acc[j] = 0.f;
    const int tb0 = t0 + hf * 32;
#pragma unroll 1
    for (int q = 0; q < 8; ++q) {
      float kw[63], zz[32];
#pragma unroll
      for (int e = 0; e < 63; ++e) {
        int d = tb0 - 32 * q - 31 + e;
        kw[e] = (d >= 0) ? ((d < 256) ? hfc[d * 512 + c] : 0.f) : ((-d - 1 < 255) ? hfc[(-d - 1) * 512 + 256 + c] : 0.f);
      }
#pragma unroll
      for (int u = 0; u < 32; ++u) zz[u] = ZC[(b * 256 + 32 * q + u) * 256 + c];
#pragma unroll
      for (int u = 0; u < 32; ++u)
#pragma unroll
        for (int j = 0; j < 32; ++j) acc[j] += kw[31 + j - u] * zz[u];
    }
#pragma unroll
    for (int j = 0; j < 32; ++j) {
      int t = tb0 + j;
      int mc = b * 256 + t;
      float z = ZC[mc * 256 + c], x0 = X0C[mc * 256 + c];
      OALL[(size_t)(ML + mc) * 1024 + 256 + c] = f2bf(x0 * (acc[j] * rn + z * bias));
    }
  }
  {
    const int wave = tid >> 6;
    const float* MOD = (const float*)(p->ws + O_MOD);
    for (int q = 0; q < 8; ++q) {
      int m = m0 + wave * 8 + q;
      const float* modl = MOD + (size_t)l * 27648 + mod_index(m) * 9216;
      const float* xs = (m < ML) ? p->out + (size_t)m * 1024 : (const float*)(p->ws + O_XC) + (size_t)(m - ML) * 1024;
      row_op(p, m, xs, nullptr, nullptr, nullptr, nullptr, 0, 0.f, p->in[6] + (size_t)(l * 3 + 1) * 1024, modl, 1, (u16*)(p->ws + O_H));
    }
  }
}

template <int BM>
DI void t5_tile(CP p, int l, int m0, int n0, char* smem) {
  constexpr int WNT = (BM == 256) ? 2 : 1;
  const u16* H = (const u16*)(p->ws + O_H);
  const u16* OALL = (const u16*)(p->ws + S_OALL);
  u16* ACCM = (u16*)(p->ws + S_ACCM);
  const int lane = tidx() & 63, wave = tidx() >> 6, r = lane & 31;
  const int wn = (BM == 256) ? (wave & 1) : (wave & 3);
  f32x16 accs[2][WNT];
  zero_acc<WNT>(accs);
#pragma unroll 1
  for (int n = 0; n < 4; ++n) {
    f32x16 g[2][WNT], u[2][WNT];
    zero_acc<WNT>(g);
    gemm_main<BM, WNT>(H, 1024, (const u16*)(p->ws + O_WGATE) + (size_t)n * 1024 * 1024, 1024, m0, n0, smem, g);
    const float* bgp = p->in[43] + (size_t)(l * 4 + n) * 1024 + n0 + 32 * WNT * wn + r;
#pragma unroll
    for (int nt = 0; nt < WNT; ++nt) {
      const float bg = bgp[32 * nt];
#pragma unroll
      for (int mt = 0; mt < 2; ++mt)
#pragma unroll
        for (int i = 0; i < 16; ++i) g[mt][nt][i] = __builtin_amdgcn_rcpf(1.f + __expf(-(g[mt][nt][i] + bg)));
    }
    zero_acc<WNT>(u);
    gemm_main<BM, WNT>(OALL + 256 * n, 1024, (const u16*)(p->ws + O_WUP) + (size_t)n * 1024 * 256, 256, m0, n0, smem, u);
#pragma unroll
    for (int mt = 0; mt < 2; ++mt)
#pragma unroll
      for (int nt = 0; nt < WNT; ++nt)
#pragma unroll
        for (int i = 0; i < 16; ++i) accs[mt][nt][i] += g[mt][nt][i] * u[mt][nt][i];
  }
  store_bf16<BM, WNT>(accs, ACCM, 1024, m0, n0);
}
DI void ph_t5(CP p, int l, char* smem, int nm = 130) {
  const int total = nm * 8;
  const int full = (gridDim.x == 256) ? (total & ~255) : total;
  for (int it = blockIdx.x; it < full; it += gridDim.x) {
    const int t = xcd_seq(it);
    t5_tile<256>(p, l, (t >> 3) * 256, (t & 7) * 128, smem);
  }
  const int nsub = (total - full) * 2;
  for (int it = blockIdx.x; it < nsub; it += gridDim.x) {
    const int t = full + (it >> 1);
    t5_tile<128>(p, l, (t >> 3) * 256 + (it & 1) * 128, (t & 7) * 128, smem);
  }
}
DI void ph_t6(CP p, char* smem, int nm = 130) { g8_phase(p, S_ACCM, O_WO, S_YM, 1024, 4, 1024, smem, nm); }

#define XB_TMO      128
#define XB_XCNT(j)  (256  + 64 * (j))
#define XB_XSUB(j)  (1280 + 64 * (j))
#define XB_XGEN(j)  (2304 + 64 * (j))
#define XB_TOP      3328
#define XB_TOPGEN   3392
#define XCD_BAR_WORDS 3456
#define XB_SPIN_CAP (1u << 18)
#define LAS __attribute__((address_space(3)))

__device__ __forceinline__ unsigned xb_ld(unsigned* p)              { return __hip_atomic_load(p, __ATOMIC_RELAXED, __HIP_MEMORY_SCOPE_AGENT); }
__device__ __forceinline__ unsigned xb_add(unsigned* p, unsigned v) { return __hip_atomic_fetch_add(p, v, __ATOMIC_RELAXED, __HIP_MEMORY_SCOPE_AGENT); }
__device__ __forceinline__ unsigned xb_xcc_id() { return (unsigned)__builtin_amdgcn_s_getreg((3 << 11) | 20) & 0xFu; }
#define XB_SPIN(cond, bar) do { unsigned _sp = 0; while (cond) { __builtin_amdgcn_s_sleep(1); \
    if ((++_sp & 255u) == 0u) { if (xb_ld(&(bar)[XB_TMO])) break; if (_sp > XB_SPIN_CAP) { atomicAdd(&(bar)[XB_TMO], 1u); break; } } } } while (0)

struct XcdBarrier {
    unsigned* bar; unsigned x;
    volatile LAS unsigned* st;
};

__device__ __forceinline__ XcdBarrier xcd_barrier_post(unsigned* bar, volatile LAS unsigned* st) {
    XcdBarrier b; b.bar = bar; b.x = xb_xcc_id(); b.st = st;
    if (threadIdx.x == 0) (void)xb_add(&bar[XB_XCNT(b.x)], 1u);
    return b;
}
__device__ __forceinline__ void xcd_barrier_complete(unsigned* bar, unsigned x, unsigned& nloc, unsigned& nx) {
    const unsigned G = gridDim.x * gridDim.y * gridDim.z;
    unsigned sum, cnt, mine, sp = 0u;
    for (;;) {
        sum = 0u; cnt = 0u; mine = 0u;
#pragma unroll
        for (unsigned j = 0; j < 16; ++j) { const unsigned c = xb_ld(&bar[XB_XCNT(j)]); sum += c; cnt += (c > 0u) ? 1u : 0u; mine = (j == x) ? c : mine; }
        if (sum == G) break;
        __builtin_amdgcn_s_sleep(1);
        if ((++sp & 255u) == 0u) { if (xb_ld(&bar[XB_TMO])) break; if (sp > XB_SPIN_CAP) { atomicAdd(&bar[XB_TMO], 1u); break; } }
    }
    nloc = mine > 0u ? mine : 1u; nx = cnt > 0u ? cnt : 1u;
}

__device__ __forceinline__ void xcd_barrier(const XcdBarrier& b) {
    asm volatile("s_waitcnt vmcnt(0)" ::: "memory");
    __syncthreads();
    if (threadIdx.x == 0) {
        unsigned* bar = b.bar;
        __builtin_amdgcn_s_waitcnt(0);
        unsigned nloc = b.st[0], nx = b.st[1];
        if (nloc == 0u) { xcd_barrier_complete(bar, b.x, nloc, nx); b.st[0] = nloc; b.st[1] = nx; }
        const unsigned old = xb_add(&bar[XB_XSUB(b.x)], 1u);
        const unsigned gen = old / nloc;
        if (old + 1u == (gen + 1u) * nloc) {
            __builtin_amdgcn_fence(__ATOMIC_RELEASE, "agent");
            asm volatile("s_waitcnt vmcnt(0)" ::: "memory");
            const unsigned og = xb_add(&bar[XB_TOP], 1u);
            const unsigned tg = og / nx;
            if (og + 1u == (tg + 1u) * nx) xb_add(&bar[XB_TOPGEN], 1u);
            else XB_SPIN(xb_ld(&bar[XB_TOPGEN]) == tg, bar);
            __builtin_amdgcn_fence(__ATOMIC_ACQUIRE, "agent");
            xb_add(&bar[XB_XGEN(b.x)], 1u);
            asm volatile("s_waitcnt vmcnt(0)" ::: "memory");
        } else {
            XB_SPIN(xb_ld(&bar[XB_XGEN(b.x)]) == gen, bar);
            __builtin_amdgcn_fence(__ATOMIC_ACQUIRE, "agent");
            asm volatile("s_waitcnt vmcnt(0)" ::: "memory");
        }
    }
    __syncthreads();
}


__global__ void __launch_bounds__(NT) mega(Params p_) {
  __shared__ __attribute__((aligned(16))) char smem[SMEM];
  __shared__ int s_item;
  cg::grid_group grid = cg::this_grid();
  const int ph0 = p_.ph0, ph1 = p_.ph1;
  CP p = (CP)__builtin_amdgcn_kernarg_segment_ptr();
  __shared__ uint4 xb_words;
  if (ph1 - ph0 > 1) {
    if (threadIdx.x == 0) xb_words = make_uint4(0u, 0u, 0u, 0u);
    __syncthreads();
    (void)xcd_barrier_post((unsigned*)(p_.ws + O_BAR), (volatile LAS unsigned*)&xb_words);
  }
#if PROBE_MASK
  long long pr_sum = 0, pr_t0 = wall_clock64();
#endif
  for (int ph = ph0; ph < ph1; ++ph) {
    if (ph == 17 && ph1 - ph0 > 1) continue;
    asm volatile("" : "+s"(p));
    if (ph == 0) {
      if (PH_ON(16)) {
        ph_prep(p, smem);
        if (ph1 - ph0 > 1) {
          const int total = CVT_TOTAL + 260;
          for (int it = blockIdx.x; it < total; it += gridDim.x) {
            if (it < CVT_TOTAL) cvt_tile(p, 0, it, smem);
            else filt_item(p, 0, it - CVT_TOTAL, smem);
          }
        }
      }
    }
    else {
      const int l = (ph - 1) >> 4, k = (ph - 1) & 15;
      switch (k) {
        case 0: if (PH_ON(0)) for (int rep = 0; rep < REP_EW; ++rep) {
          const int nrow = (l == 0) ? (M / 8) : 0;
          const int total = CVT_TOTAL + 260 + nrow;
          const int first = (ph1 - ph0 > 1) ? CVT_TOTAL + 260 : 0;
          for (int it = first + blockIdx.x; it < total; it += gridDim.x) {
            if (it < CVT_TOTAL) cvt_tile(p, l, it, smem);
            else if (it < CVT_TOTAL + 260) filt_item(p, l, it - CVT_TOTAL, smem);
            else row_dispatch(p, 0, 0, (it - CVT_TOTAL - 260) * 8 + (tidx() >> 6));
          }
        } break;
        case 1: if (PH_ON(1)) for (int rep = 0; rep < REP_GEMM; ++rep) ph_ffn1(p, 0, smem); break;
        case 2: if (PH_ON(2)) for (int rep = 0; rep < REP_GEMM; ++rep) ph_ffn2(p, 0, smem); break;
        case 3: if (PH_ON(3)) ph_rows(p, l, 1); break;
        case 4: if (PH_ON(4)) for (int rep = 0; rep < REP_GEMM; ++rep) ph_t1(p, smem); break;
        case 5: if (PH_ON(5)) for (int rep = 0; rep < REP_EW; ++rep) for (int t = blockIdx.x; t < 520; t += gridDim.x) t2a_tile(p, l, t, smem); break;
        case 6: if (PH_ON(6)) for (int rep = 0; rep < REP_EW2; ++rep) ph_t2b(p, smem); break;
        case 7: if (PH_ON(7)) for (int t = blockIdx.x; t < 520; t += gridDim.x) t2c_tile(p, l, t, smem); break;
        case 8: if (PH_ON(8)) for (int rep = 0; rep < REP_T3; ++rep) ph_t3(p, l, smem, &s_item, rep); break;
        case 9: if (PH_ON(9)) for (int rep = 0; rep < REP_EW2; ++rep) for (int t = blockIdx.x; t < (l == 1 ? 512 : 520); t += gridDim.x) t4_tile(p, l, t, smem); break;
        case 10: if (PH_ON(10)) for (int rep = 0; rep < REP_GEMM; ++rep) ph_t5(p, l, smem, l == 1 ? 128 : 130); break;
        case 11: if (PH_ON(11)) for (int rep = 0; rep < REP_GEMM; ++rep) ph_t6(p, smem, l == 1 ? 128 : 130); break;
        case 12: if (PH_ON(12)) ph_rows(p, l, 2, l == 1 ? ML : M); break;
        case 13: if (PH_ON(13)) for (int rep = 0; rep < REP_GEMM; ++rep) ph_ffn1(p, 1, smem, l == 1 ? 128 : 130); break;
        case 14: if (PH_ON(14)) for (int rep = 0; rep < REP_GEMM; ++rep) ph_ffn2(p, 1, smem, l == 1 ? 128 : 130); break;
        default: if (PH_ON(15)) {
          ph_rows(p, l, 3, l == 1 ? ML : M);
          if (l == 0 && ph1 - ph0 > 1) {
            const int total = CVT_TOTAL + 260;
            for (int it = blockIdx.x; it < total; it += gridDim.x) {
              if (it < CVT_TOTAL) cvt_tile(p, 1, it, smem);
              else filt_item(p, 1, it - CVT_TOTAL, smem);
            }
          }
        } break;
      }
    }
    if (ph + 1 < ph1) {
      if (ph == ph0) { __threadfence(); grid.sync(); __threadfence(); }
      else {
        XcdBarrier xb;
        xb.bar = (unsigned*)(p->ws + O_BAR); xb.x = xb_xcc_id(); xb.st = (volatile LAS unsigned*)&xb_words;
        xcd_barrier(xb);
      }
    }
#if PROBE_MASK
    {
      long long t1 = wall_clock64();
      int kb = (ph == 0) ? 16 : ((ph - 1) & 15);
      if ((PROBE_MASK >> kb) & 1) pr_sum += t1 - pr_t0;
      pr_t0 = t1;
    }
#endif
  }
#if PROBE_MASK
  if (blockIdx.x == 0) {
    long long te = wall_clock64();
    while (wall_clock64() - te < pr_sum) __builtin_amdgcn_s_sleep(8);
  }
#endif
}

extern "C" void kernel_launch(void* const* d_in, const int* in_sizes, int n_in, void* d_out, int out_size, void* d_ws,
                              size_t ws_size, hipStream_t stream) {
  if (n_in < 45 || ws_size < WS_NEED) {
    fprintf(stderr, "kernel_launch: bad inputs (n_in=%d ws=%zu need=%zu)\n", n_in, ws_size, (size_t)WS_NEED);
    return;
  }
  Params p{};
  for (int i = 0; i < 45; ++i) p.in[i] = (const float*)d_in[i];
  p.out = (float*)d_out;
  p.ws = (char*)d_ws;
#if COOP
  p.ph0 = 0; p.ph1 = NPH;
  hipMemsetAsync((char*)d_ws + O_BAR, 0, 16384, stream);
  void* args[] = {&p};
  hipError_t e = hipLaunchCooperativeKernel((void*)mega, dim3(256), dim3(NT), args, 0, stream);
  if (e != hipSuccess) fprintf(stderr, "cooperative launch failed: %s\n", hipGetErrorString(e));
#else
  for (int ph = 0; ph < NPH; ++ph) {
    p.ph0 = ph; p.ph1 = ph + 1;
    hipLaunchKernelGGL(mega, dim3(256), dim3(NT), 0, stream, p);
  }
#endif
}
```
